# Optimizing an MI355X kernel written in HIP

```python
import jax, jax.numpy as jnp
from jax import lax
import numpy as np

D_MODEL = 2048
BATCH = 16
SEQ = 2048
DEPTH = 1

CHUNK = 64
LEFT_CHUNKS = 8
BAND = (LEFT_CHUNKS + 1) * CHUNK
ATT_HEAD_DIM = 64
ATT_WIDTH = D_MODEL // 2
ATT_HEADS = ATT_WIDTH // ATT_HEAD_DIM
MAX_REL = 2 * CHUNK
LRU_WIDTH = D_MODEL - ATT_WIDTH
LRU_BLOCKS = 8
LRU_BLOCK_W = LRU_WIDTH // LRU_BLOCKS
CONV_WIDTH = 4
LRU_C = 8.0
MIX_WIDTH = ATT_WIDTH + LRU_WIDTH
IN_WIDTH = 3 * ATT_WIDTH + 2 * LRU_WIDTH
MEM_LEN = 256
X_HEADS = 4
X_HEAD_DIM = 128
X_WIDTH = X_HEADS * X_HEAD_DIM
N_EXPERTS = 32
TOP_K = 4
D_FF = D_MODEL
SWIGLU_ALPHA = 1.702
SWIGLU_LIMIT = 7.0
MOE_BLOCK = 256
EPS = 1e-6

kernel_name = "hybrid_chunk_attn_rglru_moe_encoder"


def rms_norm(x, g):
    xf = x.astype(jnp.float32)
    y = xf * lax.rsqrt(jnp.mean(xf * xf, axis=-1, keepdims=True) + EPS)
    return (y * g.astype(jnp.float32)).astype(x.dtype)


def chunked_band_attention(q, k, v, rel_table):
    B, S, H, Dh = q.shape
    n_chunks = S // CHUNK
    pad = LEFT_CHUNKS * CHUNK
    k_pad = jnp.pad(k, ((0, 0), (pad, 0), (0, 0), (0, 0)))
    v_pad = jnp.pad(v, ((0, 0), (pad, 0), (0, 0), (0, 0)))
    rel = jnp.arange(CHUNK)[:, None] + pad - jnp.arange(BAND)[None, :]
    bias = rel_table[:, jnp.clip(rel, -MAX_REL, MAX_REL) + MAX_REL].astype(jnp.float32)
    q_chunks = q.reshape(B, n_chunks, CHUNK, H, Dh).transpose(1, 0, 2, 3, 4)
    scale = Dh ** -0.5

    def one_chunk(args):
        qc, c = args
        start = c * CHUNK
        kb = lax.dynamic_slice_in_dim(k_pad, start, BAND, axis=1)
        vb = lax.dynamic_slice_in_dim(v_pad, start, BAND, axis=1)
        s = jnp.einsum('bqhd,bkhd->bhqk', qc, kb).astype(jnp.float32) * scale + bias
        valid = (start - pad + jnp.arange(BAND)) >= 0
        s = jnp.where(valid, s, -jnp.inf)
        p = jax.nn.softmax(s, axis=-1).astype(vb.dtype)
        return jnp.einsum('bhqk,bkhd->bqhd', p, vb)

    out = lax.map(one_chunk, (q_chunks, jnp.arange(n_chunks)))
    return out.transpose(1, 0, 2, 3, 4).reshape(B, S, H * Dh)


def rg_lru_branch(xr, gate_in, conv_w, conv_b, w_ga, b_ga, w_gx, b_gx, lam):
    B, S, W = xr.shape
    xc = lax.conv_general_dilated(
        xr, conv_w[:, None, :], window_strides=(1,), padding=[(CONV_WIDTH - 1, 0)],
        dimension_numbers=('NWC', 'WIO', 'NWC'), feature_group_count=W) + conv_b
    xb = xc.reshape(B, S, LRU_BLOCKS, LRU_BLOCK_W)
    r = jax.nn.sigmoid(jnp.einsum('bsnc,ncd->bsnd', xb, w_ga) + b_ga).reshape(B, S, W)
    i = jax.nn.sigmoid(jnp.einsum('bsnc,ncd->bsnd', xb, w_gx) + b_gx).reshape(B, S, W)
    log_a = -LRU_C * r.astype(jnp.float32) * jax.nn.softplus(-lam.astype(jnp.float32))
    a = jnp.exp(log_a)
    b = jnp.sqrt(-jnp.expm1(2.0 * log_a)) * (i * xc).astype(jnp.float32)

    def combine(left, right):
        return (left[0] * right[0], right[0] * left[1] + right[1])

    _, h = lax.associative_scan(combine, (a, b), axis=1)
    return h.astype(xr.dtype) * jax.nn.gelu(gate_in)


def memory_cross_attention(h, mem_n, w_cq, w_ckv, w_co):
    B, S, _ = h.shape
    M = mem_n.shape[1]
    cq = (h @ w_cq).reshape(B, S, X_HEADS, X_HEAD_DIM)
    ck, cv = jnp.split(mem_n @ w_ckv, 2, axis=-1)
    ck = ck.reshape(B, M, X_HEADS, X_HEAD_DIM)
    cv = cv.reshape(B, M, X_HEADS, X_HEAD_DIM)
    s = jnp.einsum('bqhd,bkhd->bhqk', cq, ck).astype(jnp.float32) * (X_HEAD_DIM ** -0.5)
    p = jax.nn.softmax(s, axis=-1).astype(cv.dtype)
    o = jnp.einsum('bhqk,bkhd->bqhd', p, cv).reshape(B, S, X_WIDTH)
    return o @ w_co


def moe_ffn(h, w_router, b_router, w_gu, b_gu, w_down, b_down):
    B, S, D = h.shape
    n_tok = B * S
    hf = h.reshape(n_tok, D)
    logits = (hf @ w_router + b_router).astype(jnp.float32)
    top_v, top_e = lax.top_k(logits, TOP_K)
    gates = jax.nn.softmax(top_v, axis=-1)
    n_assign = n_tok * TOP_K
    flat_e = top_e.reshape(-1)
    order = jnp.argsort(flat_e, stable=True)
    sorted_e = flat_e[order]
    sorted_tok = (order // TOP_K).astype(jnp.int32)
    sorted_gate = gates.reshape(-1)[order]
    counts = jnp.bincount(flat_e, length=N_EXPERTS)
    padded = (counts + MOE_BLOCK - 1) // MOE_BLOCK * MOE_BLOCK
    pad_end = jnp.cumsum(padded)
    pad_start = pad_end - padded
    start = jnp.cumsum(counts) - counts
    dest = pad_start[sorted_e] + jnp.arange(n_assign) - start[sorted_e]
    n_blocks = (n_assign + N_EXPERTS * (MOE_BLOCK - 1) + MOE_BLOCK - 1) // MOE_BLOCK
    n_slots = n_blocks * MOE_BLOCK
    slot_tok = jnp.zeros((n_slots,), jnp.int32).at[dest].set(sorted_tok)
    slot_gate = jnp.zeros((n_slots,), jnp.float32).at[dest].set(sorted_gate)
    block_expert = jnp.minimum(
        jnp.searchsorted(pad_end, jnp.arange(n_blocks) * MOE_BLOCK, side='right'), N_EXPERTS - 1)

    def expert_block(acc, blk):
        tok, g, e = blk
        xb = hf[tok]
        gu = xb @ w_gu[e] + b_gu[e]
        gate = jnp.minimum(gu[:, :D_FF], SWIGLU_LIMIT)
        up = jnp.clip(gu[:, D_FF:], -SWIGLU_LIMIT, SWIGLU_LIMIT)
        act = (up + 1.0) * gate * jax.nn.sigmoid(SWIGLU_ALPHA * gate)
        y = act @ w_down[e] + b_down[e]
        return acc.at[tok].add(y * g[:, None].astype(y.dtype)), None

    out, _ = lax.scan(expert_block, jnp.zeros_like(hf),
                      (slot_tok.reshape(n_blocks, MOE_BLOCK),
                       slot_gate.reshape(n_blocks, MOE_BLOCK), block_expert))
    return out.reshape(B, S, D)


def setup_inputs(seed: int = 0) -> dict:
    key = jax.random.key(seed)
    ks = jax.random.split(key, 32)
    f32 = jnp.float32
    nrm = lambda k, shape, scale: jax.random.normal(k, shape, f32) * scale
    gain = lambda k, n: 1.0 + 0.05 * jax.random.normal(k, (DEPTH, n), f32)
    u = jax.random.uniform(ks[8], (DEPTH, LRU_WIDTH), f32, 0.9, 0.999)
    sig = u ** (1.0 / LRU_C)
    return {
        "x": jax.random.normal(ks[0], (BATCH, SEQ, D_MODEL), f32),
        "mem": jax.random.normal(ks[1], (BATCH, MEM_LEN, D_MODEL), f32),
        "norm_mix_g": gain(ks[2], D_MODEL),
        "w_in": nrm(ks[3], (DEPTH, D_MODEL, IN_WIDTH), D_MODEL ** -0.5),
        "rel_table": nrm(ks[4], (DEPTH, ATT_HEADS, 2 * MAX_REL + 1), 0.1),
        "conv_w": nrm(ks[5], (DEPTH, CONV_WIDTH, LRU_WIDTH), CONV_WIDTH ** -0.5),
        "conv_b": nrm(ks[6], (DEPTH, LRU_WIDTH), 0.01),
        "w_ga": nrm(ks[7], (DEPTH, LRU_BLOCKS, LRU_BLOCK_W, LRU_BLOCK_W), LRU_BLOCK_W ** -0.5),
        "b_ga": nrm(ks[9], (DEPTH, LRU_BLOCKS, LRU_BLOCK_W), 0.01),
        "w_gx": nrm(ks[10], (DEPTH, LRU_BLOCKS, LRU_BLOCK_W, LRU_BLOCK_W), LRU_BLOCK_W ** -0.5),
        "b_gx": nrm(ks[11], (DEPTH, LRU_BLOCKS, LRU_BLOCK_W), 0.01),
        "lru_lambda": jnp.log(sig / (1.0 - sig)),
        "norm_att_out_g": gain(ks[12], ATT_WIDTH),
        "norm_lru_out_g": gain(ks[13], LRU_WIDTH),
        "w_out": nrm(ks[14], (DEPTH, MIX_WIDTH, D_MODEL), MIX_WIDTH ** -0.5),
        "norm_cross_g": gain(ks[15], D_MODEL),
        "norm_mem_g": gain(ks[16], D_MODEL),
        "w_cq": nrm(ks[17], (DEPTH, D_MODEL, X_WIDTH), D_MODEL ** -0.5),
        "w_ckv": nrm(ks[18], (DEPTH, D_MODEL, 2 * X_WIDTH), D_MODEL ** -0.5),
        "w_co": nrm(ks[19], (DEPTH, X_WIDTH, D_MODEL), X_WIDTH ** -0.5),
        "norm_ffn_g": gain(ks[20], D_MODEL),
        "w_router": nrm(ks[21], (DEPTH, D_MODEL, N_EXPERTS), D_MODEL ** -0.5),
        "b_router": nrm(ks[22], (DEPTH, N_EXPERTS), 0.01),
        "w_gu": nrm(ks[23], (DEPTH, N_EXPERTS, D_MODEL, 2 * D_FF), D_MODEL ** -0.5),
        "b_gu": nrm(ks[24], (DEPTH, N_EXPERTS, 2 * D_FF), 0.01),
        "w_down": nrm(ks[25], (DEPTH, N_EXPERTS, D_FF, D_MODEL), D_FF ** -0.5),
        "b_down": nrm(ks[26], (DEPTH, N_EXPERTS, D_MODEL), 0.01),
        "norm_final_g": 1.0 + 0.05 * jax.random.normal(ks[27], (D_MODEL,), f32),
    }


def reference(x, mem, norm_mix_g, w_in, rel_table, conv_w, conv_b, w_ga, b_ga, w_gx, b_gx,
              lru_lambda, norm_att_out_g, norm_lru_out_g, w_out, norm_cross_g, norm_mem_g,
              w_cq, w_ckv, w_co, norm_ffn_g, w_router, b_router, w_gu, b_gu, w_down, b_down,
              norm_final_g):
    B, S, _ = x.shape
    splits = [ATT_WIDTH, 2 * ATT_WIDTH, 3 * ATT_WIDTH, 3 * ATT_WIDTH + LRU_WIDTH]
    for l in range(DEPTH):
        h = rms_norm(x, norm_mix_g[l])
        q, k, v, xr, yg = jnp.split(h @ w_in[l], splits, axis=-1)
        att = chunked_band_attention(q.reshape(B, S, ATT_HEADS, ATT_HEAD_DIM),
                                     k.reshape(B, S, ATT_HEADS, ATT_HEAD_DIM),
                                     v.reshape(B, S, ATT_HEADS, ATT_HEAD_DIM), rel_table[l])
        lru = rg_lru_branch(xr, yg, conv_w[l], conv_b[l], w_ga[l], b_ga[l], w_gx[l], b_gx[l],
                            lru_lambda[l])
        mixed = jnp.concatenate([rms_norm(att, norm_att_out_g[l]),
                                 rms_norm(lru, norm_lru_out_g[l])], axis=-1)
        x = x + mixed @ w_out[l]
        x = x + memory_cross_attention(rms_norm(x, norm_cross_g[l]), rms_norm(mem, norm_mem_g[l]),
                                       w_cq[l], w_ckv[l], w_co[l])
        x = x + moe_ffn(rms_norm(x, norm_ffn_g[l]), w_router[l], b_router[l], w_gu[l], b_gu[l],
                        w_down[l], b_down[l])
    return rms_norm(x, norm_final_g)
```

```cpp
#include <hip/hip_runtime.h>
#include <cstdio>
#include <cstdint>
#include <cmath>

#define GAS __attribute__((address_space(1)))
#define LAS __attribute__((address_space(3)))
typedef unsigned short bf16;
typedef unsigned v4u __attribute__((ext_vector_type(4)));
typedef unsigned v2u __attribute__((ext_vector_type(2)));
typedef float f32x4 __attribute__((ext_vector_type(4)));
typedef float f32x2 __attribute__((ext_vector_type(2)));
typedef float f32x16 __attribute__((ext_vector_type(16)));
typedef short bf16x8 __attribute__((ext_vector_type(8)));

constexpr int BATCH = 16, SEQ = 2048, DM = 2048, NTOK = BATCH * SEQ;
constexpr int CHUNK = 64, LEFTC = 8, AW = 1024, AH = 16, AHD = 64, MAXREL = 128, RELW = 2 * MAXREL + 1;
constexpr int LW = 1024, LB = 8, LBW = 128;
constexpr int MEML = 256, NMEM = BATCH * MEML, XH = 4, XHD = 128, XW = 512;
constexpr int NE = 32, TOPK = 4, DFF = 2048;
constexpr int NSLOT = NTOK * TOPK + NE * 256;
constexpr float EPS = 1e-6f, LOG2E = 1.4426950408889634f;
constexpr float QSCALE = 0.125f * LOG2E;
constexpr float CQSCALE = 0.08838834764831845f * LOG2E;
constexpr float SW_ALPHA = 1.702f, SW_LIMIT = 7.0f;

constexpr size_t MiB = 1u << 20;
constexpr size_t WS_CTL = 0, CTL_ZERO_BYTES = 1 * MiB;
constexpr size_t WS_W_IN = 2 * MiB, WS_W_OUT = 22 * MiB, WS_W_CQ = 30 * MiB, WS_W_CKV = 32 * MiB, WS_W_CO = 36 * MiB;
constexpr size_t WS_W_GA = 38 * MiB, WS_W_GX = WS_W_GA + 256 * 1024, WS_W_R = WS_W_GX + 256 * 1024;
constexpr size_t WS_SS0 = 39 * MiB, WS_SSM = WS_SS0 + 128 * 1024, WS_R2 = WS_SS0 + 256 * 1024;
constexpr size_t WS_SSA = 40 * MiB, WS_SSL = 42 * MiB, WS_SCL = 44 * MiB, WS_SS1P = 45 * MiB;
constexpr size_t WS_TOPE = 49 * MiB, WS_TOPG = WS_TOPE + 512 * 1024, WS_TPOS = 50 * MiB;
constexpr size_t WS_LIST = 51 * MiB, WS_CK = 55 * MiB, WS_CVT = 59 * MiB, WS_MEMB = 64 * MiB;
constexpr size_t WS_W_GU = 128 * MiB, WS_W_DN = 640 * MiB;
constexpr size_t WS_XB = 896 * MiB, WS_MIX = WS_XB;
constexpr size_t WS_QKXY = 1024 * MiB, WS_VT = 1280 * MiB, WS_X1B = 1344 * MiB, WS_CQ = 1472 * MiB, WS_OX = 1504 * MiB, WS_X2B = 1536 * MiB;
constexpr size_t WS_ACT = 1664 * MiB, WS_Y = 2208 * MiB, WS_NA = 2752 * MiB, WS_NB = 2880 * MiB, WS_END = 3008 * MiB;
constexpr int CW_CNT = 64;
constexpr int CW_TOFF = 128;
constexpr int CW_BAR = 4096;

struct P {
    const float *x, *mem, *g_mix, *w_in, *rel, *conv_w, *conv_b, *w_ga, *b_ga, *w_gx, *b_gx, *lam, *g_att, *g_lru, *w_out, *g_cross, *g_mem,
        *w_cq, *w_ckv, *w_co, *g_ffn, *w_r, *b_r, *w_gu, *b_gu, *w_dn, *b_dn, *g_fin;
    float* out; unsigned char* ws;
    int ph_lo, ph_hi, li, pad;
};

__device__ __forceinline__ float bf2f(bf16 b) { return __uint_as_float(((unsigned)b) << 16); }
__device__ __forceinline__ unsigned f2bf(float f) { unsigned u = __float_as_uint(f); return (u + 0x7fffu + ((u >> 16) & 1u)) >> 16; }
__device__ __forceinline__ unsigned pk2(float lo, float hi) { return f2bf(lo) | (f2bf(hi) << 16); }
__device__ __forceinline__ float wave_sum(float v) {
#pragma unroll
    for (int o = 1; o < 64; o <<= 1) v += __shfl_xor(v, o);
    return v;
}
__device__ __forceinline__ float sigmoidf_(float x) { return 1.0f / (1.0f + __expf(-x)); }
__device__ __forceinline__ float gelu_tanh(float x) { const float u = 0.7978845608028654f * (x + 0.044715f * x * x * x); return 0.5f * x * (1.0f + tanhf(u)); }
__device__ __forceinline__ int find_expert(const int* toff, int tile) { int e = 0;
#pragma unroll 1
    for (int i = 1; i < NE; ++i) e += (tile >= toff[i]) ? 1 : 0;
    return e; }

template <class F>
__global__ void __launch_bounds__(256) ngemm(F f) {
    __shared__ float As[16][68], Bs[16][68];
    const int tx = threadIdx.x & 15, ty = threadIdx.x >> 4, bm = blockIdx.y, bn = blockIdx.x;
    if (!f.valid(bm)) return;
    const int lr = threadIdx.x >> 2, lk = (threadIdx.x & 3) * 4;
    const bf16* ap = f.aptr(bm * 64 + lr);
    const bf16* bp = f.bptr(bm, bn, lr);
    float acc[4][4];
#pragma unroll
    for (int i = 0; i < 4; ++i)
#pragma unroll
        for (int j = 0; j < 4; ++j) acc[i][j] = 0.f;
    for (int k0 = 0; k0 < F::K; k0 += 16) {
        f.mid(k0, bm, ty, acc);
        const v2u av = *(const v2u*)(ap + k0 + lk), bv = *(const v2u*)(bp + k0 + lk);
        As[lk + 0][lr] = __uint_as_float(av.x << 16); As[lk + 1][lr] = __uint_as_float(av.x & 0xffff0000u);
        As[lk + 2][lr] = __uint_as_float(av.y << 16); As[lk + 3][lr] = __uint_as_float(av.y & 0xffff0000u);
        Bs[lk + 0][lr] = __uint_as_float(bv.x << 16); Bs[lk + 1][lr] = __uint_as_float(bv.x & 0xffff0000u);
        Bs[lk + 2][lr] = __uint_as_float(bv.y << 16); Bs[lk + 3][lr] = __uint_as_float(bv.y & 0xffff0000u);
        __syncthreads();
#pragma unroll
        for (int kk = 0; kk < 16; ++kk) {
            const f32x4 a = *(const f32x4*)&As[kk][ty * 4], b = *(const f32x4*)&Bs[kk][tx * 4];
#pragma unroll
            for (int i = 0; i < 4; ++i)
#pragma unroll
                for (int j = 0; j < 4; ++j) acc[i][j] += a[i] * b[j];
        }
        __syncthreads();
    }
    f.out(bm, bn, ty, tx, acc);
}
struct FBase {
    __device__ bool valid(int) const { return true; }
    __device__ void mid(int, int, int, float (&)[4][4]) const {}
};
struct F1 : FBase { static constexpr int K = 2048; const bf16* A; const bf16* Bt; const float* ss0; bf16* qkxy; bf16* vt;
    __device__ const bf16* aptr(int row) const { return A + (size_t)row * K; }
    __device__ const bf16* bptr(int, int bn, int j) const { return Bt + (size_t)(bn * 64 + j) * K; }
    __device__ void out(int bm, int bn, int ty, int tx, float (&acc)[4][4]) const {
        for (int i = 0; i < 4; ++i) { const int m = bm * 64 + ty * 4 + i; const float r0 = rsqrtf(ss0[m] * (1.0f / DM) + EPS);
            for (int j = 0; j < 4; ++j) { const int n = bn * 64 + tx * 4 + j, t = n >> 10, c = n & 1023; float v = acc[i][j] * r0;
                if (t == 2) vt[(size_t)c * NTOK + m] = (bf16)f2bf(v);
                else { const int slot = t < 2 ? t : t - 1; if (t == 0) v *= QSCALE; qkxy[(size_t)slot * NTOK * 1024 + (size_t)m * 1024 + c] = (bf16)f2bf(v); } } }
    }
};
struct F1b : FBase { static constexpr int K = 2048; const bf16* A; const bf16* Bt; const float* ssm; bf16* ck; bf16* cvt;
    __device__ const bf16* aptr(int row) const { return A + (size_t)row * K; }
    __device__ const bf16* bptr(int, int bn, int j) const { return Bt + (size_t)(bn * 64 + j) * K; }
    __device__ void out(int bm, int bn, int ty, int tx, float (&acc)[4][4]) const {
        for (int i = 0; i < 4; ++i) { const int m = bm * 64 + ty * 4 + i; const float r = rsqrtf(ssm[m] * (1.0f / DM) + EPS);
            for (int j = 0; j < 4; ++j) { const int n = bn * 64 + tx * 4 + j; const float v = acc[i][j] * r;
                if (n < XW) ck[(size_t)m * XW + n] = (bf16)f2bf(v); else cvt[(size_t)(n - XW) * NMEM + m] = (bf16)f2bf(v); } }
    }
};
struct F4 : FBase { static constexpr int K = 2048; const bf16* A; const bf16* Bt; const float* scl; const float* x; float* x1; bf16* x1b; float* ss1p;
    __device__ const bf16* aptr(int row) const { return A + (size_t)row * K; }
    __device__ const bf16* bptr(int, int bn, int j) const { return Bt + (size_t)(bn * 64 + j) * K; }
    __device__ void mid(int k0, int bm, int ty, float (&acc)[4][4]) const { if (k0 == 1024) { for (int i = 0; i < 4; ++i) { const float s = scl[2 * (bm * 64 + ty * 4 + i)]; for (int j = 0; j < 4; ++j) acc[i][j] *= s; } } }
    __device__ void out(int bm, int bn, int ty, int tx, float (&acc)[4][4]) const {
        for (int i = 0; i < 4; ++i) { const int m = bm * 64 + ty * 4 + i; const float s = scl[2 * m + 1]; float q = 0.f;
            for (int j = 0; j < 4; ++j) { const int n = bn * 64 + tx * 4 + j; const float v = x[(size_t)m * DM + n] + acc[i][j] * s; x1[(size_t)m * DM + n] = v; x1b[(size_t)m * DM + n] = (bf16)f2bf(v); q += v * v; }
            q += __shfl_xor(q, 1); q += __shfl_xor(q, 2); q += __shfl_xor(q, 4); q += __shfl_xor(q, 8);
            if (tx == 0) ss1p[(size_t)m * 32 + bn] = q; }
    }
};
struct F5 : FBase { static constexpr int K = 2048; const bf16* A; const bf16* Bt; const float* ss1p; bf16* cq;
    __device__ const bf16* aptr(int row) const { return A + (size_t)row * K; }
    __device__ const bf16* bptr(int, int bn, int j) const { return Bt + (size_t)(bn * 64 + j) * K; }
    __device__ void out(int bm, int bn, int ty, int tx, float (&acc)[4][4]) const {
        for (int i = 0; i < 4; ++i) { const int m = bm * 64 + ty * 4 + i; float q = 0.f; for (int p = 0; p < 32; ++p) q += ss1p[(size_t)m * 32 + p];
            const float r1 = rsqrtf(q * (1.0f / DM) + EPS) * CQSCALE;
            for (int j = 0; j < 4; ++j) { const int n = bn * 64 + tx * 4 + j; cq[(size_t)m * XW + n] = (bf16)f2bf(acc[i][j] * r1); } }
    }
};
struct F7 : FBase { static constexpr int K = 512; const bf16* A; const bf16* Bt; float* x12; bf16* x2b;
    __device__ const bf16* aptr(int row) const { return A + (size_t)row * K; }
    __device__ const bf16* bptr(int, int bn, int j) const { return Bt + (size_t)(bn * 64 + j) * K; }
    __device__ void out(int bm, int bn, int ty, int tx, float (&acc)[4][4]) const {
        for (int i = 0; i < 4; ++i) { const int m = bm * 64 + ty * 4 + i;
            for (int j = 0; j < 4; ++j) { const int n = bn * 64 + tx * 4 + j; const float v = x12[(size_t)m * DM + n] + acc[i][j]; x12[(size_t)m * DM + n] = v; x2b[(size_t)m * DM + n] = (bf16)f2bf(v); } }
    }
};
struct F9 { static constexpr int K = 2048; const bf16* x2b; const bf16* wgu; const int* toff; const int* cnt; const int* list; const float* r2; const float* b_gu; bf16* act;
    __device__ bool valid(int bm) const { return (bm >> 2) < toff[NE]; }
    __device__ void mid(int, int, int, float (&)[4][4]) const {}
    __device__ int tok_of(int slot, int& e) const { const int tile = slot >> 8; e = find_expert(toff, tile); const int pos = slot - 256 * toff[e]; return pos < cnt[e] ? list[e * NTOK + pos] : 0; }
    __device__ const bf16* aptr(int slot) const { int e; const int tok = tok_of(slot, e); return x2b + (size_t)tok * K; }
    __device__ const bf16* bptr(int bm, int bn, int j) const { const int e = find_expert(toff, bm >> 2); const int a = bn * 32 + (j >> 2) * 2 + (j & 1), up = (j >> 1) & 1;
        const int row = 256 * (a >> 7) + (a & 127) + 128 * up; return wgu + ((size_t)e * 4096 + row) * K; }
    __device__ void out(int bm, int bn, int ty, int tx, float (&acc)[4][4]) const {
        for (int i = 0; i < 4; ++i) { const int slot = bm * 64 + ty * 4 + i; int e; const int tok = tok_of(slot, e); const float r = r2[tok];
            for (int j = 0; j < 2; ++j) { const int a = bn * 32 + tx * 2 + j;
                float g = acc[i][j] * r + b_gu[e * 4096 + a], u = acc[i][2 + j] * r + b_gu[e * 4096 + 2048 + a];
                g = fminf(g, SW_LIMIT); u = fminf(fmaxf(u, -SW_LIMIT), SW_LIMIT);
                act[(size_t)slot * DFF + a] = (bf16)f2bf((u + 1.0f) * g * sigmoidf_(SW_ALPHA * g)); } }
    }
};
struct F10 { static constexpr int K = 2048; const bf16* act; const bf16* wdn; const int* toff; const float* b_dn; bf16* y;
    __device__ bool valid(int bm) const { return (bm >> 2) < toff[NE]; }
    __device__ void mid(int, int, int, float (&)[4][4]) const {}
    __device__ const bf16* aptr(int slot) const { return act + (size_t)slot * K; }
    __device__ const bf16* bptr(int bm, int bn, int j) const { const int e = find_expert(toff, bm >> 2); return wdn + ((size_t)e * DM + bn * 64 + j) * K; }
    __device__ void out(int bm, int bn, int ty, int tx, float (&acc)[4][4]) const { const int e = find_expert(toff, bm >> 2);
        for (int i = 0; i < 4; ++i) { const int slot = bm * 64 + ty * 4 + i;
            for (int j = 0; j < 4; ++j) { const int n = bn * 64 + tx * 4 + j; y[(size_t)slot * DM + n] = (bf16)f2bf(acc[i][j] + b_dn[e * DM + n]); } }
    }
};

__global__ void __launch_bounds__(256) n_attn(const bf16* __restrict__ qkxy, const bf16* __restrict__ vt, const float* __restrict__ rel, bf16* mix, float* ssa) {
    const int blk = blockIdx.x, tq = (blk & 7) * 256 + threadIdx.x, bh = blk >> 3, h = bh & 15, b = bh >> 4;
    const size_t m = (size_t)b * SEQ + tq;
    const bf16* Q = qkxy; const bf16* Kp = qkxy + (size_t)NTOK * 1024;
    float q[64], o[64];
#pragma unroll
    for (int d = 0; d < 64; ++d) { q[d] = bf2f(Q[m * 1024 + h * 64 + d]); o[d] = 0.f; }
    float mx = -INFINITY, l = 0.f;
    const int c = tq >> 6, k0 = (c > LEFTC ? c - LEFTC : 0) * 64, k1 = (c + 1) * 64;
    const float* tab = rel + h * RELW;
    for (int key = k0; key < k1; ++key) {
        const bf16* kr = Kp + ((size_t)b * SEQ + key) * 1024 + h * 64;
        float s = 0.f;
#pragma unroll
        for (int d = 0; d < 64; ++d) s += q[d] * bf2f(kr[d]);
        int r = tq - key; r = (r < -MAXREL ? -MAXREL : (r > MAXREL ? MAXREL : r)) + MAXREL;
        s += tab[r] * LOG2E;
        const float mn = fmaxf(mx, s), corr = exp2f(mx - mn), pe = exp2f(s - mn);
        l = l * corr + pe;
        const bf16* vp = vt + (size_t)(h * 64) * NTOK + (size_t)b * SEQ + key;
#pragma unroll
        for (int d = 0; d < 64; ++d) o[d] = o[d] * corr + pe * bf2f(vp[(size_t)d * NTOK]);
        mx = mn;
    }
    const float il = 1.0f / l; float ss = 0.f;
#pragma unroll
    for (int d = 0; d < 64; ++d) { const float v = o[d] * il; ss += v * v; mix[m * DM + h * 64 + d] = (bf16)f2bf(v); }
    ssa[m * 16 + h] = ss;
}
__global__ void __launch_bounds__(256) n_xattn(const bf16* __restrict__ cq, const bf16* __restrict__ ck, const bf16* __restrict__ cvt, bf16* ox) {
    const int blk = blockIdx.x, dh = blk & 1, tq = ((blk >> 1) & 7) * 256 + threadIdx.x, bh = blk >> 4, h = bh & 3, b = bh >> 2;
    const size_t m = (size_t)b * SEQ + tq;
    float q[128], o[64];
#pragma unroll
    for (int d = 0; d < 128; ++d) q[d] = bf2f(cq[m * XW + h * XHD + d]);
#pragma unroll
    for (int d = 0; d < 64; ++d) o[d] = 0.f;
    float mx = -INFINITY, l = 0.f;
    for (int key = 0; key < MEML; ++key) {
        const bf16* kr = ck + ((size_t)b * MEML + key) * XW + h * XHD;
        float s = 0.f;
#pragma unroll
        for (int d = 0; d < 128; ++d) s += q[d] * bf2f(kr[d]);
        const float mn = fmaxf(mx, s), corr = exp2f(mx - mn), pe = exp2f(s - mn);
        l = l * corr + pe;
        const bf16* vp = cvt + (size_t)(h * XHD + dh * 64) * NMEM + (size_t)b * MEML + key;
#pragma unroll
        for (int d = 0; d < 64; ++d) o[d] = o[d] * corr + pe * bf2f(vp[(size_t)d * NMEM]);
        mx = mn;
    }
    const float il = 1.0f / l;
#pragma unroll
    for (int d = 0; d < 64; ++d) ox[m * XW + h * XHD + dh * 64 + d] = (bf16)f2bf(o[d] * il);
}
__global__ void __launch_bounds__(256) n_lru_a(const bf16* __restrict__ xr, const float* __restrict__ conv_w, const float* __restrict__ conv_b, const bf16* __restrict__ wga_t, const float* __restrict__ b_ga,
                                              const bf16* __restrict__ wgx_t, const float* __restrict__ b_gx, const float* __restrict__ lam, float* na, float* nb) {
    const size_t idx = (size_t)blockIdx.x * 256 + threadIdx.x; const int c = (int)(idx & 1023); const size_t m = idx >> 10; const int t = (int)(m & (SEQ - 1)), n = c >> 7, d = c & 127;
    float rp = b_ga[c], ip = b_gx[c], xown = 0.f;
    const bf16* wa = wga_t + (size_t)(n * 128 + d) * 128; const bf16* wx = wgx_t + (size_t)(n * 128 + d) * 128;
    for (int cp = 0; cp < 128; ++cp) { const int cc = n * 128 + cp; float xc = conv_b[cc];
#pragma unroll
        for (int j = 0; j < 4; ++j) { const int tt = t - 3 + j; if (tt >= 0) xc += conv_w[j * LW + cc] * bf2f(xr[(m - 3 + j) * 1024 + cc]); }
        rp += xc * bf2f(wa[cp]); ip += xc * bf2f(wx[cp]); if (cp == d) xown = xc; }
    const float r = sigmoidf_(rp), ig = sigmoidf_(ip);
    const float la = -8.0f * r * log1pf(__expf(-lam[c]));
    na[idx] = __expf(la); nb[idx] = sqrtf(-expm1f(2.0f * la)) * (ig * xown);
}
__global__ void __launch_bounds__(64) n_lru_b(const float* __restrict__ na, const float* __restrict__ nb, const bf16* __restrict__ yg, bf16* mix, float* ssl) {
    const int b = blockIdx.x >> 4, g = blockIdx.x & 15, c = g * 64 + threadIdx.x; float h = 0.f;
    for (int t = 0; t < SEQ; ++t) { const size_t m = (size_t)b * SEQ + t; h = na[m * 1024 + c] * h + nb[m * 1024 + c];
        const float y = h * gelu_tanh(bf2f(yg[m * 1024 + c])); mix[m * DM + 1024 + c] = (bf16)f2bf(y);
        const float s = wave_sum(y * y); if (threadIdx.x == 0) ssl[m * 16 + g] = s; }
}
__global__ void n_toff(const int* cnt, int* toff) { if (threadIdx.x == 0 && blockIdx.x == 0) { int a = 0; for (int e = 0; e < NE; ++e) { toff[e] = a; a += (cnt[e] + 255) >> 8; } toff[NE] = a; } }

#define XB_TMO      128
#define XB_XCNT(j)  (256  + 64 * (j))
#define XB_XSUB(j)  (1280 + 64 * (j))
#define XB_XGEN(j)  (2304 + 64 * (j))
#define XB_TOP      3328
#define XB_TOPGEN   3392
#define XCD_BAR_WORDS 3456
#define XB_SPIN_CAP (1u << 18)
__device__ __forceinline__ unsigned xb_ld(unsigned* p)              { return __hip_atomic_load(p, __ATOMIC_RELAXED, __HIP_MEMORY_SCOPE_AGENT); }
__device__ __forceinline__ unsigned xb_add(unsigned* p, unsigned v) { return __hip_atomic_fetch_add(p, v, __ATOMIC_RELAXED, __HIP_MEMORY_SCOPE_AGENT); }
__device__ __forceinline__ unsigned xb_xcc_id() { return (unsigned)__builtin_amdgcn_s_getreg((3 << 11) | 20) & 0xFu; }
#define XB_SPIN(cond, bar) do { unsigned _sp = 0; while (cond) { __builtin_amdgcn_s_sleep(1); \
    if ((++_sp & 255u) == 0u) { if (xb_ld(&(bar)[XB_TMO])) break; if (_sp > XB_SPIN_CAP) { atomicAdd(&(bar)[XB_TMO], 1u); break; } } } } while (0)
struct XcdBarrier { unsigned* bar; unsigned x; volatile LAS unsigned* st; };
__device__ __forceinline__ XcdBarrier xcd_barrier_post(unsigned* bar, volatile LAS unsigned* st) {
    XcdBarrier b; b.bar = bar; b.x = xb_xcc_id(); b.st = st;
    if (threadIdx.x == 0) (void)xb_add(&bar[XB_XCNT(b.x)], 1u);
    return b;
}
__device__ __forceinline__ void xcd_barrier_complete(unsigned* bar, unsigned x, unsigned& nloc, unsigned& nx) {
    const unsigned G = gridDim.x * gridDim.y * gridDim.z;
    unsigned sum, cnt, mine, sp = 0u;
    for (;;) {
        sum = 0u; cnt = 0u; mine = 0u;
#pragma unroll
        for (unsigned j = 0; j < 16; ++j) { const unsigned c = xb_ld(&bar[XB_XCNT(j)]); sum += c; cnt += (c > 0u) ? 1u : 0u; mine = (j == x) ? c : mine; }
        if (sum == G) break;
        __builtin_amdgcn_s_sleep(1);
        if ((++sp & 255u) == 0u) { if (xb_ld(&bar[XB_TMO])) break; if (sp > XB_SPIN_CAP) { atomicAdd(&bar[XB_TMO], 1u); break; } }
    }
    nloc = mine > 0u ? mine : 1u; nx = cnt > 0u ? cnt : 1u;
}
__device__ __forceinline__ void xcd_barrier(const XcdBarrier& b) {
    asm volatile("s_waitcnt vmcnt(0)" ::: "memory");
    __syncthreads();
    if (threadIdx.x == 0) {
        unsigned* bar = b.bar;
        __builtin_amdgcn_s_waitcnt(0);
        unsigned nloc = b.st[0], nx = b.st[1];
        if (nloc == 0u) { xcd_barrier_complete(bar, b.x, nloc, nx); b.st[0] = nloc; b.st[1] = nx; }
        const unsigned old = xb_add(&bar[XB_XSUB(b.x)], 1u);
        const unsigned gen = old / nloc;
        if (old + 1u == (gen + 1u) * nloc) {
            __builtin_amdgcn_fence(__ATOMIC_RELEASE, "agent");
            asm volatile("s_waitcnt vmcnt(0)" ::: "memory");
            const unsigned og = xb_add(&bar[XB_TOP], 1u);
            const unsigned tg = og / nx;
            if (og + 1u == (tg + 1u) * nx) xb_add(&bar[XB_TOPGEN], 1u);
            else XB_SPIN(xb_ld(&bar[XB_TOPGEN]) == tg, bar);
            __builtin_amdgcn_fence(__ATOMIC_ACQUIRE, "agent");
            xb_add(&bar[XB_XGEN(b.x)], 1u);
            asm volatile("s_waitcnt vmcnt(0)" ::: "memory");
        } else {
            XB_SPIN(xb_ld(&bar[XB_XGEN(b.x)]) == gen, bar);
            __builtin_amdgcn_fence(__ATOMIC_ACQUIRE, "agent");
            asm volatile("s_waitcnt vmcnt(0)" ::: "memory");
        }
    }
    __syncthreads();
}

constexpr int NWAVES = 8, NPHASE = 12;
constexpr int RING_BYTES = 131072, LDSCTL_OFF = RING_BYTES, MISC_OFF = LDSCTL_OFF + 320, LDS_BYTES = 147456;
#define LDS_WAIT() asm volatile("s_waitcnt lgkmcnt(0)" ::: "memory")
#define VM_WAIT() asm volatile("s_waitcnt vmcnt(0)" ::: "memory")

__device__ __forceinline__ void tr_item(const float* W, int K, int N, bf16* WT, int drow0, const float* gain, LAS float* scr, int k0, int n0, int lane) {
#pragma unroll 8
    for (int i = 0; i < 32; ++i) { const int kk = 2 * i + (lane >> 5); scr[kk * 33 + (lane & 31)] = W[(size_t)(k0 + kk) * N + n0 + (lane & 31)]; }
    LDS_WAIT(); asm volatile("" ::: "memory");
    const int c = lane & 7;
    float g[8];
#pragma unroll
    for (int j = 0; j < 8; ++j) g[j] = gain ? gain[k0 + 8 * c + j] : 1.0f;
#pragma unroll
    for (int j = 0; j < 4; ++j) { const int n = (lane >> 3) + 8 * j; const LAS float* s = scr + (8 * c) * 33 + n;
        v4u o; o.x = pk2(s[0 * 33] * g[0], s[1 * 33] * g[1]); o.y = pk2(s[2 * 33] * g[2], s[3 * 33] * g[3]); o.z = pk2(s[4 * 33] * g[4], s[5 * 33] * g[5]); o.w = pk2(s[6 * 33] * g[6], s[7 * 33] * g[7]);
        *(GAS v4u*)(WT + (size_t)(drow0 + n) * K + k0 + 8 * c) = o; }
    LDS_WAIT(); asm volatile("" ::: "memory");
}
__device__ __forceinline__ void row_to_bf16(const float* xrow, bf16* orow, float* ss, int lane) {
    const GAS f32x4* xr = (const GAS f32x4*)xrow + lane; float s = 0.f;
    GAS v2u* o8 = (GAS v2u*)orow + lane;
#pragma unroll
    for (int j = 0; j < 8; ++j) { const f32x4 v = xr[64 * j]; s += (v.x * v.x + v.y * v.y) + (v.z * v.z + v.w * v.w); v2u w; w.x = pk2(v.x, v.y); w.y = pk2(v.z, v.w); o8[64 * j] = w; }
    s = wave_sum(s); if (lane == 0) *ss = s;
}
__device__ __forceinline__ void p0_prologue(const P& p, LAS unsigned char* lds, int gw, int NGW, int wave, int lane) {
    LAS float* scr = (LAS float*)(lds + wave * 16384);
    unsigned char* ws = p.ws;
    for (int m = gw; m < NTOK; m += NGW) row_to_bf16(p.x + (size_t)m * DM, (bf16*)(ws + WS_XB) + (size_t)m * DM, (float*)(ws + WS_SS0) + m, lane);
    for (int m = gw; m < NMEM; m += NGW) row_to_bf16(p.mem + (size_t)m * DM, (bf16*)(ws + WS_MEMB) + (size_t)m * DM, (float*)(ws + WS_SSM) + m, lane);
    for (int i = gw * 64 + lane; i < NE * DM; i += NGW * 64) { const int e = i >> 11, k = i & 2047; ((float*)(ws + WS_W_R))[i] = p.g_ffn[k] * p.w_r[k * NE + e]; }
    constexpr int I_IN = 32 * 160, I_OUT = 32 * 64, I_CQ = 32 * 16, I_CKV = 32 * 32, I_CO = 8 * 64, I_G = 8 * 2 * 4, I_GU = 32 * 32 * 128, I_DN = 32 * 32 * 64;
    constexpr int NITEMS = I_IN + I_OUT + I_CQ + I_CKV + I_CO + 2 * I_G + I_GU + I_DN;
    for (int it = gw; it < NITEMS; it += NGW) {
        int r = it;
        if (r < I_IN)  { const int kb = r / 160, nb = r % 160; tr_item(p.w_in, DM, 5120, (bf16*)(ws + WS_W_IN), nb * 32, p.g_mix, scr, kb * 64, nb * 32, lane); continue; } r -= I_IN;
        if (r < I_OUT) { const int kb = r / 64, nb = r % 64; tr_item(p.w_out, DM, DM, (bf16*)(ws + WS_W_OUT), nb * 32, kb < 16 ? p.g_att : p.g_lru - 1024, scr, kb * 64, nb * 32, lane); continue; } r -= I_OUT;
        if (r < I_CQ)  { const int kb = r / 16, nb = r % 16; tr_item(p.w_cq, DM, XW, (bf16*)(ws + WS_W_CQ), nb * 32, p.g_cross, scr, kb * 64, nb * 32, lane); continue; } r -= I_CQ;
        if (r < I_CKV) { const int kb = r / 32, nb = r % 32; tr_item(p.w_ckv, DM, 2 * XW, (bf16*)(ws + WS_W_CKV), nb * 32, p.g_mem, scr, kb * 64, nb * 32, lane); continue; } r -= I_CKV;
        if (r < I_CO)  { const int kb = r / 64, nb = r % 64; tr_item(p.w_co, XW, DM, (bf16*)(ws + WS_W_CO), nb * 32, nullptr, scr, kb * 64, nb * 32, lane); continue; } r -= I_CO;
        if (r < I_G)   { const int n = r >> 3, kb = (r >> 2) & 1, nb = r & 3; tr_item(p.w_ga + n * 16384, LBW, LBW, (bf16*)(ws + WS_W_GA) + n * 16384, nb * 32, nullptr, scr, kb * 64, nb * 32, lane); continue; } r -= I_G;
        if (r < I_G)   { const int n = r >> 3, kb = (r >> 2) & 1, nb = r & 3; tr_item(p.w_gx + n * 16384, LBW, LBW, (bf16*)(ws + WS_W_GX) + n * 16384, nb * 32, nullptr, scr, kb * 64, nb * 32, lane); continue; } r -= I_G;
        if (r < I_GU)  { const int e = r >> 12, q = r & 4095, kb = q >> 7, nb = q & 127, n0 = nb * 32; const int c = n0 & 2047, up = n0 >> 11;
                         tr_item(p.w_gu + (size_t)e * DM * 4096, DM, 4096, (bf16*)(ws + WS_W_GU) + (size_t)e * 4096 * DM, 256 * (c >> 7) + (c & 127) + 128 * up, p.g_ffn, scr, kb * 64, n0, lane); continue; } r -= I_GU;
        { const int e = r >> 11, q = r & 2047, kb = q >> 6, nb = q & 63; tr_item(p.w_dn + (size_t)e * DFF * DM, DFF, DM, (bf16*)(ws + WS_W_DN) + (size_t)e * DM * DFF, nb * 32, nullptr, scr, kb * 64, nb * 32, lane); }
    }
}
__device__ __forceinline__ void p3_scales(const P& p, int gtid, int NT) {
    const float* ssa = (const float*)(p.ws + WS_SSA); const float* ssl = (const float*)(p.ws + WS_SSL); float* scl = (float*)(p.ws + WS_SCL);
    for (int m = gtid; m < NTOK; m += NT) { float a = 0.f, l = 0.f;
#pragma unroll
        for (int i = 0; i < 16; ++i) { a += ssa[(size_t)m * 16 + i]; l += ssl[(size_t)m * 16 + i]; }
        const float ra = rsqrtf(a * (1.0f / AW) + EPS), rl = rsqrtf(l * (1.0f / LW) + EPS);
        scl[2 * m] = ra / rl; scl[2 * m + 1] = rl; }
}
__device__ __forceinline__ void p8_router(const P& p, int gw, int NGW, int lane) {
    const float* wrt = (const float*)(p.ws + WS_W_R); const float* x2 = p.out;
    int* cnt = (int*)(p.ws + WS_CTL) + CW_CNT; int* list = (int*)(p.ws + WS_LIST);
    int* tope = (int*)(p.ws + WS_TOPE); float* topg = (float*)(p.ws + WS_TOPG); int* tpos = (int*)(p.ws + WS_TPOS); float* r2 = (float*)(p.ws + WS_R2);
    for (int m = gw; m < NTOK; m += NGW) {
        const GAS f32x4* xr = (const GAS f32x4*)(x2 + (size_t)m * DM) + lane;
        f32x4 xv[8]; float ss = 0.f;
#pragma unroll
        for (int j = 0; j < 8; ++j) { xv[j] = xr[64 * j]; ss += (xv[j].x * xv[j].x + xv[j].y * xv[j].y) + (xv[j].z * xv[j].z + xv[j].w * xv[j].w); }
        ss = wave_sum(ss); const float r = rsqrtf(ss * (1.0f / DM) + EPS);
        float mylogit = 0.f;
#pragma unroll 4
        for (int e = 0; e < NE; ++e) { const GAS f32x4* wr = (const GAS f32x4*)(wrt + (size_t)e * DM) + lane; float a = 0.f;
#pragma unroll
            for (int j = 0; j < 8; ++j) { const f32x4 w = wr[64 * j]; a += (xv[j].x * w.x + xv[j].y * w.y) + (xv[j].z * w.z + xv[j].w * w.w); }
            a = wave_sum(a); if (lane == e) mylogit = a * r + p.b_r[e]; }
        float v = lane < NE ? mylogit : -INFINITY; float tv[4]; int te[4];
#pragma unroll
        for (int k = 0; k < TOPK; ++k) { float mxv = v;
#pragma unroll
            for (int o = 1; o < 64; o <<= 1) mxv = fmaxf(mxv, __shfl_xor(mxv, o));
            const unsigned long long bal = __ballot(v == mxv); const int idx = __ffsll((long long)bal) - 1; tv[k] = mxv; te[k] = idx; if (lane == idx) v = -INFINITY; }
        const float e1 = __expf(tv[1] - tv[0]), e2 = __expf(tv[2] - tv[0]), e3 = __expf(tv[3] - tv[0]); const float inv = 1.0f / (1.0f + e1 + e2 + e3);
        if (lane < TOPK) { const int e = lane == 0 ? te[0] : lane == 1 ? te[1] : lane == 2 ? te[2] : te[3]; const float g = (lane == 0 ? 1.0f : lane == 1 ? e1 : lane == 2 ? e2 : e3) * inv;
            const int pos = atomicAdd(&cnt[e], 1); list[(size_t)e * NTOK + pos] = m; tope[m * 4 + lane] = e; topg[m * 4 + lane] = g; tpos[m * 4 + lane] = pos; }
        if (lane == 0) r2[m] = r;
    }
}
__device__ __forceinline__ void p11_combine(const P& p, int gw, int NGW, int lane) {
    const int* cnt = (const int*)(p.ws + WS_CTL) + CW_CNT; const bf16* Y = (const bf16*)(p.ws + WS_Y);
    const int* tope = (const int*)(p.ws + WS_TOPE); const float* topg = (const float*)(p.ws + WS_TOPG); const int* tpos = (const int*)(p.ws + WS_TPOS);
    int pad = lane < NE ? ((cnt[lane & 31] + 255) >> 8) : 0; int inc = pad;
#pragma unroll
    for (int o = 1; o < 32; o <<= 1) { const int t = __shfl_up(inc, o); if ((lane & 31) >= o) inc += t; }
    const int toff_l = inc - pad;
    for (int m = gw; m < NTOK; m += NGW) {
        GAS f32x4* xr = (GAS f32x4*)(p.out + (size_t)m * DM) + lane;
        f32x4 a[8];
#pragma unroll
        for (int j = 0; j < 8; ++j) a[j] = xr[64 * j];
#pragma unroll
        for (int k = 0; k < TOPK; ++k) { const int e = tope[m * 4 + k]; const float g = topg[m * 4 + k]; const int slot = 256 * __shfl(toff_l, e) + tpos[m * 4 + k];
            const GAS v2u* yr = (const GAS v2u*)(Y + (size_t)slot * DM) + lane;
#pragma unroll
            for (int j = 0; j < 8; ++j) { const v2u w = yr[64 * j]; a[j].x += g * __uint_as_float(w.x << 16); a[j].y += g * __uint_as_float(w.x & 0xffff0000u); a[j].z += g * __uint_as_float(w.y << 16); a[j].w += g * __uint_as_float(w.y & 0xffff0000u); } }
        float ss = 0.f;
#pragma unroll
        for (int j = 0; j < 8; ++j) ss += (a[j].x * a[j].x + a[j].y * a[j].y) + (a[j].z * a[j].z + a[j].w * a[j].w);
        ss = wave_sum(ss); const float r = rsqrtf(ss * (1.0f / DM) + EPS);
        const GAS f32x4* gf = (const GAS f32x4*)p.g_fin + lane;
#pragma unroll
        for (int j = 0; j < 8; ++j) { const f32x4 g = gf[64 * j]; xr[64 * j] = a[j] * r * g; }
    }
}

__global__ void __launch_bounds__(NWAVES * 64, 2) fwd(P p) {
    extern __shared__ __attribute__((aligned(16))) unsigned char lds_raw[];
    LAS unsigned char* lds = (LAS unsigned char*)lds_raw;
    volatile LAS unsigned* MISC = (volatile LAS unsigned*)(lds + MISC_OFF);
    const int tid = threadIdx.x, lane = tid & 63, wave = __builtin_amdgcn_readfirstlane(tid >> 6);
    const int G = gridDim.x, bx = blockIdx.x; const int vcu = (G % 8 == 0) ? (bx % 8) * (G / 8) + bx / 8 : bx;
    const int gw = vcu * NWAVES + wave, NGW = G * NWAVES;
    for (int u = tid; u < (LDS_BYTES - LDSCTL_OFF) / 4; u += NWAVES * 64) ((LAS unsigned*)(lds + LDSCTL_OFF))[u] = 0u;
    __syncthreads();
    unsigned* ctl = (unsigned*)(p.ws + WS_CTL);
    const int lo = p.ph_lo, hi = p.ph_hi;
    XcdBarrier bar; bar.bar = ctl + CW_BAR + p.li * XCD_BAR_WORDS; bar.x = 0; bar.st = nullptr;
    if (hi - lo > 1) bar = xcd_barrier_post(ctl + CW_BAR + p.li * XCD_BAR_WORDS, MISC + 8);
#define IN(k) (lo <= (k) && (k) < hi)
#define SEAM(k) do { if (IN(k) && IN((k) + 1)) xcd_barrier(bar); } while (0)
    if (IN(0)) { p0_prologue(p, lds, gw, NGW, wave, lane); } SEAM(0);
    if (IN(3)) { p3_scales(p, gw * 64 + lane, NGW * 64); } SEAM(3);
    if (IN(8)) { p8_router(p, gw, NGW, lane); } SEAM(8);
    if (IN(11)) { p11_combine(p, gw, NGW, lane); }
#undef IN
#undef SEAM
}

#ifndef FAST_MASK
#define FAST_MASK 0x909u
#endif
extern "C" void kernel_launch(void* const* d_in, const int* in_sizes, int n_in, void* d_out, int out_size, void* d_ws, size_t ws_size, hipStream_t stream) {
    static int grid = 0;
    if (grid == 0) {
        if (n_in != 28 || in_sizes[0] != NTOK * DM || out_size != NTOK * DM || ws_size < WS_END) { fprintf(stderr, "kernel_launch: unexpected shapes (n_in %d, ws %zu)\n", n_in, ws_size); grid = -1; return; }
        int dev = 0, cus = 0;
        if (hipGetDevice(&dev) != hipSuccess || hipDeviceGetAttribute(&cus, hipDeviceAttributeMultiprocessorCount, dev) != hipSuccess) { grid = -1; return; }
        if (hipFuncSetAttribute((const void*)fwd, hipFuncAttributeMaxDynamicSharedMemorySize, LDS_BYTES) != hipSuccess) { fprintf(stderr, "kernel_launch: hipFuncSetAttribute failed\n"); grid = -1; return; }
        int per_cu = 0; (void)hipOccupancyMaxActiveBlocksPerMultiprocessor(&per_cu, (const void*)fwd, NWAVES * 64, LDS_BYTES); (void)hipGetLastError();
        grid = cus;
    }
    if (grid < 0) return;
    (void)hipMemsetAsync((char*)d_ws + WS_CTL, 0, CTL_ZERO_BYTES, stream);
    P p{};
    const float** pp = (const float**)&p;
    for (int i = 0; i < 28; ++i) pp[i] = (const float*)d_in[i];
    p.out = (float*)d_out; p.ws = (unsigned char*)d_ws;
    unsigned char* ws = (unsigned char*)d_ws;
    bf16* QKXY = (bf16*)(ws + WS_QKXY); int* ctl = (int*)(ws + WS_CTL);
    int li = 0;
    for (int ph = 0; ph < NPHASE;) {
        if ((FAST_MASK >> ph) & 1u) { int hi = ph + 1; while (hi < NPHASE && ((FAST_MASK >> hi) & 1u)) ++hi;
            p.ph_lo = ph; p.ph_hi = hi; p.li = li++; hipLaunchKernelGGL(fwd, dim3(grid), dim3(NWAVES * 64), LDS_BYTES, stream, p); ph = hi; continue; }
        switch (ph) {
        case 1: { F1 f{}; f.A = (bf16*)(ws + WS_XB); f.Bt = (bf16*)(ws + WS_W_IN); f.ss0 = (float*)(ws + WS_SS0); f.qkxy = QKXY; f.vt = (bf16*)(ws + WS_VT);
                  hipLaunchKernelGGL(ngemm<F1>, dim3(5120 / 64, NTOK / 64), dim3(256), 0, stream, f); } break;
        case 2: { F1b f{}; f.A = (bf16*)(ws + WS_MEMB); f.Bt = (bf16*)(ws + WS_W_CKV); f.ssm = (float*)(ws + WS_SSM); f.ck = (bf16*)(ws + WS_CK); f.cvt = (bf16*)(ws + WS_CVT);
                  hipLaunchKernelGGL(ngemm<F1b>, dim3(1024 / 64, NMEM / 64), dim3(256), 0, stream, f);
                  hipLaunchKernelGGL(n_attn, dim3(BATCH * AH * 8), dim3(256), 0, stream, QKXY, (const bf16*)(ws + WS_VT), p.rel, (bf16*)(ws + WS_MIX), (float*)(ws + WS_SSA));
                  hipLaunchKernelGGL(n_lru_a, dim3(NTOK * 4), dim3(256), 0, stream, QKXY + (size_t)2 * NTOK * 1024, p.conv_w, p.conv_b, (const bf16*)(ws + WS_W_GA), p.b_ga, (const bf16*)(ws + WS_W_GX), p.b_gx, p.lam, (float*)(ws + WS_NA), (float*)(ws + WS_NB));
                  hipLaunchKernelGGL(n_lru_b, dim3(256), dim3(64), 0, stream, (const float*)(ws + WS_NA), (const float*)(ws + WS_NB), QKXY + (size_t)3 * NTOK * 1024, (bf16*)(ws + WS_MIX), (float*)(ws + WS_SSL)); } break;
        case 4: { F4 f{}; f.A = (bf16*)(ws + WS_MIX); f.Bt = (bf16*)(ws + WS_W_OUT); f.scl = (float*)(ws + WS_SCL); f.x = p.x; f.x1 = p.out; f.x1b = (bf16*)(ws + WS_X1B); f.ss1p = (float*)(ws + WS_SS1P);
                  hipLaunchKernelGGL(ngemm<F4>, dim3(DM / 64, NTOK / 64), dim3(256), 0, stream, f); } break;
        case 5: { F5 f{}; f.A = (bf16*)(ws + WS_X1B); f.Bt = (bf16*)(ws + WS_W_CQ); f.ss1p = (float*)(ws + WS_SS1P); f.cq = (bf16*)(ws + WS_CQ);
                  hipLaunchKernelGGL(ngemm<F5>, dim3(XW / 64, NTOK / 64), dim3(256), 0, stream, f); } break;
        case 6: hipLaunchKernelGGL(n_xattn, dim3(BATCH * XH * 8 * 2), dim3(256), 0, stream, (const bf16*)(ws + WS_CQ), (const bf16*)(ws + WS_CK), (const bf16*)(ws + WS_CVT), (bf16*)(ws + WS_OX)); break;
        case 7: { F7 f{}; f.A = (bf16*)(ws + WS_OX); f.Bt = (bf16*)(ws + WS_W_CO); f.x12 = p.out; f.x2b = (bf16*)(ws + WS_X2B);
                  hipLaunchKernelGGL(ngemm<F7>, dim3(DM / 64, NTOK / 64), dim3(256), 0, stream, f); } break;
        case 9: { hipLaunchKernelGGL(n_toff, dim3(1), dim3(64), 0, stream, (const int*)(ctl + CW_CNT), ctl + CW_TOFF);
                  F9 f{}; f.x2b = (bf16*)(ws + WS_X2B); f.wgu = (bf16*)(ws + WS_W_GU); f.toff = ctl + CW_TOFF; f.cnt = ctl + CW_CNT; f.list = (int*)(ws + WS_LIST); f.r2 = (float*)(ws + WS_R2); f.b_gu = p.b_gu; f.act = (bf16*)(ws + WS_ACT);
                  hipLaunchKernelGGL(ngemm<F9>, dim3(DFF / 32, NSLOT / 64), dim3(256), 0, stream, f); } break;
        case 10: { hipLaunchKernelGGL(n_toff, dim3(1), dim3(64), 0, stream, (const int*)(ctl + CW_CNT), ctl + CW_TOFF);
                  F10 f{}; f.act = (bf16*)(ws + WS_ACT); f.wdn = (bf16*)(ws + WS_W_DN); f.toff = ctl + CW_TOFF; f.b_dn = p.b_dn; f.y = (bf16*)(ws + WS_Y);
                  hipLaunchKernelGGL(ngemm<F10>, dim3(DM / 64, NSLOT / 64), dim3(256), 0, stream, f); } break;
        default: break;
        }
        ++ph;
    }
}
```

```cpp
#include <hip/hip_runtime.h>
#include <cstdio>
#include <cstdint>
#include <cmath>

#define GAS __attribute__((address_space(1)))
#define LAS __attribute__((address_space(3)))
typedef unsigned short bf16;
typedef unsigned v4u __attribute__((ext_vector_type(4)));
typedef unsigned v2u __attribute__((ext_vector_type(2)));
typedef float f32x4 __attribute__((ext_vector_type(4)));
typedef float f32x2 __attribute__((ext_vector_type(2)));
typedef float f32x16 __attribute__((ext_vector_type(16)));
typedef short bf16x8 __attribute__((ext_vector_type(8)));

constexpr int BATCH = 16, SEQ = 2048, DM = 2048, NTOK = BATCH * SEQ;
constexpr int CHUNK = 64, LEFTC = 8, AW = 1024, AH = 16, AHD = 64, MAXREL = 128, RELW = 2 * MAXREL + 1;
constexpr int LW = 1024, LB = 8, LBW = 128;
constexpr int MEML = 256, NMEM = BATCH * MEML, XH = 4, XHD = 128, XW = 512;
constexpr int NE = 32, TOPK = 4, DFF = 2048;
constexpr int NSLOT = NTOK * TOPK + NE * 256;
constexpr float EPS = 1e-6f, LOG2E = 1.4426950408889634f;
constexpr float QSCALE = 0.125f * LOG2E;
constexpr float CQSCALE = 0.08838834764831845f * LOG2E;
constexpr float SW_ALPHA = 1.702f, SW_LIMIT = 7.0f;

constexpr size_t MiB = 1u << 20;
constexpr size_t WS_CTL = 0, CTL_ZERO_BYTES = 1 * MiB;
constexpr size_t WS_W_IN = 2 * MiB, WS_W_OUT = 22 * MiB, WS_W_CQ = 30 * MiB, WS_W_CKV = 32 * MiB, WS_W_CO = 36 * MiB;
constexpr size_t WS_W_GA = 38 * MiB, WS_W_GX = WS_W_GA + 256 * 1024, WS_W_R = WS_W_GX + 256 * 1024;
constexpr size_t WS_SS0 = 39 * MiB, WS_SSM = WS_SS0 + 128 * 1024, WS_R2 = WS_SS0 + 256 * 1024;
constexpr size_t WS_SSA = 40 * MiB, WS_SSL = 42 * MiB, WS_SCL = 44 * MiB, WS_SS1P = 45 * MiB;
constexpr size_t WS_TOPE = 49 * MiB, WS_TOPG = WS_TOPE + 512 * 1024, WS_TPOS = 50 * MiB;
constexpr size_t WS_LIST = 51 * MiB, WS_CK = 55 * MiB, WS_CVT = 59 * MiB, WS_MEMB = 64 * MiB;
constexpr size_t WS_W_GU = 128 * MiB, WS_W_DN = 640 * MiB;
constexpr size_t WS_XB = 896 * MiB, WS_MIX = WS_XB;
constexpr size_t WS_QKXY = 1024 * MiB, WS_VT = 1280 * MiB, WS_X1B = 1344 * MiB, WS_CQ = 1472 * MiB, WS_OX = 1504 * MiB, WS_X2B = 1536 * MiB;
constexpr size_t WS_ACT = 1664 * MiB, WS_Y = 2208 * MiB, WS_NA = 2752 * MiB, WS_NB = 2880 * MiB, WS_END = 3008 * MiB;
constexpr int CW_CNT = 64;
constexpr int CW_TOFF = 128;
constexpr int CW_BAR = 4096;

struct P {
    const float *x, *mem, *g_mix, *w_in, *rel, *conv_w, *conv_b, *w_ga, *b_ga, *w_gx, *b_gx, *lam, *g_att, *g_lru, *w_out, *g_cross, *g_mem,
        *w_cq, *w_ckv, *w_co, *g_ffn, *w_r, *b_r, *w_gu, *b_gu, *w_dn, *b_dn, *g_fin;
    float* out; unsigned char* ws;
    int ph_lo, ph_hi, li, pad;
};

__device__ __forceinline__ float bf2f(bf16 b) { return __uint_as_float(((unsigned)b) << 16); }
__device__ __forceinline__ unsigned f2bf(float f) { unsigned u = __float_as_uint(f); return (u + 0x7fffu + ((u >> 16) & 1u)) >> 16; }
__device__ __forceinline__ unsigned pk2(float lo, float hi) { return f2bf(lo) | (f2bf(hi) << 16); }
__device__ __forceinline__ float wave_sum(float v) {
#pragma unroll
    for (int o = 1; o < 64; o <<= 1) v += __shfl_xor(v, o);
    return v;
}
__device__ __forceinline__ float sigmoidf_(float x) { return 1.0f / (1.0f + __expf(-x)); }
__device__ __forceinline__ float gelu_tanh(float x) { const float u = 0.7978845608028654f * (x + 0.044715f * x * x * x); return 0.5f * x * (1.0f + tanhf(u)); }
__device__ __forceinline__ int find_expert(const int* toff, int tile) { int e = 0;
#pragma unroll 1
    for (int i = 1; i < NE; ++i) e += (tile >= toff[i]) ? 1 : 0;
    return e; }

template <class F>
__global__ void __launch_bounds__(256) ngemm(F f) {
    __shared__ float As[16][68], Bs[16][68];
    const int tx = threadIdx.x & 15, ty = threadIdx.x >> 4, bm = blockIdx.y, bn = blockIdx.x;
    if (!f.valid(bm)) return;
    const int lr = threadIdx.x >> 2, lk = (threadIdx.x & 3) * 4;
    const bf16* ap = f.aptr(bm * 64 + lr);
    const bf16* bp = f.bptr(bm, bn, lr);
    float acc[4][4];
#pragma unroll
    for (int i = 0; i < 4; ++i)
#pragma unroll
        for (int j = 0; j < 4; ++j) acc[i][j] = 0.f;
    for (int k0 = 0; k0 < F::K; k0 += 16) {
        f.mid(k0, bm, ty, acc);
        const v2u av = *(const v2u*)(ap + k0 + lk), bv = *(const v2u*)(bp + k0 + lk);
        As[lk + 0][lr] = __uint_as_float(av.x << 16); As[lk + 1][lr] = __uint_as_float(av.x & 0xffff0000u);
        As[lk + 2][lr] = __uint_as_float(av.y << 16); As[lk + 3][lr] = __uint_as_float(av.y & 0xffff0000u);
        Bs[lk + 0][lr] = __uint_as_float(bv.x << 16); Bs[lk + 1][lr] = __uint_as_float(bv.x & 0xffff0000u);
        Bs[lk + 2][lr] = __uint_as_float(bv.y << 16); Bs[lk + 3][lr] = __uint_as_float(bv.y & 0xffff0000u);
        __syncthreads();
#pragma unroll
        for (int kk = 0; kk < 16; ++kk) {
            const f32x4 a = *(const f32x4*)&As[kk][ty * 4], b = *(const f32x4*)&Bs[kk][tx * 4];
#pragma unroll
            for (int i = 0; i < 4; ++i)
#pragma unroll
                for (int j = 0; j < 4; ++j) acc[i][j] += a[i] * b[j];
        }
        __syncthreads();
    }
    f.out(bm, bn, ty, tx, acc);
}
struct FBase {
    __device__ bool valid(int) const { return true; }
    __device__ void mid(int, int, int, float (&)[4][4]) const {}
};
struct F1 : FBase { static constexpr int K = 2048; const bf16* A; const bf16* Bt; const float* ss0; bf16* qkxy; bf16* vt;
    __device__ const bf16* aptr(int row) const { return A + (size_t)row * K; }
    __device__ const bf16* bptr(int, int bn, int j) const { return Bt + (size_t)(bn * 64 + j) * K; }
    __device__ void out(int bm, int bn, int ty, int tx, float (&acc)[4][4]) const {
        for (int i = 0; i < 4; ++i) { const int m = bm * 64 + ty * 4 + i; const float r0 = rsqrtf(ss0[m] * (1.0f / DM) + EPS);
            for (int j = 0; j < 4; ++j) { const int n = bn * 64 + tx * 4 + j, t = n >> 10, c = n & 1023; float v = acc[i][j] * r0;
                if (t == 2) vt[(size_t)c * NTOK + m] = (bf16)f2bf(v);
                else { const int slot = t < 2 ? t : t - 1; if (t == 0) v *= QSCALE; qkxy[(size_t)slot * NTOK * 1024 + (size_t)m * 1024 + c] = (bf16)f2bf(v); } } }
    }
};
struct F1b : FBase { static constexpr int K = 2048; const bf16* A; const bf16* Bt; const float* ssm; bf16* ck; bf16* cvt;
    __device__ const bf16* aptr(int row) const { return A + (size_t)row * K; }
    __device__ const bf16* bptr(int, int bn, int j) const { return Bt + (size_t)(bn * 64 + j) * K; }
    __device__ void out(int bm, int bn, int ty, int tx, float (&acc)[4][4]) const {
        for (int i = 0; i < 4; ++i) { const int m = bm * 64 + ty * 4 + i; const float r = rsqrtf(ssm[m] * (1.0f / DM) + EPS);
            for (int j = 0; j < 4; ++j) { const int n = bn * 64 + tx * 4 + j; const float v = acc[i][j] * r;
                if (n < XW) ck[(size_t)m * XW + n] = (bf16)f2bf(v); else cvt[(size_t)(n - XW) * NMEM + m] = (bf16)f2bf(v); } }
    }
};
struct F4 : FBase { static constexpr int K = 2048; const bf16* A; const bf16* Bt; const float* scl; const float* x; float* x1; bf16* x1b; float* ss1p;
    __device__ const bf16* aptr(int row) const { return A + (size_t)row * K; }
    __device__ const bf16* bptr(int, int bn, int j) const { return Bt + (size_t)(bn * 64 + j) * K; }
    __device__ void mid(int k0, int bm, int ty, float (&acc)[4][4]) const { if (k0 == 1024) { for (int i = 0; i < 4; ++i) { const float s = scl[2 * (bm * 64 + ty * 4 + i)]; for (int j = 0; j < 4; ++j) acc[i][j] *= s; } } }
    __device__ void out(int bm, int bn, int ty, int tx, float (&acc)[4][4]) const {
        for (int i = 0; i < 4; ++i) { const int m = bm * 64 + ty * 4 + i; const float s = scl[2 * m + 1]; float q = 0.f;
            for (int j = 0; j < 4; ++j) { const int n = bn * 64 + tx * 4 + j; const float v = x[(size_t)m * DM + n] + acc[i][j] * s; x1[(size_t)m * DM + n] = v; x1b[(size_t)m * DM + n] = (bf16)f2bf(v); q += v * v; }
            q += __shfl_xor(q, 1); q += __shfl_xor(q, 2); q += __shfl_xor(q, 4); q += __shfl_xor(q, 8);
            if (tx == 0) ss1p[(size_t)m * 32 + bn] = q; }
    }
};
struct F5 : FBase { static constexpr int K = 2048; const bf16* A; const bf16* Bt; const float* ss1p; bf16* cq;
    __device__ const bf16* aptr(int row) const { return A + (size_t)row * K; }
    __device__ const bf16* bptr(int, int bn, int j) const { return Bt + (size_t)(bn * 64 + j) * K; }
    __device__ void out(int bm, int bn, int ty, int tx, float (&acc)[4][4]) const {
        for (int i = 0; i < 4; ++i) { const int m = bm * 64 + ty * 4 + i; float q = 0.f; for (int p = 0; p < 32; ++p) q += ss1p[(size_t)m * 32 + p];
            const float r1 = rsqrtf(q * (1.0f / DM) + EPS) * CQSCALE;
            for (int j = 0; j < 4; ++j) { const int n = bn * 64 + tx * 4 + j; cq[(size_t)m * XW + n] = (bf16)f2bf(acc[i][j] * r1); } }
    }
};
struct F7 : FBase { static constexpr int K = 512; const bf16* A; const bf16* Bt; float* x12; bf16* x2b;
    __device__ const bf16* aptr(int row) const { return A + (size_t)row * K; }
    __device__ const bf16* bptr(int, int bn, int j) const { return Bt + (size_t)(bn * 64 + j) * K; }
    __device__ void out(int bm, int bn, int ty, int tx, float (&acc)[4][4]) const {
        for (int i = 0; i < 4; ++i) { const int m = bm * 64 + ty * 4 + i;
            for (int j = 0; j < 4; ++j) { const int n = bn * 64 + tx * 4 + j; const float v = x12[(size_t)m * DM + n] + acc[i][j]; x12[(size_t)m * DM + n] = v; x2b[(size_t)m * DM + n] = (bf16)f2bf(v); } }
    }
};
struct F9 { static constexpr int K = 2048; const bf16* x2b; const bf16* wgu; const int* toff; const int* cnt; const int* list; const float* r2; const float* b_gu; bf16* act;
    __device__ bool valid(int bm) const { return (bm >> 2) < toff[NE]; }
    __device__ void mid(int, int, int, float (&)[4][4]) const {}
    __device__ int tok_of(int slot, int& e) const { const int tile = slot >> 8; e = find_expert(toff, tile); const int pos = slot - 256 * toff[e]; return pos < cnt[e] ? list[e * NTOK + pos] : 0; }
    __device__ const bf16* aptr(int slot) const { int e; const int tok = tok_of(slot, e); return x2b + (size_t)tok * K; }
    __device__ const bf16* bptr(int bm, int bn, int j) const { const int e = find_expert(toff, bm >> 2); const int a = bn * 32 + (j >> 2) * 2 + (j & 1), up = (j >> 1) & 1;
        const int row = 256 * (a >> 7) + (a & 127) + 128 * up; return wgu + ((size_t)e * 4096 + row) * K; }
    __device__ void out(int bm, int bn, int ty, int tx, float (&acc)[4][4]) const {
        for (int i = 0; i < 4; ++i) { const int slot = bm * 64 + ty * 4 + i; int e; const int tok = tok_of(slot, e); const float r = r2[tok];
            for (int j = 0; j < 2; ++j) { const int a = bn * 32 + tx * 2 + j;
                float g = acc[i][j] * r + b_gu[e * 4096 + a], u = acc[i][2 + j] * r + b_gu[e * 4096 + 2048 + a];
                g = fminf(g, SW_LIMIT); u = fminf(fmaxf(u, -SW_LIMIT), SW_LIMIT);
                act[(size_t)slot * DFF + a] = (bf16)f2bf((u + 1.0f) * g * sigmoidf_(SW_ALPHA * g)); } }
    }
};
struct F10 { static constexpr int K = 2048; const bf16* act; const bf16* wdn; const int* toff; const float* b_dn; bf16* y;
    __device__ bool valid(int bm) const { return (bm >> 2) < toff[NE]; }
    __device__ void mid(int, int, int, float (&)[4][4]) const {}
    __device__ const bf16* aptr(int slot) const { return act + (size_t)slot * K; }
    __device__ const bf16* bptr(int bm, int bn, int j) const { const int e = find_expert(toff, bm >> 2); return wdn + ((size_t)e * DM + bn * 64 + j) * K; }
    __device__ void out(int bm, int bn, int ty, int tx, float (&acc)[4][4]) const { const int e = find_expert(toff, bm >> 2);
        for (int i = 0; i < 4; ++i) { const int slot = bm * 64 + ty * 4 + i;
            for (int j = 0; j < 4; ++j) { const int n = bn * 64 + tx * 4 + j; y[(size_t)slot * DM + n] = (bf16)f2bf(acc[i][j] + b_dn[e * DM + n]); } }
    }
};

__global__ void __launch_bounds__(256) n_attn(const bf16* __restrict__ qkxy, const bf16* __restrict__ vt, const float* __restrict__ rel, bf16* mix, float* ssa) {
    const int blk = blockIdx.x, tq = (blk & 7) * 256 + threadIdx.x, bh = blk >> 3, h = bh & 15, b = bh >> 4;
    const size_t m = (size_t)b * SEQ + tq;
    const bf16* Q = qkxy; const bf16* Kp = qkxy + (size_t)NTOK * 1024;
    float q[64], o[64];
#pragma unroll
    for (int d = 0; d < 64; ++d) { q[d] = bf2f(Q[m * 1024 + h * 64 + d]); o[d] = 0.f; }
    float mx = -INFINITY, l = 0.f;
    const int c = tq >> 6, k0 = (c > LEFTC ? c - LEFTC : 0) * 64, k1 = (c + 1) * 64;
    const float* tab = rel + h * RELW;
    for (int key = k0; key < k1; ++key) {
        const bf16* kr = Kp + ((size_t)b * SEQ + key) * 1024 + h * 64;
        float s = 0.f;
#pragma unroll
        for (int d = 0; d < 64; ++d) s += q[d] * bf2f(kr[d]);
        int r = tq - key; r = (r < -MAXREL ? -MAXREL : (r > MAXREL ? MAXREL : r)) + MAXREL;
        s += tab[r] * LOG2E;
        const float mn = fmaxf(mx, s), corr = exp2f(mx - mn), pe = exp2f(s - mn);
        l = l * corr + pe;
        const bf16* vp = vt + (size_t)(h * 64) * NTOK + (size_t)b * SEQ + key;
#pragma unroll
        for (int d = 0; d < 64; ++d) o[d] = o[d] * corr + pe * bf2f(vp[(size_t)d * NTOK]);
        mx = mn;
    }
    const float il = 1.0f / l; float ss = 0.f;
#pragma unroll
    for (int d = 0; d < 64; ++d) { const float v = o[d] * il; ss += v * v; mix[m * DM + h * 64 + d] = (bf16)f2bf(v); }
    ssa[m * 16 + h] = ss;
}
__global__ void __launch_bounds__(256) n_xattn(const bf16* __restrict__ cq, const bf16* __restrict__ ck, const bf16* __restrict__ cvt, bf16* ox) {
    const int blk = blockIdx.x, dh = blk & 1, tq = ((blk >> 1) & 7) * 256 + threadIdx.x, bh = blk >> 4, h = bh & 3, b = bh >> 2;
    const size_t m = (size_t)b * SEQ + tq;
    float q[128], o[64];
#pragma unroll
    for (int d = 0; d < 128; ++d) q[d] = bf2f(cq[m * XW + h * XHD + d]);
#pragma unroll
    for (int d = 0; d < 64; ++d) o[d] = 0.f;
    float mx = -INFINITY, l = 0.f;
    for (int key = 0; key < MEML; ++key) {
        const bf16* kr = ck + ((size_t)b * MEML + key) * XW + h * XHD;
        float s = 0.f;
#pragma unroll
        for (int d = 0; d < 128; ++d) s += q[d] * bf2f(kr[d]);
        const float mn = fmaxf(mx, s), corr = exp2f(mx - mn), pe = exp2f(s - mn);
        l = l * corr + pe;
        const bf16* vp = cvt + (size_t)(h * XHD + dh * 64) * NMEM + (size_t)b * MEML + key;
#pragma unroll
        for (int d = 0; d < 64; ++d) o[d] = o[d] * corr + pe * bf2f(vp[(size_t)d * NMEM]);
        mx = mn;
    }
    const float il = 1.0f / l;
#pragma unroll
    for (int d = 0; d < 64; ++d) ox[m * XW + h * XHD + dh * 64 + d] = (bf16)f2bf(o[d] * il);
}
__global__ void __launch_bounds__(256) n_lru_a(const bf16* __restrict__ xr, const float* __restrict__ conv_w, const float* __restrict__ conv_b, const bf16* __restrict__ wga_t, const float* __restrict__ b_ga,
                                              const bf16* __restrict__ wgx_t, const float* __restrict__ b_gx, const float* __restrict__ lam, float* na, float* nb) {
    const size_t idx = (size_t)blockIdx.x * 256 + threadIdx.x; const int c = (int)(idx & 1023); const size_t m = idx >> 10; const int t = (int)(m & (SEQ - 1)), n = c >> 7, d = c & 127;
    float rp = b_ga[c], ip = b_gx[c], xown = 0.f;
    const bf16* wa = wga_t + (size_t)(n * 128 + d) * 128; const bf16* wx = wgx_t + (size_t)(n * 128 + d) * 128;
    for (int cp = 0; cp < 128; ++cp) { const int cc = n * 128 + cp; float xc = conv_b[cc];
#pragma unroll
        for (int j = 0; j < 4; ++j) { const int tt = t - 3 + j; if (tt >= 0) xc += conv_w[j * LW + cc] * bf2f(xr[(m - 3 + j) * 1024 + cc]); }
        rp += xc * bf2f(wa[cp]); ip += xc * bf2f(wx[cp]); if (cp == d) xown = xc; }
    const float r = sigmoidf_(rp), ig = sigmoidf_(ip);
    const float la = -8.0f * r * log1pf(__expf(-lam[c]));
    na[idx] = __expf(la); nb[idx] = sqrtf(-expm1f(2.0f * la)) * (ig * xown);
}
__global__ void __launch_bounds__(64) n_lru_b(const float* __restrict__ na, const float* __restrict__ nb, const bf16* __restrict__ yg, bf16* mix, float* ssl) {
    const int b = blockIdx.x >> 4, g = blockIdx.x & 15, c = g * 64 + threadIdx.x; float h = 0.f;
    for (int t = 0; t < SEQ; ++t) { const size_t m = (size_t)b * SEQ + t; h = na[m * 1024 + c] * h + nb[m * 1024 + c];
        const float y = h * gelu_tanh(bf2f(yg[m * 1024 + c])); mix[m * DM + 1024 + c] = (bf16)f2bf(y);
        const float s = wave_sum(y * y); if (threadIdx.x == 0) ssl[m * 16 + g] = s; }
}
__global__ void n_toff(const int* cnt, int* toff) { if (threadIdx.x == 0 && blockIdx.x == 0) { int a = 0; for (int e = 0; e < NE; ++e) { toff[e] = a; a += (cnt[e] + 255) >> 8; } toff[NE] = a; } }

#define XB_TMO      128
#define XB_XCNT(j)  (256  + 64 * (j))
#define XB_XSUB(j)  (1280 + 64 * (j))
#define XB_XGEN(j)  (2304 + 64 * (j))
#define XB_TOP      3328
#define XB_TOPGEN   3392
#define XCD_BAR_WORDS 3456
#define XB_SPIN_CAP (1u << 18)
__device__ __forceinline__ unsigned xb_ld(unsigned* p)              { return __hip_atomic_load(p, __ATOMIC_RELAXED, __HIP_MEMORY_SCOPE_AGENT); }
__device__ __forceinline__ unsigned xb_add(unsigned* p, unsigned v) { return __hip_atomic_fetch_add(p, v, __ATOMIC_RELAXED, __HIP_MEMORY_SCOPE_AGENT); }
__device__ __forceinline__ unsigned xb_xcc_id() { return (unsigned)__builtin_amdgcn_s_getreg((3 << 11) | 20) & 0xFu; }
#define XB_SPIN(cond, bar) do { unsigned _sp = 0; while (cond) { __builtin_amdgcn_s_sleep(1); \
    if ((++_sp & 255u) == 0u) { if (xb_ld(&(bar)[XB_TMO])) break; if (_sp > XB_SPIN_CAP) { atomicAdd(&(bar)[XB_TMO], 1u); break; } } } } while (0)
struct XcdBarrier { unsigned* bar; unsigned x; volatile LAS unsigned* st; };
__device__ __forceinline__ XcdBarrier xcd_barrier_post(unsigned* bar, volatile LAS unsigned* st) {
    XcdBarrier b; b.bar = bar; b.x = xb_xcc_id(); b.st = st;
    if (threadIdx.x == 0) (void)xb_add(&bar[XB_XCNT(b.x)], 1u);
    return b;
}
__device__ __forceinline__ void xcd_barrier_complete(unsigned* bar, unsigned x, unsigned& nloc, unsigned& nx) {
    const unsigned G = gridDim.x * gridDim.y * gridDim.z;
    unsigned sum, cnt, mine, sp = 0u;
    for (;;) {
        sum = 0u; cnt = 0u; mine = 0u;
#pragma unroll
        for (unsigned j = 0; j < 16; ++j) { const unsigned c = xb_ld(&bar[XB_XCNT(j)]); sum += c; cnt += (c > 0u) ? 1u : 0u; mine = (j == x) ? c : mine; }
        if (sum == G) break;
        __builtin_amdgcn_s_sleep(1);
        if ((++sp & 255u) == 0u) { if (xb_ld(&bar[XB_TMO])) break; if (sp > XB_SPIN_CAP) { atomicAdd(&bar[XB_TMO], 1u); break; } }
    }
    nloc = mine > 0u ? mine : 1u; nx = cnt > 0u ? cnt : 1u;
}
__device__ __forceinline__ void xcd_barrier(const XcdBarrier& b) {
    asm volatile("s_waitcnt vmcnt(0)" ::: "memory");
    __syncthreads();
    if (threadIdx.x == 0) {
        unsigned* bar = b.bar;
        __builtin_amdgcn_s_waitcnt(0);
        unsigned nloc = b.st[0], nx = b.st[1];
        if (nloc == 0u) { xcd_barrier_complete(bar, b.x, nloc, nx); b.st[0] = nloc; b.st[1] = nx; }
        const unsigned old = xb_add(&bar[XB_XSUB(b.x)], 1u);
        const unsigned gen = old / nloc;
        if (old + 1u == (gen + 1u) * nloc) {
            __builtin_amdgcn_fence(__ATOMIC_RELEASE, "agent");
            asm volatile("s_waitcnt vmcnt(0)" ::: "memory");
            const unsigned og = xb_add(&bar[XB_TOP], 1u);
            const unsigned tg = og / nx;
            if (og + 1u == (tg + 1u) * nx) xb_add(&bar[XB_TOPGEN], 1u);
            else XB_SPIN(xb_ld(&bar[XB_TOPGEN]) == tg, bar);
            __builtin_amdgcn_fence(__ATOMIC_ACQUIRE, "agent");
            xb_add(&bar[XB_XGEN(b.x)], 1u);
            asm volatile("s_waitcnt vmcnt(0)" ::: "memory");
        } else {
            XB_SPIN(xb_ld(&bar[XB_XGEN(b.x)]) == gen, bar);
            __builtin_amdgcn_fence(__ATOMIC_ACQUIRE, "agent");
            asm volatile("s_waitcnt vmcnt(0)" ::: "memory");
        }
    }
    __syncthreads();
}

namespace pg8 {
constexpr int BM = 256, BK = 64, HALF = 128, HTB = HALF * BK * 2, STAGE_BYTES = 8 * HTB;
__host__ __device__ __forceinline__ int lds_byte(int r, int c) { const int st = (r >> 4) * 2 + (c >> 5), rr = r & 15, cc = c & 31, ob = rr * 64 + cc * 2; return st * 1024 + (ob ^ (((ob >> 9) & 1) << 5)); }
__host__ __device__ __forceinline__ void stage_rc(int b, int& R, int& C) { const int st = b / 1024, sb = b % 1024, swz = sb ^ (((sb >> 9) & 1) << 5); R = (st >> 1) * 16 + swz / 64; C = (st & 1) * 32 + (swz % 64) / 2; }
__host__ __device__ __forceinline__ int perm32(int rho) { const int n = rho >> 4, i = rho & 15; return 8 * (i >> 2) + 4 * n + (i & 3); }
__device__ __forceinline__ unsigned cvt_pk_bf16(float lo, float hi) { unsigned r; asm volatile("v_cvt_pk_bf16_f32 %0, %1, %2" : "=v"(r) : "v"(lo), "v"(hi)); return r; }
struct Unit { const char* a; const char* b; int pm, pn, e, tl; };
typedef f32x4 Acc[2][2][4][2];
template <class Epi, class Sched>
__device__ __forceinline__ void gemm_phase(LAS unsigned char* lds, const int K, const Sched& S, const Epi& E) {
    const int tid = threadIdx.x, wid = __builtin_amdgcn_readfirstlane(tid >> 6), lane = tid & 63, wr = wid >> 2, wc = wid & 3, fr = lane & 15, fq = lane >> 4;
    const int nt = K / BK;
    unsigned voffA[2], voffB[2];
#pragma unroll
    for (int i = 0; i < 2; ++i) { int R, C; stage_rc(tid * 16 + i * 8192, R, C); const int Rb = Epi::PERM ? ((R & ~31) + perm32(R & 31)) : R;
        voffA[i] = Sched::GATHER ? (unsigned)(C * 2) : (unsigned)(R * K + C) * 2u; voffB[i] = (unsigned)(Rb * K + C) * 2u; }
    const size_t kstep = (size_t)(BK * 2);
    const size_t hstep = (size_t)HALF * K * 2;
    const unsigned ldsw = (unsigned)wid * 1024u;
    const int aoff = lds_byte(wr * 64 + fr, fq * 8), boff = lds_byte(wc * 32 + fr, fq * 8);
#define PG8_SA(b, h) (((b) * 2 + (h)) * HTB)
#define PG8_SB(b, h) ((4 + (b) * 2 + (h)) * HTB)
#define PG8_STAGE(bufoff, gbase, voff) do { _Pragma("unroll") for (int _i = 0; _i < 2; ++_i) \
        __builtin_amdgcn_global_load_lds((const unsigned*)((const char*)(gbase) + (voff)[_i]), (LAS unsigned*)(lds + (bufoff) + ldsw + _i * 8192), 16, 0, 0); } while (0)
#define PG8_STAGE_A(bufoff, gbase, h, go) do { if constexpr (Sched::GATHER) { PG8_STAGE(bufoff, gbase, go[h]); } else { PG8_STAGE(bufoff, (gbase) + (h) * hstep, voffA); } } while (0)
#define PG8_LDA(dst, b, h) do { _Pragma("unroll") for (int m = 0; m < 4; ++m) _Pragma("unroll") for (int k = 0; k < 2; ++k) dst[m][k] = *(const LAS bf16x8*)(lds + PG8_SA(b, h) + aoff + m * 2048 + k * 1024); } while (0)
#define PG8_LDB(dst, b, h) do { _Pragma("unroll") for (int n = 0; n < 2; ++n) _Pragma("unroll") for (int k = 0; k < 2; ++k) dst[n][k] = *(const LAS bf16x8*)(lds + PG8_SB(b, h) + boff + n * 2048 + k * 1024); } while (0)
#define PG8_MMA(ai, bj, At, Bt) do { __builtin_amdgcn_s_setprio(1); _Pragma("unroll") for (int m = 0; m < 4; ++m) _Pragma("unroll") for (int n = 0; n < 2; ++n) _Pragma("unroll") for (int k = 0; k < 2; ++k) \
        acc[ai][bj][m][n] = __builtin_amdgcn_mfma_f32_16x16x32_bf16(Bt[n][k], At[m][k], acc[ai][bj][m][n], 0, 0, 0); __builtin_amdgcn_s_setprio(0); } while (0)
#define PG8_WAIT_V(n) asm volatile("s_waitcnt vmcnt(" #n ")" ::: "memory")
#define PG8_WAIT_L(n) asm volatile("s_waitcnt lgkmcnt(" #n ")" ::: "memory")
#define PG8_BAR __builtin_amdgcn_s_barrier()
#define PG8_SCHED __builtin_amdgcn_sched_barrier(0)
    Unit cur, nxt; int ui = 0;
    if (!S.next(0, cur)) return;
    Acc acc;
#pragma unroll
    for (int a = 0; a < 2; ++a)
#pragma unroll
        for (int b = 0; b < 2; ++b)
#pragma unroll
            for (int m = 0; m < 4; ++m)
#pragma unroll
                for (int n = 0; n < 2; ++n) acc[a][b][m][n] = (f32x4){0.f, 0.f, 0.f, 0.f};
    bf16x8 At[4][2], B0[2][2], B1[2][2];
    const char* cA = cur.a; const char* cB = cur.b;
    unsigned gc[2][2], gn[2][2];
    if constexpr (Sched::GATHER) { S.gather(cur, voffA, gc); }
    PG8_STAGE(PG8_SB(0, 0), cB, voffB); PG8_STAGE(PG8_SB(0, 1), cB + hstep, voffB); PG8_STAGE_A(PG8_SA(0, 0), cA, 0, gc); PG8_STAGE_A(PG8_SA(0, 1), cA, 1, gc);
    if (wr == 1) PG8_BAR;
    PG8_WAIT_V(2); PG8_BAR;
    PG8_STAGE(PG8_SB(1, 0), cB + kstep, voffB); PG8_STAGE_A(PG8_SA(1, 0), cA + kstep, 0, gc); PG8_STAGE(PG8_SB(1, 1), cB + hstep + kstep, voffB);
    PG8_WAIT_V(6); PG8_BAR;
    for (;;) {
        const bool has_next = S.next(ui + 1, nxt);
        const char* nA = has_next ? nxt.a : cA; const char* nB = has_next ? nxt.b : cB;
        if constexpr (Sched::GATHER) { if (has_next) S.gather(nxt, voffA, gn); else {
#pragma unroll
            for (int h = 0; h < 2; ++h)
#pragma unroll
                for (int i = 0; i < 2; ++i) gn[h][i] = gc[h][i]; } }
        for (int t = 0; t < nt; t += 2) {
            const bool last = (t == nt - 2);
            if constexpr (Epi::MIDK) { if (t == nt / 2) E.midk(acc, cur, wr, fr); }
            const char* a1 = cA + (size_t)(t + 1) * kstep;
            const char* a2 = last ? nA : cA + (size_t)(t + 2) * kstep; const char* b2 = last ? nB : cB + (size_t)(t + 2) * kstep;
            const char* a3 = a2 + kstep; const char* b3 = b2 + kstep;
            unsigned g2[2][2];
            if constexpr (Sched::GATHER) {
#pragma unroll
                for (int h = 0; h < 2; ++h)
#pragma unroll
                    for (int i = 0; i < 2; ++i) g2[h][i] = last ? gn[h][i] : gc[h][i]; }
            PG8_LDB(B0, 0, 0); PG8_LDB(B1, 0, 1); PG8_SCHED; PG8_LDA(At, 0, 0); PG8_STAGE_A(PG8_SA(1, 1), a1, 1, gc);
            PG8_WAIT_V(8); PG8_WAIT_L(0); PG8_BAR; PG8_MMA(0, 0, At, B0); PG8_MMA(0, 1, At, B1); PG8_BAR; PG8_SCHED;
            PG8_LDA(At, 0, 1); PG8_STAGE(PG8_SB(0, 0), b2, voffB); PG8_STAGE(PG8_SB(0, 1), b2 + hstep, voffB); PG8_STAGE_A(PG8_SA(0, 0), a2, 0, g2);
            PG8_WAIT_V(8); PG8_WAIT_L(0); PG8_BAR; PG8_MMA(1, 0, At, B0); PG8_MMA(1, 1, At, B1); PG8_BAR; PG8_SCHED;
            PG8_LDB(B0, 1, 0); PG8_LDB(B1, 1, 1); PG8_SCHED; PG8_LDA(At, 1, 0); PG8_STAGE_A(PG8_SA(0, 1), a2, 1, g2);
            PG8_WAIT_V(8); PG8_WAIT_L(0); PG8_BAR; PG8_MMA(0, 0, At, B0); PG8_MMA(0, 1, At, B1); PG8_BAR; PG8_SCHED;
            PG8_LDA(At, 1, 1); PG8_STAGE(PG8_SB(1, 0), b3, voffB); PG8_STAGE(PG8_SB(1, 1), b3 + hstep, voffB); PG8_STAGE_A(PG8_SA(1, 0), a3, 0, g2);
            PG8_WAIT_V(8); PG8_WAIT_L(0); PG8_BAR; PG8_MMA(1, 0, At, B0); PG8_MMA(1, 1, At, B1); PG8_BAR; PG8_SCHED;
        }
        if (wr == 0) PG8_BAR;
        E(acc, cur, wr, wc, fr, fq);
        if (!has_next) break;
#pragma unroll
        for (int a = 0; a < 2; ++a)
#pragma unroll
            for (int b = 0; b < 2; ++b)
#pragma unroll
                for (int m = 0; m < 4; ++m)
#pragma unroll
                    for (int n = 0; n < 2; ++n) acc[a][b][m][n] = (f32x4){0.f, 0.f, 0.f, 0.f};
        cur = nxt; cA = nA; cB = nB; ++ui;
        if constexpr (Sched::GATHER) {
#pragma unroll
            for (int h = 0; h < 2; ++h)
#pragma unroll
                for (int i = 0; i < 2; ++i) gc[h][i] = gn[h][i]; }
        if (wr == 1) PG8_BAR;
    }
    PG8_WAIT_V(0);
    PG8_BAR;
#undef PG8_SA
#undef PG8_SB
#undef PG8_STAGE
#undef PG8_STAGE_A
#undef PG8_LDA
#undef PG8_LDB
#undef PG8_MMA
#undef PG8_WAIT_V
#undef PG8_WAIT_L
#undef PG8_BAR
#undef PG8_SCHED
}
}

namespace pg8 {
__device__ __forceinline__ void tile_of(int L, int nM, int nN, int& pm, int& pn) {
    const int nwg = nM * nN; int wgid = L; { const int q = nwg / 8, r = nwg % 8, xcd = wgid % 8, off = wgid / 8; wgid = (xcd < r ? xcd * (q + 1) : r * (q + 1) + (xcd - r) * q) + off; }
    const int nig = 8 * nN, gid = wgid / nig, fm = gid * 8, gsz = (nM - fm) < 8 ? (nM - fm) : 8;
    pm = fm + ((wgid % nig) % gsz); pn = (wgid % nig) / gsz;
}
struct SchedReg { static constexpr bool GATHER = false;
    const char* A; const char* Bt; int nM, nN, G, c, rowbytes, bskip_from, bskip_rows;
    __device__ __forceinline__ bool next(int i, Unit& u) const { const int L = i * G + c; if (L >= nM * nN) return false; tile_of(L, nM, nN, u.pm, u.pn); u.e = 0; u.tl = 0;
        u.a = A + (size_t)u.pm * 256 * rowbytes; const int brow = u.pn * 256 + (u.pn >= bskip_from ? bskip_rows : 0); u.b = Bt + (size_t)brow * rowbytes; return true; }
    __device__ __forceinline__ void gather(const Unit&, const unsigned (&)[2], unsigned (&)[2][2]) const {}
};
template <bool G_> struct SchedMoE { static constexpr bool GATHER = G_;
    const LAS int* toff; const LAS int* cnt; const int* list; const char* A; const char* Bt; int npn, brows, G, c;
    __device__ __forceinline__ bool next(int i, Unit& u) const { const int L = i * G + c; if (L >= toff[NE] * npn) return false;
        int e = 0;
#pragma unroll 1
        for (int j = 1; j < NE; ++j) e += (L >= toff[j] * npn) ? 1 : 0;
        const int t0 = toff[e], ne = toff[e + 1] - t0, Ll = L - t0 * npn, pn = Ll / ne, tl = Ll - pn * ne;
        u.pm = t0 + tl; u.pn = pn; u.e = e; u.tl = tl; u.a = GATHER ? A : A + (size_t)u.pm * 256 * 4096; u.b = Bt + ((size_t)e * brows + pn * 256) * 4096; return true; }
    __device__ __forceinline__ void gather(const Unit& u, const unsigned (&voffA)[2], unsigned (&g)[2][2]) const {
        const int ce = cnt[u.e];
#pragma unroll
        for (int i = 0; i < 2; ++i) { int R, C; stage_rc((int)threadIdx.x * 16 + i * 8192, R, C);
#pragma unroll
            for (int h = 0; h < 2; ++h) { const int pos = u.tl * 256 + h * 128 + R; const int tok = pos < ce ? list[(size_t)u.e * NTOK + pos] : 0; g[h][i] = (unsigned)tok * 4096u + voffA[i]; } }
    }
};
#define EPI_ROWS(ai, m) (u.pm * 256 + (ai) * 128 + wr * 64 + (m) * 16 + fr)
__device__ __forceinline__ v4u pack8(const f32x4 a, const f32x4 b) { v4u w; w.x = cvt_pk_bf16(a[0], a[1]); w.y = cvt_pk_bf16(a[2], a[3]); w.z = cvt_pk_bf16(b[0], b[1]); w.w = cvt_pk_bf16(b[2], b[3]); return w; }
struct EpiRowScale { static constexpr bool PERM = true, MIDK = false; const float* ss; bf16* out; int ld, split_cols; size_t split_stride; float mul0;
    __device__ __forceinline__ void operator()(const Acc& acc, const Unit& u, int wr, int wc, int fr, int fq) const {
        int colt = u.pn * 256; bf16* base = out; float mul = mul0;
        if (split_cols) { const int t = colt / split_cols; base += (size_t)t * split_stride; colt -= t * split_cols; mul = t == 0 ? mul0 : 1.0f; }
        const int col0 = colt + wc * 32 + 8 * fq;
#pragma unroll
        for (int ai = 0; ai < 2; ++ai)
#pragma unroll
            for (int m = 0; m < 4; ++m) { const int row = EPI_ROWS(ai, m); const float r = rsqrtf(ss[row] * (1.0f / DM) + EPS) * mul; bf16* rowp = base + (size_t)row * ld + col0;
#pragma unroll
                for (int bj = 0; bj < 2; ++bj) *(v4u*)(rowp + bj * 128) = pack8(acc[ai][bj][m][0] * r, acc[ai][bj][m][1] * r); }
    }
};
struct EpiColScale { static constexpr bool PERM = true, MIDK = false; const float* ss; bf16* out; size_t ld;
    __device__ __forceinline__ void operator()(const Acc& acc, const Unit& u, int wr, int wc, int fr, int fq) const {
#pragma unroll
        for (int bj = 0; bj < 2; ++bj) { const int c0 = u.pn * 256 + bj * 128 + wc * 32 + 8 * fq; f32x4 s0 = *(const f32x4*)(ss + c0), s1 = *(const f32x4*)(ss + c0 + 4);
#pragma unroll
            for (int j = 0; j < 4; ++j) { s0[j] = rsqrtf(s0[j] * (1.0f / DM) + EPS); s1[j] = rsqrtf(s1[j] * (1.0f / DM) + EPS); }
#pragma unroll
            for (int ai = 0; ai < 2; ++ai)
#pragma unroll
                for (int m = 0; m < 4; ++m) { const int row = EPI_ROWS(ai, m); *(v4u*)(out + (size_t)row * ld + c0) = pack8(acc[ai][bj][m][0] * s0, acc[ai][bj][m][1] * s1); } }
    }
};
struct EpiX1 { static constexpr bool PERM = true, MIDK = true; const float* scl; const float* x; float* x1; bf16* x1b; float* ss1p;
    __device__ __forceinline__ void midk(Acc& acc, const Unit& u, int wr, int fr) const {
#pragma unroll
        for (int ai = 0; ai < 2; ++ai)
#pragma unroll
            for (int m = 0; m < 4; ++m) { const float s = scl[2 * (size_t)EPI_ROWS(ai, m)];
#pragma unroll
                for (int bj = 0; bj < 2; ++bj) { acc[ai][bj][m][0] *= s; acc[ai][bj][m][1] *= s; } }
    }
    __device__ __forceinline__ void operator()(const Acc& acc, const Unit& u, int wr, int wc, int fr, int fq) const {
        const int col0 = u.pn * 256 + wc * 32 + 8 * fq;
#pragma unroll
        for (int ai = 0; ai < 2; ++ai)
#pragma unroll
            for (int m = 0; m < 4; ++m) { const int row = EPI_ROWS(ai, m); const float s = scl[2 * (size_t)row + 1]; const size_t off = (size_t)row * DM + col0; float q = 0.f;
#pragma unroll
                for (int bj = 0; bj < 2; ++bj) { const f32x4 xa = *(const f32x4*)(x + off + bj * 128), xb = *(const f32x4*)(x + off + bj * 128 + 4);
                    const f32x4 v0 = xa + acc[ai][bj][m][0] * s, v1 = xb + acc[ai][bj][m][1] * s;
                    *(f32x4*)(x1 + off + bj * 128) = v0; *(f32x4*)(x1 + off + bj * 128 + 4) = v1; *(v4u*)(x1b + off + bj * 128) = pack8(v0, v1);
                    q += (v0[0] * v0[0] + v0[1] * v0[1]) + (v0[2] * v0[2] + v0[3] * v0[3]) + (v1[0] * v1[0] + v1[1] * v1[1]) + (v1[2] * v1[2] + v1[3] * v1[3]); }
                q += __shfl_xor(q, 16); q += __shfl_xor(q, 32);
                if (fq == 0) ss1p[(size_t)row * 32 + u.pn * 4 + wc] = q; }
    }
};
struct EpiCQ { static constexpr bool PERM = true, MIDK = false; const float* ss1p; bf16* cq;
    __device__ __forceinline__ void operator()(const Acc& acc, const Unit& u, int wr, int wc, int fr, int fq) const {
        const int col0 = u.pn * 256 + wc * 32 + 8 * fq;
#pragma unroll
        for (int ai = 0; ai < 2; ++ai)
#pragma unroll
            for (int m = 0; m < 4; ++m) { const int row = EPI_ROWS(ai, m); const f32x4* sp = (const f32x4*)(ss1p + (size_t)row * 32); f32x4 t = sp[0];
#pragma unroll
                for (int j = 1; j < 8; ++j) t += sp[j];
                const float r = rsqrtf(((t[0] + t[1]) + (t[2] + t[3])) * (1.0f / DM) + EPS) * CQSCALE;
#pragma unroll
                for (int bj = 0; bj < 2; ++bj) *(v4u*)(cq + (size_t)row * XW + col0 + bj * 128) = pack8(acc[ai][bj][m][0] * r, acc[ai][bj][m][1] * r); }
    }
};
struct EpiX2 { static constexpr bool PERM = true, MIDK = false; float* x12; bf16* x2b;
    __device__ __forceinline__ void operator()(const Acc& acc, const Unit& u, int wr, int wc, int fr, int fq) const {
        const int col0 = u.pn * 256 + wc * 32 + 8 * fq;
#pragma unroll
        for (int ai = 0; ai < 2; ++ai)
#pragma unroll
            for (int m = 0; m < 4; ++m) { const size_t off = (size_t)EPI_ROWS(ai, m) * DM + col0;
#pragma unroll
                for (int bj = 0; bj < 2; ++bj) { const f32x4 v0 = *(const f32x4*)(x12 + off + bj * 128) + acc[ai][bj][m][0], v1 = *(const f32x4*)(x12 + off + bj * 128 + 4) + acc[ai][bj][m][1];
                    *(f32x4*)(x12 + off + bj * 128) = v0; *(f32x4*)(x12 + off + bj * 128 + 4) = v1; *(v4u*)(x2b + off + bj * 128) = pack8(v0, v1); } }
    }
};
struct EpiAct { static constexpr bool PERM = true, MIDK = false; const LAS int* cnt; const int* list; const float* r2; const float* b_gu; bf16* act;
    __device__ __forceinline__ void operator()(const Acc& acc, const Unit& u, int wr, int wc, int fr, int fq) const {
        const int cb = u.pn * 128 + wc * 32 + 8 * fq, ce = cnt[u.e];
        const float* bg = b_gu + (size_t)u.e * 4096 + cb;
        const f32x4 bg0 = *(const f32x4*)bg, bg1 = *(const f32x4*)(bg + 4), bu0 = *(const f32x4*)(bg + 2048), bu1 = *(const f32x4*)(bg + 2052);
#pragma unroll
        for (int ai = 0; ai < 2; ++ai)
#pragma unroll
            for (int m = 0; m < 4; ++m) { const int r = ai * 128 + wr * 64 + m * 16 + fr, pos = u.tl * 256 + r; const int tok = pos < ce ? list[(size_t)u.e * NTOK + pos] : 0; const float s = r2[tok];
                f32x4 g0 = acc[ai][0][m][0] * s + bg0, g1 = acc[ai][0][m][1] * s + bg1, u0 = acc[ai][1][m][0] * s + bu0, u1 = acc[ai][1][m][1] * s + bu1;
#pragma unroll
                for (int j = 0; j < 4; ++j) { float g = fminf(g0[j], SW_LIMIT), uu = fminf(fmaxf(u0[j], -SW_LIMIT), SW_LIMIT); g0[j] = (uu + 1.0f) * g * __builtin_amdgcn_rcpf(1.0f + __expf(-SW_ALPHA * g));
                    g = fminf(g1[j], SW_LIMIT); uu = fminf(fmaxf(u1[j], -SW_LIMIT), SW_LIMIT); g1[j] = (uu + 1.0f) * g * __builtin_amdgcn_rcpf(1.0f + __expf(-SW_ALPHA * g)); }
                *(v4u*)(act + (size_t)(u.pm * 256 + r) * DFF + cb) = pack8(g0, g1); }
    }
};
struct EpiY { static constexpr bool PERM = true, MIDK = false; const float* b_dn; bf16* y;
    __device__ __forceinline__ void operator()(const Acc& acc, const Unit& u, int wr, int wc, int fr, int fq) const {
        const int col0 = u.pn * 256 + wc * 32 + 8 * fq;
#pragma unroll
        for (int bj = 0; bj < 2; ++bj) { const float* bp = b_dn + (size_t)u.e * DM + col0 + bj * 128; const f32x4 b0 = *(const f32x4*)bp, b1 = *(const f32x4*)(bp + 4);
#pragma unroll
            for (int ai = 0; ai < 2; ++ai)
#pragma unroll
                for (int m = 0; m < 4; ++m) *(v4u*)(y + (size_t)EPI_ROWS(ai, m) * DM + col0 + bj * 128) = pack8(acc[ai][bj][m][0] + b0, acc[ai][bj][m][1] + b1); }
    }
};
#undef EPI_ROWS
}

#define GLDS16(gp, lp) __builtin_amdgcn_global_load_lds((const unsigned*)(gp), (LAS unsigned*)(lp), 16, 0, 0)
#define MFMA32(a, b, c) __builtin_amdgcn_mfma_f32_32x32x16_bf16((a), (b), (c), 0, 0, 0)
#define MFMA16(a, b, c) __builtin_amdgcn_mfma_f32_16x16x32_bf16((a), (b), (c), 0, 0, 0)
__device__ __forceinline__ bf16x8 pack_p(const f32x16& p, int s) {
    v4u w; w.x = pg8::cvt_pk_bf16(p[8 * s + 0], p[8 * s + 1]); w.y = pg8::cvt_pk_bf16(p[8 * s + 2], p[8 * s + 3]); w.z = pg8::cvt_pk_bf16(p[8 * s + 4], p[8 * s + 5]); w.w = pg8::cvt_pk_bf16(p[8 * s + 6], p[8 * s + 7]);
    return __builtin_bit_cast(bf16x8, w);
}
__device__ __forceinline__ int pi32(int r) { return (r & 0x13) | ((r & 4) << 1) | ((r & 8) >> 1); }
__device__ __forceinline__ float max16(const f32x16& p) { float a = fmaxf(fmaxf(p[0], p[1]), fmaxf(p[2], p[3])), b = fmaxf(fmaxf(p[4], p[5]), fmaxf(p[6], p[7])), c = fmaxf(fmaxf(p[8], p[9]), fmaxf(p[10], p[11])), d = fmaxf(fmaxf(p[12], p[13]), fmaxf(p[14], p[15])); return fmaxf(fmaxf(a, b), fmaxf(c, d)); }
__device__ __forceinline__ float sum16(const f32x16& p) { return ((p[0] + p[1]) + (p[2] + p[3])) + ((p[4] + p[5]) + (p[6] + p[7])) + ((p[8] + p[9]) + (p[10] + p[11])) + ((p[12] + p[13]) + (p[14] + p[15])); }

namespace battn {
constexpr int NS = 5, SLOT = 16384, TAB_OFF = NS * SLOT;
__device__ __forceinline__ void unit(LAS unsigned char* lds, const bf16* __restrict__ Q, const bf16* __restrict__ Kp, const bf16* __restrict__ VT, const float* __restrict__ rel, bf16* mix, float* ssa, int b, int h, int u) {
    const int tid = threadIdx.x, lane = tid & 63, wave = __builtin_amdgcn_readfirstlane(tid >> 6), r32 = lane & 31, hh = lane >> 5, j = wave >> 1, qh = wave & 1, c0 = 4 * u;
    LAS float* tab = (LAS float*)(lds + TAB_OFF);
    if (tid < RELW) tab[tid] = rel[h * RELW + tid] * LOG2E;
    const int lrow = tid >> 3, lchunk = (tid & 7) ^ ((lrow >> 1) & 7);
    const bf16* ksrc = Kp + ((size_t)b * SEQ + lrow) * 1024 + h * 64 + lchunk * 8;
    const bf16* vsrc = VT + (size_t)(h * 64 + lrow) * NTOK + (size_t)b * SEQ + lchunk * 8;
#define BA_LOAD(T) do { const int _sl = (((T) + 8) % NS) * SLOT + wave * 1024; GLDS16(ksrc + (size_t)(T) * 64 * 1024, lds + _sl); GLDS16(vsrc + (size_t)(T) * 64, lds + _sl + 8192); } while (0)
    const size_t tok = (size_t)b * SEQ + (c0 + j) * 64 + 32 * qh + r32;
    bf16x8 qf[4];
#pragma unroll
    for (int d0 = 0; d0 < 4; ++d0) qf[d0] = *(const bf16x8*)(Q + tok * 1024 + h * 64 + 16 * d0 + 8 * hh);
#pragma unroll
    for (int T = c0 - 8; T < c0 - 4; ++T) if (T >= 0) BA_LOAD(T);
    asm volatile("s_waitcnt vmcnt(0) lgkmcnt(0)" ::: "memory"); __builtin_amdgcn_s_barrier(); asm volatile("" ::: "memory");
    float mrun = -1e30f, lsum = 0.f; f32x16 o0 = {}, o1 = {};
    const int k0r = pi32(r32), k1r = 32 + k0r;
    const int ka0 = k0r * 128, ka1 = k1r * 128, ks0 = (k0r >> 1) & 7, ks1 = (k1r >> 1) & 7;
    const int v0r = r32, v1r = 32 + r32, vs0 = (v0r >> 1) & 7, vs1 = (v1r >> 1) & 7;
#pragma unroll 1
    for (int s = 0; s < 9; ++s) {
        if (s < 8) { const int Tn = c0 - 4 + s; if (Tn >= 0) BA_LOAD(Tn); }
        const int T = c0 + j - 8 + s;
        if (T >= 0) {
            const LAS unsigned char* sb = lds + ((T + 8) % NS) * SLOT;
            f32x16 p0 = {}, p1 = {};
#pragma unroll
            for (int d0 = 0; d0 < 4; ++d0) {
                const bf16x8 a0 = *(const LAS bf16x8*)(sb + ka0 + (((2 * d0 + hh) ^ ks0) << 4)), a1 = *(const LAS bf16x8*)(sb + ka1 + (((2 * d0 + hh) ^ ks1) << 4));
                p0 = MFMA32(a0, qf[d0], p0); p1 = MFMA32(a1, qf[d0], p1); }
            const int dj = 8 - s;
            if (dj >= 3) { const float c = tab[256];
#pragma unroll
                for (int r = 0; r < 16; ++r) { p0[r] += c; p1[r] += c; } }
            else { const int base = 64 * dj + 32 * qh + r32 + 128 - 8 * hh;
#pragma unroll
                for (int r = 0; r < 16; ++r) { const int i0 = base - (16 * (r >> 3) + (r & 7)); p0[r] += tab[i0 < 256 ? i0 : 256]; const int i1 = i0 - 32; p1[r] += tab[i1 < 256 ? i1 : 256]; } }
            float mx = fmaxf(max16(p0), max16(p1)); mx = fmaxf(mx, __shfl_xor(mx, 32));
            const float mnew = fmaxf(mrun, mx), corr = __builtin_amdgcn_exp2f(mrun - mnew); mrun = mnew;
#pragma unroll
            for (int r = 0; r < 16; ++r) { p0[r] = __builtin_amdgcn_exp2f(p0[r] - mnew); p1[r] = __builtin_amdgcn_exp2f(p1[r] - mnew); }
            lsum = lsum * corr + (sum16(p0) + sum16(p1));
#pragma unroll
            for (int r = 0; r < 16; ++r) { o0[r] *= corr; o1[r] *= corr; }
            const bf16x8 pf00 = pack_p(p0, 0), pf01 = pack_p(p0, 1), pf10 = pack_p(p1, 0), pf11 = pack_p(p1, 1);
            const LAS unsigned char* vb = sb + 8192;
#define BA_V(row, sw, c) (*(const LAS bf16x8*)(vb + (row) * 128 + ((((c) + hh) ^ (sw)) << 4)))
            o0 = MFMA32(BA_V(v0r, vs0, 0), pf00, o0); o0 = MFMA32(BA_V(v0r, vs0, 2), pf01, o0); o0 = MFMA32(BA_V(v0r, vs0, 4), pf10, o0); o0 = MFMA32(BA_V(v0r, vs0, 6), pf11, o0);
            o1 = MFMA32(BA_V(v1r, vs1, 0), pf00, o1); o1 = MFMA32(BA_V(v1r, vs1, 2), pf01, o1); o1 = MFMA32(BA_V(v1r, vs1, 4), pf10, o1); o1 = MFMA32(BA_V(v1r, vs1, 6), pf11, o1);
#undef BA_V
        }
        asm volatile("s_waitcnt vmcnt(0) lgkmcnt(0)" ::: "memory"); __builtin_amdgcn_s_barrier(); asm volatile("" ::: "memory");
    }
#undef BA_LOAD
    const float inv = 1.0f / (lsum + __shfl_xor(lsum, 32)); float ss = 0.f;
#pragma unroll
    for (int r = 0; r < 16; ++r) { o0[r] *= inv; o1[r] *= inv; ss += o0[r] * o0[r] + o1[r] * o1[r]; }
    ss += __shfl_xor(ss, 32); if (hh == 0) ssa[tok * 16 + h] = ss;
    bf16* op = mix + tok * DM + h * 64 + 4 * hh;
#pragma unroll
    for (int g = 0; g < 4; ++g) { v2u w; w.x = pg8::cvt_pk_bf16(o0[4 * g], o0[4 * g + 1]); w.y = pg8::cvt_pk_bf16(o0[4 * g + 2], o0[4 * g + 3]); *(v2u*)(op + 8 * g) = w;
        w.x = pg8::cvt_pk_bf16(o1[4 * g], o1[4 * g + 1]); w.y = pg8::cvt_pk_bf16(o1[4 * g + 2], o1[4 * g + 3]); *(v2u*)(op + 32 + 8 * g) = w; }
}
}

namespace xattn {
__device__ __forceinline__ void unit(LAS unsigned char* lds, const bf16* __restrict__ CQ, const bf16* __restrict__ CK, const bf16* __restrict__ CVT, bf16* ox, int b, int h, int qb, bool reload) {
    const int tid = threadIdx.x, lane = tid & 63, wave = __builtin_amdgcn_readfirstlane(tid >> 6), r32 = lane & 31, hh = lane >> 5;
    if (reload) {
#pragma unroll
        for (int i = 0; i < 8; ++i) { const int idx = i * 512 + tid;
            const int kr = idx >> 4, kc = (idx & 15) ^ (kr & 15); GLDS16(CK + ((size_t)b * MEML + kr) * XW + h * XHD + kc * 8, lds + i * 8192 + wave * 1024);
            const int vr = idx >> 5, vc = (idx & 31) ^ (vr & 15); GLDS16(CVT + (size_t)(h * XHD + vr) * NMEM + (size_t)b * MEML + vc * 8, lds + 65536 + i * 8192 + wave * 1024); }
    }
    const size_t tok = (size_t)b * SEQ + qb * 256 + wave * 32 + r32;
    bf16x8 qf[8];
#pragma unroll
    for (int d0 = 0; d0 < 8; ++d0) qf[d0] = *(const bf16x8*)(CQ + tok * XW + h * XHD + 16 * d0 + 8 * hh);
    asm volatile("s_waitcnt vmcnt(0)" ::: "memory"); __builtin_amdgcn_s_barrier(); asm volatile("" ::: "memory");
    float mrun = -1e30f, lsum = 0.f; f32x16 o[4] = {};
    const int kp = pi32(r32);
#pragma unroll 1
    for (int s = 0; s < 4; ++s) {
        f32x16 p0 = {}, p1 = {};
        const int k0r = 64 * s + kp, k1r = k0r + 32;
#pragma unroll
        for (int d0 = 0; d0 < 8; ++d0) {
            const bf16x8 a0 = *(const LAS bf16x8*)(lds + k0r * 256 + (((2 * d0 + hh) ^ (k0r & 15)) << 4)), a1 = *(const LAS bf16x8*)(lds + k1r * 256 + (((2 * d0 + hh) ^ (k1r & 15)) << 4));
            p0 = MFMA32(a0, qf[d0], p0); p1 = MFMA32(a1, qf[d0], p1); }
        float mx = fmaxf(max16(p0), max16(p1)); mx = fmaxf(mx, __shfl_xor(mx, 32));
        const float mnew = fmaxf(mrun, mx), corr = __builtin_amdgcn_exp2f(mrun - mnew); mrun = mnew;
#pragma unroll
        for (int r = 0; r < 16; ++r) { p0[r] = __builtin_amdgcn_exp2f(p0[r] - mnew); p1[r] = __builtin_amdgcn_exp2f(p1[r] - mnew); }
        lsum = lsum * corr + (sum16(p0) + sum16(p1));
        const bf16x8 pf00 = pack_p(p0, 0), pf01 = pack_p(p0, 1), pf10 = pack_p(p1, 0), pf11 = pack_p(p1, 1);
#pragma unroll
        for (int dh = 0; dh < 4; ++dh) { const int vr = 32 * dh + r32; const LAS unsigned char* vb = lds + 65536 + vr * 512;
#pragma unroll
            for (int r = 0; r < 16; ++r) o[dh][r] *= corr;
#define XA_V(c) (*(const LAS bf16x8*)(vb + ((((8 * s + (c) + hh)) ^ (vr & 15)) << 4)))
            o[dh] = MFMA32(XA_V(0), pf00, o[dh]); o[dh] = MFMA32(XA_V(2), pf01, o[dh]); o[dh] = MFMA32(XA_V(4), pf10, o[dh]); o[dh] = MFMA32(XA_V(6), pf11, o[dh]);
#undef XA_V
        }
    }
    const float inv = 1.0f / (lsum + __shfl_xor(lsum, 32));
    bf16* op = ox + tok * XW + h * XHD + 4 * hh;
#pragma unroll
    for (int dh = 0; dh < 4; ++dh)
#pragma unroll
        for (int g = 0; g < 4; ++g) { v2u w; w.x = pg8::cvt_pk_bf16(o[dh][4 * g] * inv, o[dh][4 * g + 1] * inv); w.y = pg8::cvt_pk_bf16(o[dh][4 * g + 2] * inv, o[dh][4 * g + 3] * inv); *(v2u*)(op + 32 * dh + 8 * g) = w; }
    asm volatile("s_waitcnt lgkmcnt(0)" ::: "memory"); __builtin_amdgcn_s_barrier(); asm volatile("" ::: "memory");
}
}

namespace lru {
constexpr int XA_P = 272, XA_OFF = 0, XF_OFF = 64 * XA_P, SA_OFF = XF_OFF + 64 * 64 * 4, SB_OFF = SA_OFF + 64 * 68 * 4, SC_OFF = SB_OFF + 64 * 68 * 4, HS_OFF = SC_OFF + 8 * 64 * 8, CW_OFF = HS_OFF + 256, END_OFF = CW_OFF + 5 * 128 * 4;
__device__ __forceinline__ void unit(LAS unsigned char* lds, const bf16* __restrict__ xr, const bf16* __restrict__ yg, const float* __restrict__ conv_w, const float* __restrict__ conv_b, const bf16* __restrict__ wga_t, const bf16* __restrict__ wgx_t,
                                     const float* __restrict__ b_ga, const float* __restrict__ b_gx, const float* __restrict__ lam, bf16* mix, float* ssl, int b, int g) {
    const int tid = threadIdx.x, lane = tid & 63, wave = __builtin_amdgcn_readfirstlane(tid >> 6), n = g >> 1, hf = g & 1;
    LAS float* XF = (LAS float*)(lds + XF_OFF); LAS float* SA = (LAS float*)(lds + SA_OFF); LAS float* SB = (LAS float*)(lds + SB_OFF); LAS f32x2* SC = (LAS f32x2*)(lds + SC_OFF); LAS float* HS = (LAS float*)(lds + HS_OFF); LAS float* CW = (LAS float*)(lds + CW_OFF);
    for (int i = tid; i < 5 * 128; i += 512) { const int jj = i >> 7, c = i & 127; CW[i] = jj < 4 ? conv_w[jj * LW + n * 128 + c] : conv_b[n * 128 + c]; }
    if (tid < 64) HS[tid] = 0.f;
    const int tb = wave & 3, dq = wave >> 2, l15 = lane & 15, l4 = lane >> 4;
    bf16x8 wf[2][2][4];
#pragma unroll
    for (int dt = 0; dt < 2; ++dt)
#pragma unroll
        for (int ks = 0; ks < 4; ++ks) { const size_t off = (size_t)(n * 128 + hf * 64 + dq * 32 + 16 * dt + l15) * 128 + 32 * ks + 8 * l4;
            wf[0][dt][ks] = *(const bf16x8*)(wga_t + off); wf[1][dt][ks] = *(const bf16x8*)(wgx_t + off); }
    float cba[2][4], cbx[2][4], csp[2][4];
#pragma unroll
    for (int dt = 0; dt < 2; ++dt)
#pragma unroll
        for (int r = 0; r < 4; ++r) { const int c = n * 128 + hf * 64 + dq * 32 + 16 * dt + 4 * l4 + r; cba[dt][r] = b_ga[c]; cbx[dt][r] = b_gx[c]; csp[dt][r] = -8.0f * log1pf(__expf(-lam[c])); }
    const int tt = tid >> 3, cg = tid & 7;
    const bf16* xrp = xr + ((size_t)b * SEQ + tt) * 1024 + n * 128 + cg * 16;
    const int cc = lane, sg = wave;
    const bf16* ygp = yg + ((size_t)b * SEQ + 8 * sg) * 1024 + n * 128 + hf * 64 + cc;
    bf16* outp = mix + ((size_t)b * SEQ + 8 * sg) * DM + 1024 + n * 128 + hf * 64 + cc;
    v4u xv[4][2]; bf16 yv[8];
#define LRU_LOADX(t0) do { _Pragma("unroll") for (int jj = 0; jj < 4; ++jj) { const int trow = (t0) + tt - 3 + jj; \
        if (trow >= 0) { const v4u* q_ = (const v4u*)(xrp + ((ptrdiff_t)((t0) - 3 + jj)) * 1024); xv[jj][0] = q_[0]; xv[jj][1] = q_[1]; } else { xv[jj][0] = (v4u){0u, 0u, 0u, 0u}; xv[jj][1] = (v4u){0u, 0u, 0u, 0u}; } } \
        _Pragma("unroll") for (int i = 0; i < 8; ++i) yv[i] = ygp[((size_t)(t0) + i) * 1024]; } while (0)
    LRU_LOADX(0);
    asm volatile("s_waitcnt lgkmcnt(0)" ::: "memory"); __builtin_amdgcn_s_barrier(); asm volatile("" ::: "memory");
#pragma unroll 1
    for (int t0 = 0; t0 < SEQ; t0 += 64) {
        {
            float xc[16];
#pragma unroll
            for (int i = 0; i < 16; ++i) xc[i] = CW[4 * 128 + cg * 16 + i];
#pragma unroll
            for (int jj = 0; jj < 4; ++jj)
#pragma unroll
                for (int i = 0; i < 16; ++i) { const unsigned w = xv[jj][i >> 3][(i >> 1) & 3]; const float xf = (i & 1) ? __uint_as_float(w & 0xffff0000u) : __uint_as_float(w << 16); xc[i] += CW[jj * 128 + cg * 16 + i] * xf; }
            v4u w0, w1; w0.x = pg8::cvt_pk_bf16(xc[0], xc[1]); w0.y = pg8::cvt_pk_bf16(xc[2], xc[3]); w0.z = pg8::cvt_pk_bf16(xc[4], xc[5]); w0.w = pg8::cvt_pk_bf16(xc[6], xc[7]);
            w1.x = pg8::cvt_pk_bf16(xc[8], xc[9]); w1.y = pg8::cvt_pk_bf16(xc[10], xc[11]); w1.z = pg8::cvt_pk_bf16(xc[12], xc[13]); w1.w = pg8::cvt_pk_bf16(xc[14], xc[15]);
            *(LAS v4u*)(lds + XA_OFF + tt * XA_P + cg * 32) = w0; *(LAS v4u*)(lds + XA_OFF + tt * XA_P + cg * 32 + 16) = w1;
            if ((cg >> 2) == hf) {
#pragma unroll
                for (int i = 0; i < 16; i += 4) *(LAS f32x4*)(XF + tt * 64 + (cg & 3) * 16 + i) = (f32x4){xc[i], xc[i + 1], xc[i + 2], xc[i + 3]}; }
        }
        bf16 ycur[8];
#pragma unroll
        for (int i = 0; i < 8; ++i) ycur[i] = yv[i];
        if (t0 + 64 < SEQ) LRU_LOADX(t0 + 64);
        asm volatile("s_waitcnt lgkmcnt(0)" ::: "memory"); __builtin_amdgcn_s_barrier(); asm volatile("" ::: "memory");
        {
            f32x4 ar[2] = {}, ai[2] = {};
#pragma unroll
            for (int ks = 0; ks < 4; ++ks) { const bf16x8 xfr = *(const LAS bf16x8*)(lds + XA_OFF + (16 * tb + l15) * XA_P + 64 * ks + 16 * l4);
#pragma unroll
                for (int dt = 0; dt < 2; ++dt) { ar[dt] = MFMA16(wf[0][dt][ks], xfr, ar[dt]); ai[dt] = MFMA16(wf[1][dt][ks], xfr, ai[dt]); } }
            const int tk = 16 * tb + l15;
#pragma unroll
            for (int dt = 0; dt < 2; ++dt) { const int dl = dq * 32 + 16 * dt + 4 * l4; const f32x4 xo = *(const LAS f32x4*)(XF + tk * 64 + dl); f32x4 av, bv;
#pragma unroll
                for (int r = 0; r < 4; ++r) { const float rg = sigmoidf_(ar[dt][r] + cba[dt][r]), ig = sigmoidf_(ai[dt][r] + cbx[dt][r]); const float la = rg * csp[dt][r];
                    av[r] = __expf(la); bv[r] = sqrtf(-expm1f(2.0f * la)) * (ig * xo[r]); }
                *(LAS f32x4*)(SA + tk * 68 + dl) = av; *(LAS f32x4*)(SB + tk * 68 + dl) = bv; }
        }
        asm volatile("s_waitcnt lgkmcnt(0)" ::: "memory"); __builtin_amdgcn_s_barrier(); asm volatile("" ::: "memory");
        float a8[8], b8[8];
        { float A = 1.f, B = 0.f;
#pragma unroll
            for (int i = 0; i < 8; ++i) { a8[i] = SA[(8 * sg + i) * 68 + cc]; b8[i] = SB[(8 * sg + i) * 68 + cc]; B = a8[i] * B + b8[i]; A *= a8[i]; }
            SC[sg * 64 + cc] = (f32x2){A, B}; }
        asm volatile("s_waitcnt lgkmcnt(0)" ::: "memory"); __builtin_amdgcn_s_barrier(); asm volatile("" ::: "memory");
        {
            float hcur = HS[cc];
#pragma unroll
            for (int s2 = 0; s2 < 7; ++s2) { const f32x2 ab = SC[s2 * 64 + cc]; if (s2 < sg) hcur = ab.x * hcur + ab.y; }
#pragma unroll
            for (int i = 0; i < 8; ++i) { hcur = a8[i] * hcur + b8[i]; const float y = hcur * gelu_tanh(bf2f(ycur[i])); outp[((size_t)t0 + i) * DM] = (bf16)f2bf(y);
                const float s = wave_sum(y * y); if (lane == 0) ssl[((size_t)b * SEQ + t0 + 8 * sg + i) * 16 + g] = s; }
            asm volatile("s_waitcnt lgkmcnt(0)" ::: "memory"); __builtin_amdgcn_s_barrier(); asm volatile("" ::: "memory");
            if (sg == 7) HS[cc] = hcur;
        }
    }
#undef LRU_LOADX
    asm volatile("s_waitcnt vmcnt(0) lgkmcnt(0)" ::: "memory"); __builtin_amdgcn_s_barrier(); asm volatile("" ::: "memory");
}
}

constexpr int NWAVES = 8, NPHASE = 12;
constexpr int RING_BYTES = 131072, LDSCTL_OFF = RING_BYTES, MISC_OFF = LDSCTL_OFF + 320, LDS_BYTES = 147456;
#define LDS_WAIT() asm volatile("s_waitcnt lgkmcnt(0)" ::: "memory")
#define VM_WAIT() asm volatile("s_waitcnt vmcnt(0)" ::: "memory")

__device__ __forceinline__ void tr_item(const float* W, int K, int N, bf16* WT, int drow0, const float* gain, LAS float* scr, int k0, int n0, int lane) {
#pragma unroll 8
    for (int i = 0; i < 32; ++i) { const int kk = 2 * i + (lane >> 5); scr[kk * 33 + (lane & 31)] = W[(size_t)(k0 + kk) * N + n0 + (lane & 31)]; }
    LDS_WAIT(); asm volatile("" ::: "memory");
    const int c = lane & 7;
    float g[8];
#pragma unroll
    for (int j = 0; j < 8; ++j) g[j] = gain ? gain[k0 + 8 * c + j] : 1.0f;
#pragma unroll
    for (int j = 0; j < 4; ++j) { const int n = (lane >> 3) + 8 * j; const LAS float* s = scr + (8 * c) * 33 + n;
        v4u o; o.x = pk2(s[0 * 33] * g[0], s[1 * 33] * g[1]); o.y = pk2(s[2 * 33] * g[2], s[3 * 33] * g[3]); o.z = pk2(s[4 * 33] * g[4], s[5 * 33] * g[5]); o.w = pk2(s[6 * 33] * g[6], s[7 * 33] * g[7]);
        *(GAS v4u*)(WT + (size_t)(drow0 + n) * K + k0 + 8 * c) = o; }
    LDS_WAIT(); asm volatile("" ::: "memory");
}
__device__ __forceinline__ void row_to_bf16(const float* xrow, bf16* orow, float* ss, int lane) {
    const GAS f32x4* xr = (const GAS f32x4*)xrow + lane; float s = 0.f;
    GAS v2u* o8 = (GAS v2u*)orow + lane;
#pragma unroll
    for (int j = 0; j < 8; ++j) { const f32x4 v = xr[64 * j]; s += (v.x * v.x + v.y * v.y) + (v.z * v.z + v.w * v.w); v2u w; w.x = pk2(v.x, v.y); w.y = pk2(v.z, v.w); o8[64 * j] = w; }
    s = wave_sum(s); if (lane == 0) *ss = s;
}
__device__ __forceinline__ void p0_prologue(const P& p, LAS unsigned char* lds, int gw, int NGW, int wave, int lane) {
    LAS float* scr = (LAS float*)(lds + wave * 16384);
    unsigned char* ws = p.ws;
    for (int m = gw; m < NTOK; m += NGW) row_to_bf16(p.x + (size_t)m * DM, (bf16*)(ws + WS_XB) + (size_t)m * DM, (float*)(ws + WS_SS0) + m, lane);
    for (int m = gw; m < NMEM; m += NGW) row_to_bf16(p.mem + (size_t)m * DM, (bf16*)(ws + WS_MEMB) + (size_t)m * DM, (float*)(ws + WS_SSM) + m, lane);
    for (int i = gw * 64 + lane; i < NE * DM; i += NGW * 64) { const int e = i >> 11, k = i & 2047; ((float*)(ws + WS_W_R))[i] = p.g_ffn[k] * p.w_r[k * NE + e]; }
    constexpr int I_IN = 32 * 160, I_OUT = 32 * 64, I_CQ = 32 * 16, I_CKV = 32 * 32, I_CO = 8 * 64, I_G = 8 * 2 * 4, I_GU = 32 * 32 * 128, I_DN = 32 * 32 * 64;
    constexpr int NITEMS = I_IN + I_OUT + I_CQ + I_CKV + I_CO + 2 * I_G + I_GU + I_DN;
    for (int it = gw; it < NITEMS; it += NGW) {
        int r = it;
        if (r < I_IN)  { const int kb = r / 160, nb = r % 160; tr_item(p.w_in, DM, 5120, (bf16*)(ws + WS_W_IN), nb * 32, p.g_mix, scr, kb * 64, nb * 32, lane); continue; } r -= I_IN;
        if (r < I_OUT) { const int kb = r / 64, nb = r % 64; tr_item(p.w_out, DM, DM, (bf16*)(ws + WS_W_OUT), nb * 32, kb < 16 ? p.g_att : p.g_lru - 1024, scr, kb * 64, nb * 32, lane); continue; } r -= I_OUT;
        if (r < I_CQ)  { const int kb = r / 16, nb = r % 16; tr_item(p.w_cq, DM, XW, (bf16*)(ws + WS_W_CQ), nb * 32, p.g_cross, scr, kb * 64, nb * 32, lane); continue; } r -= I_CQ;
        if (r < I_CKV) { const int kb = r / 32, nb = r % 32; tr_item(p.w_ckv, DM, 2 * XW, (bf16*)(ws + WS_W_CKV), nb * 32, p.g_mem, scr, kb * 64, nb * 32, lane); continue; } r -= I_CKV;
        if (r < I_CO)  { const int kb = r / 64, nb = r % 64; tr_item(p.w_co, XW, DM, (bf16*)(ws + WS_W_CO), nb * 32, nullptr, scr, kb * 64, nb * 32, lane); continue; } r -= I_CO;
        if (r < I_G)   { const int n = r >> 3, kb = (r >> 2) & 1, nb = r & 3; tr_item(p.w_ga + n * 16384, LBW, LBW, (bf16*)(ws + WS_W_GA) + n * 16384, nb * 32, nullptr, scr, kb * 64, nb * 32, lane); continue; } r -= I_G;
        if (r < I_G)   { const int n = r >> 3, kb = (r >> 2) & 1, nb = r & 3; tr_item(p.w_gx + n * 16384, LBW, LBW, (bf16*)(ws + WS_W_GX) + n * 16384, nb * 32, nullptr, scr, kb * 64, nb * 32, lane); continue; } r -= I_G;
        if (r < I_GU)  { const int e = r >> 12, q = r & 4095, kb = q >> 7, nb = q & 127, n0 = nb * 32; const int c = n0 & 2047, up = n0 >> 11;
                         tr_item(p.w_gu + (size_t)e * DM * 4096, DM, 4096, (bf16*)(ws + WS_W_GU) + (size_t)e * 4096 * DM, 256 * (c >> 7) + (c & 127) + 128 * up, p.g_ffn, scr, kb * 64, n0, lane); continue; } r -= I_GU;
        { const int e = r >> 11, q = r & 2047, kb = q >> 6, nb = q & 63; tr_item(p.w_dn + (size_t)e * DFF * DM, DFF, DM, (bf16*)(ws + WS_W_DN) + (size_t)e * DM * DFF, nb * 32, nullptr, scr, kb * 64, nb * 32, lane); }
    }
}
__device__ __forceinline__ void p3_scales(const P& p, int gtid, int NT) {
    const float* ssa = (const float*)(p.ws + WS_SSA); const float* ssl = (const float*)(p.ws + WS_SSL); float* scl = (float*)(p.ws + WS_SCL);
    for (int m = gtid; m < NTOK; m += NT) { float a = 0.f, l = 0.f;
#pragma unroll
        for (int i = 0; i < 16; ++i) { a += ssa[(size_t)m * 16 + i]; l += ssl[(size_t)m * 16 + i]; }
        const float ra = rsqrtf(a * (1.0f / AW) + EPS), rl = rsqrtf(l * (1.0f / LW) + EPS);
        scl[2 * m] = ra / rl; scl[2 * m + 1] = rl; }
}
__device__ __forceinline__ void p8_router(const P& p, int gw, int NGW, int lane) {
    const float* wrt = (const float*)(p.ws + WS_W_R); const float* x2 = p.out;
    int* cnt = (int*)(p.ws + WS_CTL) + CW_CNT; int* list = (int*)(p.ws + WS_LIST);
    int* tope = (int*)(p.ws + WS_TOPE); float* topg = (float*)(p.ws + WS_TOPG); int* tpos = (int*)(p.ws + WS_TPOS); float* r2 = (float*)(p.ws + WS_R2);
    for (int m = gw; m < NTOK; m += NGW) {
        const GAS f32x4* xr = (const GAS f32x4*)(x2 + (size_t)m * DM) + lane;
        f32x4 xv[8]; float ss = 0.f;
#pragma unroll
        for (int j = 0; j < 8; ++j) { xv[j] = xr[64 * j]; ss += (xv[j].x * xv[j].x + xv[j].y * xv[j].y) + (xv[j].z * xv[j].z + xv[j].w * xv[j].w); }
        ss = wave_sum(ss); const float r = rsqrtf(ss * (1.0f / DM) + EPS);
        float mylogit = 0.f;
#pragma unroll 4
        for (int e = 0; e < NE; ++e) { const GAS f32x4* wr = (const GAS f32x4*)(wrt + (size_t)e * DM) + lane; float a = 0.f;
#pragma unroll
            for (int j = 0; j < 8; ++j) { const f32x4 w = wr[64 * j]; a += (xv[j].x * w.x + xv[j].y * w.y) + (xv[j].z * w.z + xv[j].w * w.w); }
            a = wave_sum(a); if (lane == e) mylogit = a * r + p.b_r[e]; }
        float v = lane < NE ? mylogit : -INFINITY; float tv[4]; int te[4];
#pragma unroll
        for (int k = 0; k < TOPK; ++k) { float mxv = v;
#pragma unroll
            for (int o = 1; o < 64; o <<= 1) mxv = fmaxf(mxv, __shfl_xor(mxv, o));
            const unsigned long long bal = __ballot(v == mxv); const int idx = __ffsll((long long)bal) - 1; tv[k] = mxv; te[k] = idx; if (lane == idx) v = -INFINITY; }
        const float e1 = __expf(tv[1] - tv[0]), e2 = __expf(tv[2] - tv[0]), e3 = __expf(tv[3] - tv[0]); const float inv = 1.0f / (1.0f + e1 + e2 + e3);
        if (lane < TOPK) { const int e = lane == 0 ? te[0] : lane == 1 ? te[1] : lane == 2 ? te[2] : te[3]; const float g = (lane == 0 ? 1.0f : lane == 1 ? e1 : lane == 2 ? e2 : e3) * inv;
            const int pos = atomicAdd(&cnt[e], 1); list[(size_t)e * NTOK + pos] = m; tope[m * 4 + lane] = e; topg[m * 4 + lane] = g; tpos[m * 4 + lane] = pos; }
        if (lane == 0) r2[m] = r;
    }
}
__device__ __forceinline__ void p11_combine(const P& p, int gw, int NGW, int lane) {
    const int* cnt = (const int*)(p.ws + WS_CTL) + CW_CNT; const bf16* Y = (const bf16*)(p.ws + WS_Y);
    const int* tope = (const int*)(p.ws + WS_TOPE); const float* topg = (const float*)(p.ws + WS_TOPG); const int* tpos = (const int*)(p.ws + WS_TPOS);
    int pad = lane < NE ? ((cnt[lane & 31] + 255) >> 8) : 0; int inc = pad;
#pragma unroll
    for (int o = 1; o < 32; o <<= 1) { const int t = __shfl_up(inc, o); if ((lane & 31) >= o) inc += t; }
    const int toff_l = inc - pad;
    for (int m = gw; m < NTOK; m += NGW) {
        GAS f32x4* xr = (GAS f32x4*)(p.out + (size_t)m * DM) + lane;
        f32x4 a[8];
#pragma unroll
        for (int j = 0; j < 8; ++j) a[j] = xr[64 * j];
#pragma unroll
        for (int k = 0; k < TOPK; ++k) { const int e = tope[m * 4 + k]; const float g = topg[m * 4 + k]; const int slot = 256 * __shfl(toff_l, e) + tpos[m * 4 + k];
            const GAS v2u* yr = (const GAS v2u*)(Y + (size_t)slot * DM) + lane;
#pragma unroll
            for (int j = 0; j < 8; ++j) { const v2u w = yr[64 * j]; a[j].x += g * __uint_as_float(w.x << 16); a[j].y += g * __uint_as_float(w.x & 0xffff0000u); a[j].z += g * __uint_as_float(w.y << 16); a[j].w += g * __uint_as_float(w.y & 0xffff0000u); } }
        float ss = 0.f;
#pragma unroll
        for (int j = 0; j < 8; ++j) ss += (a[j].x * a[j].x + a[j].y * a[j].y) + (a[j].z * a[j].z + a[j].w * a[j].w);
        ss = wave_sum(ss); const float r = rsqrtf(ss * (1.0f / DM) + EPS);
        const GAS f32x4* gf = (const GAS f32x4*)p.g_fin + lane;
#pragma unroll
        for (int j = 0; j < 8; ++j) { const f32x4 g = gf[64 * j]; xr[64 * j] = a[j] * r * g; }
    }
}

#ifndef FAST_MASK
#define FAST_MASK 0xFFFu
#endif
#ifndef SUB2_MASK
#define SUB2_MASK 0x7u
#endif
__global__ void __launch_bounds__(NWAVES * 64, 2) fwd(P p) {
    extern __shared__ __attribute__((aligned(16))) unsigned char lds_raw[];
    LAS unsigned char* lds = (LAS unsigned char*)lds_raw;
    volatile LAS unsigned* MISC = (volatile LAS unsigned*)(lds + MISC_OFF);
    const int tid = threadIdx.x, lane = tid & 63, wave = __builtin_amdgcn_readfirstlane(tid >> 6);
    const int G = gridDim.x, bx = blockIdx.x; const int vcu = (G % 8 == 0) ? (bx % 8) * (G / 8) + bx / 8 : bx;
    const int gw = vcu * NWAVES + wave, NGW = G * NWAVES;
    for (int u = tid; u < (LDS_BYTES - LDSCTL_OFF) / 4; u += NWAVES * 64) ((LAS unsigned*)(lds + LDSCTL_OFF))[u] = 0u;
    __syncthreads();
    unsigned* ctl = (unsigned*)(p.ws + WS_CTL);
    const int lo = p.ph_lo, hi = p.ph_hi;
    XcdBarrier bar; bar.bar = ctl + CW_BAR + p.li * XCD_BAR_WORDS; bar.x = 0; bar.st = nullptr;
    if (hi - lo > 1) bar = xcd_barrier_post(ctl + CW_BAR + p.li * XCD_BAR_WORDS, MISC + 8);
#define IN(k) (lo <= (k) && (k) < hi)
#define SEAM(k) do { if (IN(k) && IN((k) + 1)) xcd_barrier(bar); } while (0)
    unsigned char* ws = p.ws;
    LAS int* l_toff = (LAS int*)(lds + LDSCTL_OFF + 512); LAS int* l_cnt = (LAS int*)(lds + LDSCTL_OFF + 768);
    if (IN(0)) { p0_prologue(p, lds, gw, NGW, wave, lane); } SEAM(0);
    if (IN(1)) {
        { pg8::SchedReg S{(const char*)(ws + WS_XB), (const char*)(ws + WS_W_IN), NTOK / 256, 16, G, bx, 4096, 8, 1024};
          pg8::EpiRowScale E{(const float*)(ws + WS_SS0), (bf16*)(ws + WS_QKXY), 1024, 1024, (size_t)NTOK * 1024, QSCALE};
          pg8::gemm_phase(lds, DM, S, E); }
        { pg8::SchedReg S{(const char*)(ws + WS_W_IN) + (size_t)2048 * 4096, (const char*)(ws + WS_XB), 4, NTOK / 256, G, bx, 4096, 1 << 30, 0};
          pg8::EpiColScale E{(const float*)(ws + WS_SS0), (bf16*)(ws + WS_VT), (size_t)NTOK};
          pg8::gemm_phase(lds, DM, S, E); }
    } SEAM(1);
    if (IN(2)) {
        if (SUB2_MASK & 1u) {
            { pg8::SchedReg S{(const char*)(ws + WS_MEMB), (const char*)(ws + WS_W_CKV), NMEM / 256, 2, G, bx, 4096, 1 << 30, 0};
              pg8::EpiRowScale E{(const float*)(ws + WS_SSM), (bf16*)(ws + WS_CK), XW, 0, 0, 1.0f};
              pg8::gemm_phase(lds, DM, S, E); }
            { pg8::SchedReg S{(const char*)(ws + WS_W_CKV) + (size_t)512 * 4096, (const char*)(ws + WS_MEMB), 2, NMEM / 256, G, (bx + 32) % G, 4096, 1 << 30, 0};
              pg8::EpiColScale E{(const float*)(ws + WS_SSM), (bf16*)(ws + WS_CVT), (size_t)NMEM};
              pg8::gemm_phase(lds, DM, S, E); }
        }
        const bf16* QKXY = (const bf16*)(ws + WS_QKXY);
        if (SUB2_MASK & 4u) {
            for (int U = vcu; U < BATCH * 16; U += G)
                lru::unit(lds, QKXY + (size_t)2 * NTOK * 1024, QKXY + (size_t)3 * NTOK * 1024, p.conv_w, p.conv_b, (const bf16*)(ws + WS_W_GA), (const bf16*)(ws + WS_W_GX), p.b_ga, p.b_gx, p.lam, (bf16*)(ws + WS_MIX), (float*)(ws + WS_SSL), U >> 4, U & 15);
        }
        if (SUB2_MASK & 2u) {
            for (int U = vcu; U < BATCH * AH * 8; U += G)
                battn::unit(lds, QKXY, QKXY + (size_t)NTOK * 1024, (const bf16*)(ws + WS_VT), p.rel, (bf16*)(ws + WS_MIX), (float*)(ws + WS_SSA), U >> 7, (U >> 3) & 15, U & 7);
        }
    } SEAM(2);
    if (IN(3)) { p3_scales(p, gw * 64 + lane, NGW * 64); } SEAM(3);
    if (IN(4)) {
        pg8::SchedReg S{(const char*)(ws + WS_MIX), (const char*)(ws + WS_W_OUT), NTOK / 256, 8, G, bx, 4096, 1 << 30, 0};
        pg8::EpiX1 E{(const float*)(ws + WS_SCL), p.x, p.out, (bf16*)(ws + WS_X1B), (float*)(ws + WS_SS1P)};
        pg8::gemm_phase(lds, DM, S, E);
    } SEAM(4);
    if (IN(5)) {
        pg8::SchedReg S{(const char*)(ws + WS_X1B), (const char*)(ws + WS_W_CQ), NTOK / 256, 2, G, bx, 4096, 1 << 30, 0};
        pg8::EpiCQ E{(const float*)(ws + WS_SS1P), (bf16*)(ws + WS_CQ)};
        pg8::gemm_phase(lds, DM, S, E);
    } SEAM(5);
    if (IN(6)) {
        int prev = -1;
        for (int U = vcu; U < BATCH * XH * 8; U += G) { const int bh = U >> 3;
            xattn::unit(lds, (const bf16*)(ws + WS_CQ), (const bf16*)(ws + WS_CK), (const bf16*)(ws + WS_CVT), (bf16*)(ws + WS_OX), bh >> 2, bh & 3, U & 7, bh != prev); prev = bh; }
    } SEAM(6);
    if (IN(7)) {
        pg8::SchedReg S{(const char*)(ws + WS_OX), (const char*)(ws + WS_W_CO), NTOK / 256, 8, G, bx, 1024, 1 << 30, 0};
        pg8::EpiX2 E{p.out, (bf16*)(ws + WS_X2B)};
        pg8::gemm_phase(lds, XW, S, E);
    } SEAM(7);
    if (IN(8)) { p8_router(p, gw, NGW, lane); } SEAM(8);
    if (IN(9) || IN(10)) {
        if (tid < NE) l_cnt[tid] = ((const int*)ctl)[CW_CNT + tid];
        __syncthreads();
        if (tid == 0) { int a = 0; for (int e = 0; e < NE; ++e) { l_toff[e] = a; a += (l_cnt[e] + 255) >> 8; } l_toff[NE] = a; }
        __syncthreads();
    }
    if (IN(9)) {
        pg8::SchedMoE<true> S{l_toff, l_cnt, (const int*)(ws + WS_LIST), (const char*)(ws + WS_X2B), (const char*)(ws + WS_W_GU), 16, 4096, G, bx};
        pg8::EpiAct E{l_cnt, (const int*)(ws + WS_LIST), (const float*)(ws + WS_R2), p.b_gu, (bf16*)(ws + WS_ACT)};
        pg8::gemm_phase(lds, DM, S, E);
    } SEAM(9);
    if (IN(10)) {
        pg8::SchedMoE<false> S{l_toff, l_cnt, nullptr, (const char*)(ws + WS_ACT), (const char*)(ws + WS_W_DN), 8, 2048, G, bx};
        pg8::EpiY E{p.b_dn, (bf16*)(ws + WS_Y)};
        pg8::gemm_phase(lds, DFF, S, E);
    } SEAM(10);
    if (IN(11)) { p11_combine(p, gw, NGW, lane); }
#undef IN
#undef SEAM
}

extern "C" void kernel_launch(void* const* d_in, const int* in_sizes, int n_in, void* d_out, int out_size, void* d_ws, size_t ws_size, hipStream_t stream) {
    static int grid = 0;
    if (grid == 0) {
        if (n_in != 28 || in_sizes[0] != NTOK * DM || out_size != NTOK * DM || ws_size < WS_END) { fprintf(stderr, "kernel_launch: unexpected shapes (n_in %d, ws %zu)\n", n_in, ws_size); grid = -1; return; }
        int dev = 0, cus = 0;
        if (hipGetDevice(&dev) != hipSuccess || hipDeviceGetAttribute(&cus, hipDeviceAttributeMultiprocessorCount, dev) != hipSuccess) { grid = -1; return; }
        if (hipFuncSetAttribute((const void*)fwd, hipFuncAttributeMaxDynamicSharedMemorySize, LDS_BYTES) != hipSuccess) { fprintf(stderr, "kernel_launch: hipFuncSetAttribute failed\n"); grid = -1; return; }
        int per_cu = 0; (void)hipOccupancyMaxActiveBlocksPerMultiprocessor(&per_cu, (const void*)fwd, NWAVES * 64, LDS_BYTES); (void)hipGetLastError();
        grid = cus;
    }
    if (grid < 0) return;
    (void)hipMemsetAsync((char*)d_ws + WS_CTL, 0, CTL_ZERO_BYTES, stream);
    P p{};
    const float** pp = (const float**)&p;
    for (int i = 0; i < 28; ++i) pp[i] = (const float*)d_in[i];
    p.out = (float*)d_out; p.ws = (unsigned char*)d_ws;
    unsigned char* ws = (unsigned char*)d_ws;
    bf16* QKXY = (bf16*)(ws + WS_QKXY); int* ctl = (int*)(ws + WS_CTL);
    int li = 0;
    auto isfast = [](int ph) { return ph == 2 ? (SUB2_MASK != 0u) : (((FAST_MASK >> ph) & 1u) != 0u); };
    for (int ph = 0; ph < NPHASE;) {
        if (ph == 2) {
            if (!(SUB2_MASK & 1u)) { F1b f{}; f.A = (bf16*)(ws + WS_MEMB); f.Bt = (bf16*)(ws + WS_W_CKV); f.ssm = (float*)(ws + WS_SSM); f.ck = (bf16*)(ws + WS_CK); f.cvt = (bf16*)(ws + WS_CVT);
                  hipLaunchKernelGGL(ngemm<F1b>, dim3(1024 / 64, NMEM / 64), dim3(256), 0, stream, f); }
            if (!(SUB2_MASK & 2u)) hipLaunchKernelGGL(n_attn, dim3(BATCH * AH * 8), dim3(256), 0, stream, QKXY, (const bf16*)(ws + WS_VT), p.rel, (bf16*)(ws + WS_MIX), (float*)(ws + WS_SSA));
            if (!(SUB2_MASK & 4u)) {
                  hipLaunchKernelGGL(n_lru_a, dim3(NTOK * 4), dim3(256), 0, stream, QKXY + (size_t)2 * NTOK * 1024, p.conv_w, p.conv_b, (const bf16*)(ws + WS_W_GA), p.b_ga, (const bf16*)(ws + WS_W_GX), p.b_gx, p.lam, (float*)(ws + WS_NA), (float*)(ws + WS_NB));
                  hipLaunchKernelGGL(n_lru_b, dim3(256), dim3(64), 0, stream, (const float*)(ws + WS_NA), (const float*)(ws + WS_NB), QKXY + (size_t)3 * NTOK * 1024, (bf16*)(ws + WS_MIX), (float*)(ws + WS_SSL)); }
        }
        if (isfast(ph)) { int hi = ph + 1; while (hi < NPHASE && isfast(hi) && !(hi == 2 && SUB2_MASK != 7u)) ++hi;
            p.ph_lo = ph; p.ph_hi = hi; p.li = li++; hipLaunchKernelGGL(fwd, dim3(grid), dim3(NWAVES * 64), LDS_BYTES, stream, p); ph = hi; continue; }
        switch (ph) {
        case 1: { F1 f{}; f.A = (bf16*)(ws + WS_XB); f.Bt = (bf16*)(ws + WS_W_IN); f.ss0 = (float*)(ws + WS_SS0); f.qkxy = QKXY; f.vt = (bf16*)(ws + WS_VT);
                  hipLaunchKernelGGL(ngemm<F1>, dim3(5120 / 64, NTOK / 64), dim3(256), 0, stream, f); } break;
        case 4: { F4 f{}; f.A = (bf16*)(ws + WS_MIX); f.Bt = (bf16*)(ws + WS_W_OUT); f.scl = (float*)(ws + WS_SCL); f.x = p.x; f.x1 = p.out; f.x1b = (bf16*)(ws + WS_X1B); f.ss1p = (float*)(ws + WS_SS1P);
                  hipLaunchKernelGGL(ngemm<F4>, dim3(DM / 64, NTOK / 64), dim3(256), 0, stream, f); } break;
        case 5: { F5 f{}; f.A = (bf16*)(ws + WS_X1B); f.Bt = (bf16*)(ws + WS_W_CQ); f.ss1p = (float*)(ws + WS_SS1P); f.cq = (bf16*)(ws + WS_CQ);
                  hipLaunchKernelGGL(ngemm<F5>, dim3(XW / 64, NTOK / 64), dim3(256), 0, stream, f); } break;
        case 6: hipLaunchKernelGGL(n_xattn, dim3(BATCH * XH * 8 * 2), dim3(256), 0, stream, (const bf16*)(ws + WS_CQ), (const bf16*)(ws + WS_CK), (const bf16*)(ws + WS_CVT), (bf16*)(ws + WS_OX)); break;
        case 7: { F7 f{}; f.A = (bf16*)(ws + WS_OX); f.Bt = (bf16*)(ws + WS_W_CO); f.x12 = p.out; f.x2b = (bf16*)(ws + WS_X2B);
                  hipLaunchKernelGGL(ngemm<F7>, dim3(DM / 64, NTOK / 64), dim3(256), 0, stream, f); } break;
        case 9: { hipLaunchKernelGGL(n_toff, dim3(1), dim3(64), 0, stream, (const int*)(ctl + CW_CNT), ctl + CW_TOFF);
                  F9 f{}; f.x2b = (bf16*)(ws + WS_X2B); f.wgu = (bf16*)(ws + WS_W_GU); f.toff = ctl + CW_TOFF; f.cnt = ctl + CW_CNT; f.list = (int*)(ws + WS_LIST); f.r2 = (float*)(ws + WS_R2); f.b_gu = p.b_gu; f.act = (bf16*)(ws + WS_ACT);
                  hipLaunchKernelGGL(ngemm<F9>, dim3(DFF / 32, NSLOT / 64), dim3(256), 0, stream, f); } break;
        case 10: { hipLaunchKernelGGL(n_toff, dim3(1), dim3(64), 0, stream, (const int*)(ctl + CW_CNT), ctl + CW_TOFF);
                  F10 f{}; f.act = (bf16*)(ws + WS_ACT); f.wdn = (bf16*)(ws + WS_W_DN); f.toff = ctl + CW_TOFF; f.b_dn = p.b_dn; f.y = (bf16*)(ws + WS_Y);
                  hipLaunchKernelGGL(ngemm<F10>, dim3(DM / 64, NSLOT / 64), dim3(256), 0, stream, f); } break;
        default: break;
        }
        ++ph;
    }
}
```

```cpp
#include <hip/hip_runtime.h>
#include <cstdio>
#include <cstdint>
#include <cmath>

#define GAS __attribute__((address_space(1)))
#define LAS __attribute__((address_space(3)))
typedef unsigned short bf16;
typedef unsigned v4u __attribute__((ext_vector_type(4)));
typedef unsigned v2u __attribute__((ext_vector_type(2)));
typedef float f32x4 __attribute__((ext_vector_type(4)));
typedef float f32x2 __attribute__((ext_vector_type(2)));
typedef float f32x16 __attribute__((ext_vector_type(16)));
typedef short bf16x8 __attribute__((ext_vector_type(8)));

constexpr int BATCH = 16, SEQ = 2048, DM = 2048, NTOK = BATCH * SEQ;
constexpr int CHUNK = 64, LEFTC = 8, AW = 1024, AH = 16, AHD = 64, MAXREL = 128, RELW = 2 * MAXREL + 1;
constexpr int LW = 1024, LB = 8, LBW = 128;
constexpr int MEML = 256, NMEM = BATCH * MEML, XH = 4, XHD = 128, XW = 512;
constexpr int NE = 32, TOPK = 4, DFF = 2048;
constexpr int NSLOT = NTOK * TOPK + NE * 256;
constexpr float EPS = 1e-6f, LOG2E = 1.4426950408889634f;
constexpr float QSCALE = 0.125f * LOG2E;
constexpr float CQSCALE = 0.08838834764831845f * LOG2E;
constexpr float SW_ALPHA = 1.702f, SW_LIMIT = 7.0f;

constexpr size_t MiB = 1u << 20;
constexpr size_t WS_CTL = 0, CTL_ZERO_BYTES = 1 * MiB;
constexpr size_t WS_W_IN = 2 * MiB, WS_W_OUT = 22 * MiB, WS_W_CQ = 30 * MiB, WS_W_CKV = 32 * MiB, WS_W_CO = 36 * MiB;
constexpr size_t WS_W_GA = 38 * MiB, WS_W_GX = WS_W_GA + 256 * 1024, WS_W_R = WS_W_GX + 256 * 1024;
constexpr size_t WS_SS0 = 39 * MiB, WS_SSM = WS_SS0 + 128 * 1024, WS_R2 = WS_SS0 + 256 * 1024;
constexpr size_t WS_SSA = 40 * MiB, WS_SSL = 42 * MiB, WS_SCL = 44 * MiB, WS_SS1P = 45 * MiB;
constexpr size_t WS_TOPE = 49 * MiB, WS_TOPG = WS_TOPE + 512 * 1024, WS_TPOS = 50 * MiB;
constexpr size_t WS_LIST = 51 * MiB, WS_CK = 55 * MiB, WS_CVT = 59 * MiB, WS_MEMB = 64 * MiB;
constexpr size_t WS_W_GU = 128 * MiB, WS_W_DN = 640 * MiB;
constexpr size_t WS_XB = 896 * MiB, WS_MIX = WS_XB;
constexpr size_t WS_QKXY = 1024 * MiB, WS_VT = 1280 * MiB, WS_X1B = 1344 * MiB, WS_CQ = 1472 * MiB, WS_OX = 1504 * MiB, WS_X2B = 1536 * MiB;
constexpr size_t WS_ACT = 1664 * MiB, WS_Y = 2208 * MiB, WS_NA = 2752 * MiB, WS_NB = 2880 * MiB, WS_END = 3008 * MiB;
constexpr int CW_CNT = 64;
constexpr int CW_TOFF = 128;
constexpr int CW_BAR = 4096;

struct P {
    const float *x, *mem, *g_mix, *w_in, *rel, *conv_w, *conv_b, *w_ga, *b_ga, *w_gx, *b_gx, *lam, *g_att, *g_lru, *w_out, *g_cross, *g_mem,
        *w_cq, *w_ckv, *w_co, *g_ffn, *w_r, *b_r, *w_gu, *b_gu, *w_dn, *b_dn, *g_fin;
    float* out; unsigned char* ws;
    int ph_lo, ph_hi, li, pad;
};

__device__ __forceinline__ float bf2f(bf16 b) { return __uint_as_float(((unsigned)b) << 16); }
__device__ __forceinline__ unsigned f2bf(float f) { unsigned u = __float_as_uint(f); return (u + 0x7fffu + ((u >> 16) & 1u)) >> 16; }
__device__ __forceinline__ unsigned pk2(float lo, float hi) { return f2bf(lo) | (f2bf(hi) << 16); }
constexpr float W8_SCALE = 64.0f, W8_INV = 1.0f / 64.0f;
__device__ __forceinline__ unsigned pk4_fp8(float a, float b, float c, float d) { int w = 0; w = __builtin_amdgcn_cvt_pk_fp8_f32(a, b, w, false); w = __builtin_amdgcn_cvt_pk_fp8_f32(c, d, w, true); return (unsigned)w; }
__device__ __forceinline__ float fp8_to_f(unsigned b) { const unsigned s = (b >> 7) & 1u, e = (b >> 3) & 15u, m = b & 7u; const float v = e ? ldexpf(1.0f + (float)m * 0.125f, (int)e - 7) : ldexpf((float)m * 0.125f, -6); return s ? -v : v; }
__device__ __forceinline__ float wave_sum(float v) {
#pragma unroll
    for (int o = 1; o < 64; o <<= 1) v += __shfl_xor(v, o);
    return v;
}
__device__ __forceinline__ float sigmoidf_(float x) { return 1.0f / (1.0f + __expf(-x)); }
__device__ __forceinline__ float gelu_tanh(float x) { const float u = 0.7978845608028654f * (x + 0.044715f * x * x * x); return 0.5f * x * (1.0f + tanhf(u)); }
__device__ __forceinline__ int find_expert(const int* toff, int tile) { int e = 0;
#pragma unroll 1
    for (int i = 1; i < NE; ++i) e += (tile >= toff[i]) ? 1 : 0;
    return e; }

template <class F>
__global__ void __launch_bounds__(256) ngemm(F f) {
    __shared__ float As[16][68], Bs[16][68];
    const int tx = threadIdx.x & 15, ty = threadIdx.x >> 4, bm = blockIdx.y, bn = blockIdx.x;
    if (!f.valid(bm)) return;
    const int lr = threadIdx.x >> 2, lk = (threadIdx.x & 3) * 4;
    const unsigned char* ap = (const unsigned char*)f.aptr(bm * 64 + lr);
    const unsigned char* bp = (const unsigned char*)f.bptr(bm, bn, lr);
    float acc[4][4];
#pragma unroll
    for (int i = 0; i < 4; ++i)
#pragma unroll
        for (int j = 0; j < 4; ++j) acc[i][j] = 0.f;
    for (int k0 = 0; k0 < F::K; k0 += 16) {
        f.mid(k0, bm, ty, acc);
        if constexpr (F::FP8) { const unsigned av = *(const unsigned*)(ap + k0 + lk), bv = *(const unsigned*)(bp + k0 + lk);
#pragma unroll
            for (int q = 0; q < 4; ++q) { As[lk + q][lr] = fp8_to_f((av >> (8 * q)) & 255u); Bs[lk + q][lr] = fp8_to_f((bv >> (8 * q)) & 255u) * W8_INV; } }
        else { const v2u av = *(const v2u*)(ap + 2 * (k0 + lk)), bv = *(const v2u*)(bp + 2 * (k0 + lk));
        As[lk + 0][lr] = __uint_as_float(av.x << 16); As[lk + 1][lr] = __uint_as_float(av.x & 0xffff0000u);
        As[lk + 2][lr] = __uint_as_float(av.y << 16); As[lk + 3][lr] = __uint_as_float(av.y & 0xffff0000u);
        Bs[lk + 0][lr] = __uint_as_float(bv.x << 16); Bs[lk + 1][lr] = __uint_as_float(bv.x & 0xffff0000u);
        Bs[lk + 2][lr] = __uint_as_float(bv.y << 16); Bs[lk + 3][lr] = __uint_as_float(bv.y & 0xffff0000u); }
        __syncthreads();
#pragma unroll
        for (int kk = 0; kk < 16; ++kk) {
            const f32x4 a = *(const f32x4*)&As[kk][ty * 4], b = *(const f32x4*)&Bs[kk][tx * 4];
#pragma unroll
            for (int i = 0; i < 4; ++i)
#pragma unroll
                for (int j = 0; j < 4; ++j) acc[i][j] += a[i] * b[j];
        }
        __syncthreads();
    }
    f.out(bm, bn, ty, tx, acc);
}
struct FBase { static constexpr bool FP8 = false;
    __device__ bool valid(int) const { return true; }
    __device__ void mid(int, int, int, float (&)[4][4]) const {}
};
struct F1 : FBase { static constexpr int K = 2048; const bf16* A; const bf16* Bt; const float* ss0; bf16* qkxy; bf16* vt;
    __device__ const bf16* aptr(int row) const { return A + (size_t)row * K; }
    __device__ const bf16* bptr(int, int bn, int j) const { return Bt + (size_t)(bn * 64 + j) * K; }
    __device__ void out(int bm, int bn, int ty, int tx, float (&acc)[4][4]) const {
        for (int i = 0; i < 4; ++i) { const int m = bm * 64 + ty * 4 + i; const float r0 = rsqrtf(ss0[m] * (1.0f / DM) + EPS);
            for (int j = 0; j < 4; ++j) { const int n = bn * 64 + tx * 4 + j, t = n >> 10, c = n & 1023; float v = acc[i][j] * r0;
                if (t == 2) vt[(size_t)c * NTOK + m] = (bf16)f2bf(v);
                else { const int slot = t < 2 ? t : t - 1; if (t == 0) v *= QSCALE; qkxy[(size_t)slot * NTOK * 1024 + (size_t)m * 1024 + c] = (bf16)f2bf(v); } } }
    }
};
struct F1b : FBase { static constexpr int K = 2048; const bf16* A; const bf16* Bt; const float* ssm; bf16* ck; bf16* cvt;
    __device__ const bf16* aptr(int row) const { return A + (size_t)row * K; }
    __device__ const bf16* bptr(int, int bn, int j) const { return Bt + (size_t)(bn * 64 + j) * K; }
    __device__ void out(int bm, int bn, int ty, int tx, float (&acc)[4][4]) const {
        for (int i = 0; i < 4; ++i) { const int m = bm * 64 + ty * 4 + i; const float r = rsqrtf(ssm[m] * (1.0f / DM) + EPS);
            for (int j = 0; j < 4; ++j) { const int n = bn * 64 + tx * 4 + j; const float v = acc[i][j] * r;
                if (n < XW) ck[(size_t)m * XW + n] = (bf16)f2bf(v); else cvt[(size_t)(n - XW) * NMEM + m] = (bf16)f2bf(v); } }
    }
};
struct F4 : FBase { static constexpr int K = 2048; const bf16* A; const bf16* Bt; const float* scl; const float* x; float* x1; bf16* x1b; float* ss1p;
    __device__ const bf16* aptr(int row) const { return A + (size_t)row * K; }
    __device__ const bf16* bptr(int, int bn, int j) const { return Bt + (size_t)(bn * 64 + j) * K; }
    __device__ void mid(int k0, int bm, int ty, float (&acc)[4][4]) const { if (k0 == 1024) { for (int i = 0; i < 4; ++i) { const float s = scl[2 * (bm * 64 + ty * 4 + i)]; for (int j = 0; j < 4; ++j) acc[i][j] *= s; } } }
    __device__ void out(int bm, int bn, int ty, int tx, float (&acc)[4][4]) const {
        for (int i = 0; i < 4; ++i) { const int m = bm * 64 + ty * 4 + i; const float s = scl[2 * m + 1]; float q = 0.f;
            for (int j = 0; j < 4; ++j) { const int n = bn * 64 + tx * 4 + j; const float v = x[(size_t)m * DM + n] + acc[i][j] * s; x1[(size_t)m * DM + n] = v; x1b[(size_t)m * DM + n] = (bf16)f2bf(v); q += v * v; }
            q += __shfl_xor(q, 1); q += __shfl_xor(q, 2); q += __shfl_xor(q, 4); q += __shfl_xor(q, 8);
            if (tx == 0) ss1p[(size_t)m * 32 + bn] = q; }
    }
};
struct F5 : FBase { static constexpr int K = 2048; const bf16* A; const bf16* Bt; const float* ss1p; bf16* cq;
    __device__ const bf16* aptr(int row) const { return A + (size_t)row * K; }
    __device__ const bf16* bptr(int, int bn, int j) const { return Bt + (size_t)(bn * 64 + j) * K; }
    __device__ void out(int bm, int bn, int ty, int tx, float (&acc)[4][4]) const {
        for (int i = 0; i < 4; ++i) { const int m = bm * 64 + ty * 4 + i; float q = 0.f; for (int p = 0; p < 32; ++p) q += ss1p[(size_t)m * 32 + p];
            const float r1 = rsqrtf(q * (1.0f / DM) + EPS) * CQSCALE;
            for (int j = 0; j < 4; ++j) { const int n = bn * 64 + tx * 4 + j; cq[(size_t)m * XW + n] = (bf16)f2bf(acc[i][j] * r1); } }
    }
};
struct F7 : FBase { static constexpr int K = 512; const bf16* A; const bf16* Bt; float* x12; unsigned char* x2b;
    __device__ const bf16* aptr(int row) const { return A + (size_t)row * K; }
    __device__ const bf16* bptr(int, int bn, int j) const { return Bt + (size_t)(bn * 64 + j) * K; }
    __device__ void out(int bm, int bn, int ty, int tx, float (&acc)[4][4]) const {
        for (int i = 0; i < 4; ++i) { const int m = bm * 64 + ty * 4 + i;
            for (int j = 0; j < 4; ++j) { const int n = bn * 64 + tx * 4 + j; const float v = x12[(size_t)m * DM + n] + acc[i][j]; x12[(size_t)m * DM + n] = v; x2b[(size_t)m * DM + n] = (unsigned char)(pk4_fp8(v, 0.f, 0.f, 0.f) & 255u); } }
    }
};
struct F9 { static constexpr int K = 2048; static constexpr bool FP8 = true; const unsigned char* x2b; const unsigned char* wgu; const int* toff; const int* cnt; const int* list; const float* r2; const float* b_gu; unsigned char* act;
    __device__ bool valid(int bm) const { return (bm >> 2) < toff[NE]; }
    __device__ void mid(int, int, int, float (&)[4][4]) const {}
    __device__ int tok_of(int slot, int& e) const { const int tile = slot >> 8; e = find_expert(toff, tile); const int pos = slot - 256 * toff[e]; return pos < cnt[e] ? list[e * NTOK + pos] : 0; }
    __device__ const unsigned char* aptr(int slot) const { int e; const int tok = tok_of(slot, e); return x2b + (size_t)tok * K; }
    __device__ const unsigned char* bptr(int bm, int bn, int j) const { const int e = find_expert(toff, bm >> 2); const int a = bn * 32 + (j >> 2) * 2 + (j & 1), up = (j >> 1) & 1;
        const int row = 256 * (a >> 7) + (a & 127) + 128 * up; return wgu + ((size_t)e * 4096 + row) * K; }
    __device__ void out(int bm, int bn, int ty, int tx, float (&acc)[4][4]) const {
        for (int i = 0; i < 4; ++i) { const int slot = bm * 64 + ty * 4 + i; int e; const int tok = tok_of(slot, e); const float r = r2[tok];
            for (int j = 0; j < 2; ++j) { const int a = bn * 32 + tx * 2 + j;
                float g = acc[i][j] * r + b_gu[e * 4096 + a], u = acc[i][2 + j] * r + b_gu[e * 4096 + 2048 + a];
                g = fminf(g, SW_LIMIT); u = fminf(fmaxf(u, -SW_LIMIT), SW_LIMIT);
                act[(size_t)slot * DFF + a] = (unsigned char)(pk4_fp8((u + 1.0f) * g * sigmoidf_(SW_ALPHA * g), 0.f, 0.f, 0.f) & 255u); } }
    }
};
struct F10 { static constexpr int K = 2048; static constexpr bool FP8 = true; const unsigned char* act; const unsigned char* wdn; const int* toff; const float* b_dn; bf16* y;
    __device__ bool valid(int bm) const { return (bm >> 2) < toff[NE]; }
    __device__ void mid(int, int, int, float (&)[4][4]) const {}
    __device__ const unsigned char* aptr(int slot) const { return act + (size_t)slot * K; }
    __device__ const unsigned char* bptr(int bm, int bn, int j) const { const int e = find_expert(toff, bm >> 2); return wdn + ((size_t)e * DM + bn * 64 + j) * K; }
    __device__ void out(int bm, int bn, int ty, int tx, float (&acc)[4][4]) const { const int e = find_expert(toff, bm >> 2);
        for (int i = 0; i < 4; ++i) { const int slot = bm * 64 + ty * 4 + i;
            for (int j = 0; j < 4; ++j) { const int n = bn * 64 + tx * 4 + j; y[(size_t)slot * DM + n] = (bf16)f2bf(acc[i][j] + b_dn[e * DM + n]); } }
    }
};

__global__ void __launch_bounds__(256) n_attn(const bf16* __restrict__ qkxy, const bf16* __restrict__ vt, const float* __restrict__ rel, bf16* mix, float* ssa) {
    const int blk = blockIdx.x, tq = (blk & 7) * 256 + threadIdx.x, bh = blk >> 3, h = bh & 15, b = bh >> 4;
    const size_t m = (size_t)b * SEQ + tq;
    const bf16* Q = qkxy; const bf16* Kp = qkxy + (size_t)NTOK * 1024;
    float q[64], o[64];
#pragma unroll
    for (int d = 0; d < 64; ++d) { q[d] = bf2f(Q[m * 1024 + h * 64 + d]); o[d] = 0.f; }
    float mx = -INFINITY, l = 0.f;
    const int c = tq >> 6, k0 = (c > LEFTC ? c - LEFTC : 0) * 64, k1 = (c + 1) * 64;
    const float* tab = rel + h * RELW;
    for (int key = k0; key < k1; ++key) {
        const bf16* kr = Kp + ((size_t)b * SEQ + key) * 1024 + h * 64;
        float s = 0.f;
#pragma unroll
        for (int d = 0; d < 64; ++d) s += q[d] * bf2f(kr[d]);
        int r = tq - key; r = (r < -MAXREL ? -MAXREL : (r > MAXREL ? MAXREL : r)) + MAXREL;
        s += tab[r] * LOG2E;
        const float mn = fmaxf(mx, s), corr = exp2f(mx - mn), pe = exp2f(s - mn);
        l = l * corr + pe;
        const bf16* vp = vt + (size_t)(h * 64) * NTOK + (size_t)b * SEQ + key;
#pragma unroll
        for (int d = 0; d < 64; ++d) o[d] = o[d] * corr + pe * bf2f(vp[(size_t)d * NTOK]);
        mx = mn;
    }
    const float il = 1.0f / l; float ss = 0.f;
#pragma unroll
    for (int d = 0; d < 64; ++d) { const float v = o[d] * il; ss += v * v; mix[m * DM + h * 64 + d] = (bf16)f2bf(v); }
    ssa[m * 16 + h] = ss;
}
__global__ void __launch_bounds__(256) n_xattn(const bf16* __restrict__ cq, const bf16* __restrict__ ck, const bf16* __restrict__ cvt, bf16* ox) {
    const int blk = blockIdx.x, dh = blk & 1, tq = ((blk >> 1) & 7) * 256 + threadIdx.x, bh = blk >> 4, h = bh & 3, b = bh >> 2;
    const size_t m = (size_t)b * SEQ + tq;
    float q[128], o[64];
#pragma unroll
    for (int d = 0; d < 128; ++d) q[d] = bf2f(cq[m * XW + h * XHD + d]);
#pragma unroll
    for (int d = 0; d < 64; ++d) o[d] = 0.f;
    float mx = -INFINITY, l = 0.f;
    for (int key = 0; key < MEML; ++key) {
        const bf16* kr = ck + ((size_t)b * MEML + key) * XW + h * XHD;
        float s = 0.f;
#pragma unroll
        for (int d = 0; d < 128; ++d) s += q[d] * bf2f(kr[d]);
        const float mn = fmaxf(mx, s), corr = exp2f(mx - mn), pe = exp2f(s - mn);
        l = l * corr + pe;
        const bf16* vp = cvt + (size_t)(h * XHD + dh * 64) * NMEM + (size_t)b * MEML + key;
#pragma unroll
        for (int d = 0; d < 64; ++d) o[d] = o[d] * corr + pe * bf2f(vp[(size_t)d * NMEM]);
        mx = mn;
    }
    const float il = 1.0f / l;
#pragma unroll
    for (int d = 0; d < 64; ++d) ox[m * XW + h * XHD + dh * 64 + d] = (bf16)f2bf(o[d] * il);
}
__global__ void __launch_bounds__(256) n_lru_a(const bf16* __restrict__ xr, const float* __restrict__ conv_w, const float* __restrict__ conv_b, const bf16* __restrict__ wga_t, const float* __restrict__ b_ga,
                                              const bf16* __restrict__ wgx_t, const float* __restrict__ b_gx, const float* __restrict__ lam, float* na, float* nb) {
    const size_t idx = (size_t)blockIdx.x * 256 + threadIdx.x; const int c = (int)(idx & 1023); const size_t m = idx >> 10; const int t = (int)(m & (SEQ - 1)), n = c >> 7, d = c & 127;
    float rp = b_ga[c], ip = b_gx[c], xown = 0.f;
    const bf16* wa = wga_t + (size_t)(n * 128 + d) * 128; const bf16* wx = wgx_t + (size_t)(n * 128 + d) * 128;
    for (int cp = 0; cp < 128; ++cp) { const int cc = n * 128 + cp; float xc = conv_b[cc];
#pragma unroll
        for (int j = 0; j < 4; ++j) { const int tt = t - 3 + j; if (tt >= 0) xc += conv_w[j * LW + cc] * bf2f(xr[(m - 3 + j) * 1024 + cc]); }
        rp += xc * bf2f(wa[cp]); ip += xc * bf2f(wx[cp]); if (cp == d) xown = xc; }
    const float r = sigmoidf_(rp), ig = sigmoidf_(ip);
    const float la = -8.0f * r * log1pf(__expf(-lam[c]));
    na[idx] = __expf(la); nb[idx] = sqrtf(-expm1f(2.0f * la)) * (ig * xown);
}
__global__ void __launch_bounds__(64) n_lru_b(const float* __restrict__ na, const float* __restrict__ nb, const bf16* __restrict__ yg, bf16* mix, float* ssl) {
    const int b = blockIdx.x >> 4, g = blockIdx.x & 15, c = g * 64 + threadIdx.x; float h = 0.f;
    for (int t = 0; t < SEQ; ++t) { const size_t m = (size_t)b * SEQ + t; h = na[m * 1024 + c] * h + nb[m * 1024 + c];
        const float y = h * gelu_tanh(bf2f(yg[m * 1024 + c])); mix[m * DM + 1024 + c] = (bf16)f2bf(y);
        const float s = wave_sum(y * y); if (threadIdx.x == 0) ssl[m * 16 + g] = s; }
}
__global__ void n_toff(const int* cnt, int* toff) { if (threadIdx.x == 0 && blockIdx.x == 0) { int a = 0; for (int e = 0; e < NE; ++e) { toff[e] = a; a += (cnt[e] + 255) >> 8; } toff[NE] = a; } }

#define XB_TMO      128
#define XB_XCNT(j)  (256  + 64 * (j))
#define XB_XSUB(j)  (1280 + 64 * (j))
#define XB_XGEN(j)  (2304 + 64 * (j))
#define XB_TOP      3328
#define XB_TOPGEN   3392
#define XCD_BAR_WORDS 3456
#define XB_SPIN_CAP (1u << 18)
__device__ __forceinline__ unsigned xb_ld(unsigned* p)              { return __hip_atomic_load(p, __ATOMIC_RELAXED, __HIP_MEMORY_SCOPE_AGENT); }
__device__ __forceinline__ unsigned xb_add(unsigned* p, unsigned v) { return __hip_atomic_fetch_add(p, v, __ATOMIC_RELAXED, __HIP_MEMORY_SCOPE_AGENT); }
__device__ __forceinline__ unsigned xb_xcc_id() { return (unsigned)__builtin_amdgcn_s_getreg((3 << 11) | 20) & 0xFu; }
#define XB_SPIN(cond, bar) do { unsigned _sp = 0; while (cond) { __builtin_amdgcn_s_sleep(1); \
    if ((++_sp & 255u) == 0u) { if (xb_ld(&(bar)[XB_TMO])) break; if (_sp > XB_SPIN_CAP) { atomicAdd(&(bar)[XB_TMO], 1u); break; } } } } while (0)
struct XcdBarrier { unsigned* bar; unsigned x; volatile LAS unsigned* st; };
__device__ __forceinline__ XcdBarrier xcd_barrier_post(unsigned* bar, volatile LAS unsigned* st) {
    XcdBarrier b; b.bar = bar; b.x = xb_xcc_id(); b.st = st;
    if (threadIdx.x == 0) (void)xb_add(&bar[XB_XCNT(b.x)], 1u);
    return b;
}
__device__ __forceinline__ void xcd_barrier_complete(unsigned* bar, unsigned x, unsigned& nloc, unsigned& nx) {
    const unsigned G = gridDim.x * gridDim.y * gridDim.z;
    unsigned sum, cnt, mine, sp = 0u;
    for (;;) {
        sum = 0u; cnt = 0u; mine = 0u;
#pragma unroll
        for (unsigned j = 0; j < 16; ++j) { const unsigned c = xb_ld(&bar[XB_XCNT(j)]); sum += c; cnt += (c > 0u) ? 1u : 0u; mine = (j == x) ? c : mine; }
        if (sum == G) break;
        __builtin_amdgcn_s_sleep(1);
        if ((++sp & 255u) == 0u) { if (xb_ld(&bar[XB_TMO])) break; if (sp > XB_SPIN_CAP) { atomicAdd(&bar[XB_TMO], 1u); break; } }
    }
    nloc = mine > 0u ? mine : 1u; nx = cnt > 0u ? cnt : 1u;
}
__device__ __forceinline__ void xcd_barrier(const XcdBarrier& b) {
    asm volatile("s_waitcnt vmcnt(0)" ::: "memory");
    __syncthreads();
    if (threadIdx.x == 0) {
        unsigned* bar = b.bar;
        __builtin_amdgcn_s_waitcnt(0);
        unsigned nloc = b.st[0], nx = b.st[1];
        if (nloc == 0u) { xcd_barrier_complete(bar, b.x, nloc, nx); b.st[0] = nloc; b.st[1] = nx; }
        const unsigned old = xb_add(&bar[XB_XSUB(b.x)], 1u);
        const unsigned gen = old / nloc;
        if (old + 1u == (gen + 1u) * nloc) {
            __builtin_amdgcn_fence(__ATOMIC_RELEASE, "agent");
            asm volatile("s_waitcnt vmcnt(0)" ::: "memory");
            const unsigned og = xb_add(&bar[XB_TOP], 1u);
            const unsigned tg = og / nx;
            if (og + 1u == (tg + 1u) * nx) xb_add(&bar[XB_TOPGEN], 1u);
            else XB_SPIN(xb_ld(&bar[XB_TOPGEN]) == tg, bar);
            __builtin_amdgcn_fence(__ATOMIC_ACQUIRE, "agent");
            xb_add(&bar[XB_XGEN(b.x)], 1u);
            asm volatile("s_waitcnt vmcnt(0)" ::: "memory");
        } else {
            XB_SPIN(xb_ld(&bar[XB_XGEN(b.x)]) == gen, bar);
            __builtin_amdgcn_fence(__ATOMIC_ACQUIRE, "agent");
            asm volatile("s_waitcnt vmcnt(0)" ::: "memory");
        }
    }
    __syncthreads();
}

namespace pg8 {
constexpr int BM = 256, BK = 64, HALF = 128, HTB = HALF * BK * 2, STAGE_BYTES = 8 * HTB;
__host__ __device__ __forceinline__ int lds_byte(int r, int c) { const int st = (r >> 4) * 2 + (c >> 5), rr = r & 15, cc = c & 31, ob = rr * 64 + cc * 2; return st * 1024 + (ob ^ (((ob >> 9) & 1) << 5)); }
__host__ __device__ __forceinline__ void stage_rc(int b, int& R, int& C) { const int st = b / 1024, sb = b % 1024, swz = sb ^ (((sb >> 9) & 1) << 5); R = (st >> 1) * 16 + swz / 64; C = (st & 1) * 32 + (swz % 64) / 2; }
__host__ __device__ __forceinline__ int perm32(int rho) { const int n = rho >> 4, i = rho & 15; return 8 * (i >> 2) + 4 * n + (i & 3); }
__device__ __forceinline__ unsigned cvt_pk_bf16(float lo, float hi) { unsigned r; asm volatile("v_cvt_pk_bf16_f32 %0, %1, %2" : "=v"(r) : "v"(lo), "v"(hi)); return r; }
struct Unit { const char* a; const char* b; int pm, pn, e, tl; };
typedef f32x4 Acc[2][2][4][2];
typedef int v8i __attribute__((ext_vector_type(8)));
__device__ __forceinline__ v8i cat8(const bf16x8 lo, const bf16x8 hi) { const v4u a = __builtin_bit_cast(v4u, lo), b = __builtin_bit_cast(v4u, hi); return (v8i){(int)a.x, (int)a.y, (int)a.z, (int)a.w, (int)b.x, (int)b.y, (int)b.z, (int)b.w}; }
template <class Epi, class Sched>
__device__ __forceinline__ void gemm_phase(LAS unsigned char* lds, const int KB  , const Sched& S, const Epi& E) {
    const int tid = threadIdx.x, wid = __builtin_amdgcn_readfirstlane(tid >> 6), lane = tid & 63, wr = wid >> 2, wc = wid & 3, fr = lane & 15, fq = lane >> 4;
    const int nt = KB / 128;
    unsigned voffA[2], voffB[2];
#pragma unroll
    for (int i = 0; i < 2; ++i) { int R, C; stage_rc(tid * 16 + i * 8192, R, C); const int Rb = Epi::PERM ? ((R & ~31) + perm32(R & 31)) : R;
        voffA[i] = Sched::GATHER ? (unsigned)(C * 2) : (unsigned)(R * KB + C * 2); voffB[i] = (unsigned)(Rb * KB + C * 2); }
    const size_t kstep = (size_t)(BK * 2);
    const size_t hstep = (size_t)HALF * KB;
    const unsigned ldsw = (unsigned)wid * 1024u;
    const int aoff = lds_byte(wr * 64 + fr, fq * 8), boff = lds_byte(wc * 32 + fr, fq * 8);
#define PG8_SA(b, h) (((b) * 2 + (h)) * HTB)
#define PG8_SB(b, h) ((4 + (b) * 2 + (h)) * HTB)
#define PG8_STAGE(bufoff, gbase, voff) do { _Pragma("unroll") for (int _i = 0; _i < 2; ++_i) { unsigned _vo = (voff)[_i]; asm volatile("" : "+v"(_vo)); \
        __builtin_amdgcn_global_load_lds((const unsigned*)((const char*)(gbase) + _vo), (LAS unsigned*)(lds + (bufoff) + ldsw + _i * 8192), 16, 0, 0); } } while (0)
#define PG8_STAGE_A(bufoff, gbase, h, go) do { if constexpr (Sched::GATHER) { PG8_STAGE(bufoff, gbase, go[h]); } else { PG8_STAGE(bufoff, (gbase) + (h) * hstep, voffA); } } while (0)
#define PG8_LDA(dst, b, h) do { _Pragma("unroll") for (int m = 0; m < 4; ++m) _Pragma("unroll") for (int k = 0; k < 2; ++k) dst[m][k] = *(const LAS bf16x8*)(lds + PG8_SA(b, h) + aoff + m * 2048 + k * 1024); } while (0)
#define PG8_LDB(dst, b, h) do { _Pragma("unroll") for (int n = 0; n < 2; ++n) _Pragma("unroll") for (int k = 0; k < 2; ++k) dst[n][k] = *(const LAS bf16x8*)(lds + PG8_SB(b, h) + boff + n * 2048 + k * 1024); } while (0)
#define PG8_MMA(ai, bj, At, Bt) do { __builtin_amdgcn_s_setprio(1); _Pragma("unroll") for (int m = 0; m < 4; ++m) _Pragma("unroll") for (int n = 0; n < 2; ++n) { \
        if constexpr (Sched::FP8) acc[ai][bj][m][n] = __builtin_amdgcn_mfma_scale_f32_16x16x128_f8f6f4(cat8(Bt[n][0], Bt[n][1]), cat8(At[m][0], At[m][1]), acc[ai][bj][m][n], 0, 0, 0, 0x7C7C7C7C, 0, 0x7C7C7C7C);     \
        else { _Pragma("unroll") for (int k = 0; k < 2; ++k) acc[ai][bj][m][n] = __builtin_amdgcn_mfma_f32_16x16x32_bf16(Bt[n][k], At[m][k], acc[ai][bj][m][n], 0, 0, 0); } } __builtin_amdgcn_s_setprio(0); } while (0)
#define PG8_WAIT_V(n) asm volatile("s_waitcnt vmcnt(" #n ")" ::: "memory")
#define PG8_WAIT_L(n) asm volatile("s_waitcnt lgkmcnt(" #n ")" ::: "memory")
#define PG8_BAR __builtin_amdgcn_s_barrier()
#define PG8_SCHED __builtin_amdgcn_sched_barrier(0)
    Unit cur, nxt; int ui = 0;
    if (!S.next(0, cur)) return;
    Acc acc;
#pragma unroll
    for (int a = 0; a < 2; ++a)
#pragma unroll
        for (int b = 0; b < 2; ++b)
#pragma unroll
            for (int m = 0; m < 4; ++m)
#pragma unroll
                for (int n = 0; n < 2; ++n) acc[a][b][m][n] = (f32x4){0.f, 0.f, 0.f, 0.f};
    bf16x8 At[4][2], B0[2][2], B1[2][2];
    const char* cA = cur.a; const char* cB = cur.b;
    unsigned gc[2][2], gn[2][2];
    if constexpr (Sched::GATHER) { S.gather(cur, voffA, gc); }
    PG8_STAGE(PG8_SB(0, 0), cB, voffB); PG8_STAGE(PG8_SB(0, 1), cB + hstep, voffB); PG8_STAGE_A(PG8_SA(0, 0), cA, 0, gc); PG8_STAGE_A(PG8_SA(0, 1), cA, 1, gc);
    if (wr == 1) PG8_BAR;
    PG8_WAIT_V(2); PG8_BAR;
    PG8_STAGE(PG8_SB(1, 0), cB + kstep, voffB); PG8_STAGE_A(PG8_SA(1, 0), cA + kstep, 0, gc); PG8_STAGE(PG8_SB(1, 1), cB + hstep + kstep, voffB);
    PG8_WAIT_V(6); PG8_BAR;
    for (;;) {
        const bool has_next = S.next(ui + 1, nxt);
        const char* nA = has_next ? nxt.a : cA; const char* nB = has_next ? nxt.b : cB;
        if constexpr (Sched::GATHER) { if (has_next) S.gather(nxt, voffA, gn); else {
#pragma unroll
            for (int h = 0; h < 2; ++h)
#pragma unroll
                for (int i = 0; i < 2; ++i) gn[h][i] = gc[h][i]; } }
        for (int t = 0; t < nt; t += 2) {
            const bool last = (t == nt - 2);
            if constexpr (Epi::MIDK) { if (t == nt / 2) { int fr_e = fr; asm volatile("" : "+v"(fr_e)); E.midk(acc, cur, wr, fr_e); } }
            const char* a1 = cA + (size_t)(t + 1) * kstep;
            const char* a2 = last ? nA : cA + (size_t)(t + 2) * kstep; const char* b2 = last ? nB : cB + (size_t)(t + 2) * kstep;
            const char* a3 = a2 + kstep; const char* b3 = b2 + kstep;
            PG8_LDB(B0, 0, 0); PG8_LDB(B1, 0, 1); PG8_SCHED; PG8_LDA(At, 0, 0); PG8_STAGE_A(PG8_SA(1, 1), a1, 1, gc);
            if constexpr (Sched::GATHER) { if (last) {
#pragma unroll
                for (int h = 0; h < 2; ++h)
#pragma unroll
                    for (int i = 0; i < 2; ++i) gc[h][i] = gn[h][i]; } }
            PG8_WAIT_V(8); PG8_WAIT_L(0); PG8_BAR; PG8_MMA(0, 0, At, B0); PG8_MMA(0, 1, At, B1); PG8_BAR; PG8_SCHED;
            PG8_LDA(At, 0, 1); PG8_STAGE(PG8_SB(0, 0), b2, voffB); PG8_STAGE(PG8_SB(0, 1), b2 + hstep, voffB); PG8_STAGE_A(PG8_SA(0, 0), a2, 0, gc);
            PG8_WAIT_V(8); PG8_WAIT_L(0); PG8_BAR; PG8_MMA(1, 0, At, B0); PG8_MMA(1, 1, At, B1); PG8_BAR; PG8_SCHED;
            PG8_LDB(B0, 1, 0); PG8_LDB(B1, 1, 1); PG8_SCHED; PG8_LDA(At, 1, 0); PG8_STAGE_A(PG8_SA(0, 1), a2, 1, gc);
            PG8_WAIT_V(8); PG8_WAIT_L(0); PG8_BAR; PG8_MMA(0, 0, At, B0); PG8_MMA(0, 1, At, B1); PG8_BAR; PG8_SCHED;
            PG8_LDA(At, 1, 1); PG8_STAGE(PG8_SB(1, 0), b3, voffB); PG8_STAGE(PG8_SB(1, 1), b3 + hstep, voffB); PG8_STAGE_A(PG8_SA(1, 0), a3, 0, gc);
            PG8_WAIT_V(8); PG8_WAIT_L(0); PG8_BAR; PG8_MMA(1, 0, At, B0); PG8_MMA(1, 1, At, B1); PG8_BAR; PG8_SCHED;
        }
        if (wr == 0) PG8_BAR;
        { int fr_e = fr, fq_e = fq; asm volatile("" : "+v"(fr_e), "+v"(fq_e));
          E(acc, cur, wr, wc, fr_e, fq_e); }
        if (!has_next) break;
#pragma unroll
        for (int a = 0; a < 2; ++a)
#pragma unroll
            for (int b = 0; b < 2; ++b)
#pragma unroll
                for (int m = 0; m < 4; ++m)
#pragma unroll
                    for (int n = 0; n < 2; ++n) acc[a][b][m][n] = (f32x4){0.f, 0.f, 0.f, 0.f};
        cur = nxt; cA = nA; cB = nB; ++ui;
        if (wr == 1) PG8_BAR;
    }
    PG8_WAIT_V(0);
    PG8_BAR;
#undef PG8_SA
#undef PG8_SB
#undef PG8_STAGE
#undef PG8_STAGE_A
#undef PG8_LDA
#undef PG8_LDB
#undef PG8_MMA
#undef PG8_WAIT_V
#undef PG8_WAIT_L
#undef PG8_BAR
#undef PG8_SCHED
}
}

namespace pg8 {
__device__ __forceinline__ void tile_of(int L, int nM, int nN, int& pm, int& pn) {
    const int nwg = nM * nN; int wgid = L; { const int q = nwg / 8, r = nwg % 8, xcd = wgid % 8, off = wgid / 8; wgid = (xcd < r ? xcd * (q + 1) : r * (q + 1) + (xcd - r) * q) + off; }
    const int nig = 8 * nN, gid = wgid / nig, fm = gid * 8, gsz = (nM - fm) < 8 ? (nM - fm) : 8;
    pm = fm + ((wgid % nig) % gsz); pn = (wgid % nig) / gsz;
}
struct SchedReg { static constexpr bool GATHER = false, FP8 = false;
    const char* A; const char* Bt; int nM, nN, G, c, rowbytes, bskip_from, bskip_rows;
    __device__ __forceinline__ bool next(int i, Unit& u) const { const int L = i * G + c; if (L >= nM * nN) return false; tile_of(L, nM, nN, u.pm, u.pn); u.e = 0; u.tl = 0;
        u.a = A + (size_t)u.pm * 256 * rowbytes; const int brow = u.pn * 256 + (u.pn >= bskip_from ? bskip_rows : 0); u.b = Bt + (size_t)brow * rowbytes; return true; }
    __device__ __forceinline__ void gather(const Unit&, const unsigned (&)[2], unsigned (&)[2][2]) const {}
};
template <bool G_> struct SchedMoE { static constexpr bool GATHER = G_, FP8 = true;
    const LAS int* toff; const LAS int* cnt; const int* list; const char* A; const char* Bt; int npn, brows, G, c;
    __device__ __forceinline__ bool next(int i, Unit& u) const { const int L = i * G + c; if (L >= toff[NE] * npn) return false;
        int e = 0;
#pragma unroll 1
        for (int j = 1; j < NE; ++j) e += (L >= toff[j] * npn) ? 1 : 0;
        const int t0 = toff[e], ne = toff[e + 1] - t0, Ll = L - t0 * npn, pn = Ll / ne, tl = Ll - pn * ne;
        u.pm = t0 + tl; u.pn = pn; u.e = e; u.tl = tl; u.a = GATHER ? A : A + (size_t)u.pm * 256 * 2048; u.b = Bt + ((size_t)e * brows + pn * 256) * 2048; return true; }
    __device__ __forceinline__ void gather(const Unit& u, const unsigned (&voffA)[2], unsigned (&g)[2][2]) const {
        const int ce = cnt[u.e];
#pragma unroll
        for (int i = 0; i < 2; ++i) { int R, C; stage_rc((int)threadIdx.x * 16 + i * 8192, R, C);
#pragma unroll
            for (int h = 0; h < 2; ++h) { const int pos = u.tl * 256 + h * 128 + R; const int tok = pos < ce ? list[(size_t)u.e * NTOK + pos] : 0; g[h][i] = (unsigned)tok * 2048u + voffA[i]; } }
    }
};
#define EPI_ROWS(ai, m) (u.pm * 256 + (ai) * 128 + wr * 64 + (m) * 16 + fr)
__device__ __forceinline__ v4u pack8(const f32x4 a, const f32x4 b) { v4u w; w.x = cvt_pk_bf16(a[0], a[1]); w.y = cvt_pk_bf16(a[2], a[3]); w.z = cvt_pk_bf16(b[0], b[1]); w.w = cvt_pk_bf16(b[2], b[3]); return w; }
struct EpiRowScale { static constexpr bool PERM = true, MIDK = false; const float* ss; bf16* out; int ld, split_cols; size_t split_stride; float mul0;
    __device__ __forceinline__ void operator()(const Acc& acc, const Unit& u, int wr, int wc, int fr, int fq) const {
        int colt = u.pn * 256; bf16* base = out; float mul = mul0;
        if (split_cols) { const int t = colt / split_cols; base += (size_t)t * split_stride; colt -= t * split_cols; mul = t == 0 ? mul0 : 1.0f; }
        const int col0 = colt + wc * 32 + 8 * fq;
#pragma unroll
        for (int ai = 0; ai < 2; ++ai)
#pragma unroll
            for (int m = 0; m < 4; ++m) { const int row = EPI_ROWS(ai, m); const float r = rsqrtf(ss[row] * (1.0f / DM) + EPS) * mul; bf16* rowp = base + (size_t)row * ld + col0;
#pragma unroll
                for (int bj = 0; bj < 2; ++bj) *(v4u*)(rowp + bj * 128) = pack8(acc[ai][bj][m][0] * r, acc[ai][bj][m][1] * r); }
    }
};
struct EpiColScale { static constexpr bool PERM = true, MIDK = false; const float* ss; bf16* out; size_t ld;
    __device__ __forceinline__ void operator()(const Acc& acc, const Unit& u, int wr, int wc, int fr, int fq) const {
#pragma unroll
        for (int bj = 0; bj < 2; ++bj) { const int c0 = u.pn * 256 + bj * 128 + wc * 32 + 8 * fq; f32x4 s0 = *(const f32x4*)(ss + c0), s1 = *(const f32x4*)(ss + c0 + 4);
#pragma unroll
            for (int j = 0; j < 4; ++j) { s0[j] = rsqrtf(s0[j] * (1.0f / DM) + EPS); s1[j] = rsqrtf(s1[j] * (1.0f / DM) + EPS); }
#pragma unroll
            for (int ai = 0; ai < 2; ++ai)
#pragma unroll
                for (int m = 0; m < 4; ++m) { const int row = EPI_ROWS(ai, m); *(v4u*)(out + (size_t)row * ld + c0) = pack8(acc[ai][bj][m][0] * s0, acc[ai][bj][m][1] * s1); } }
    }
};
struct EpiX1 { static constexpr bool PERM = true, MIDK = true; const float* scl; const float* x; float* x1; bf16* x1b; float* ss1p;
    __device__ __forceinline__ void midk(Acc& acc, const Unit& u, int wr, int fr) const {
#pragma unroll
        for (int ai = 0; ai < 2; ++ai)
#pragma unroll
            for (int m = 0; m < 4; ++m) { const float s = scl[2 * (size_t)EPI_ROWS(ai, m)];
#pragma unroll
                for (int bj = 0; bj < 2; ++bj) { acc[ai][bj][m][0] *= s; acc[ai][bj][m][1] *= s; } }
    }
    __device__ __forceinline__ void operator()(const Acc& acc, const Unit& u, int wr, int wc, int fr, int fq) const {
        const int col0 = u.pn * 256 + wc * 32 + 8 * fq;
#pragma unroll
        for (int ai = 0; ai < 2; ++ai)
#pragma unroll
            for (int m = 0; m < 4; ++m) { const int row = EPI_ROWS(ai, m); const float s = scl[2 * (size_t)row + 1]; const size_t off = (size_t)row * DM + col0; float q = 0.f;
#pragma unroll
                for (int bj = 0; bj < 2; ++bj) { const f32x4 xa = *(const f32x4*)(x + off + bj * 128), xb = *(const f32x4*)(x + off + bj * 128 + 4);
                    const f32x4 v0 = xa + acc[ai][bj][m][0] * s, v1 = xb + acc[ai][bj][m][1] * s;
                    *(f32x4*)(x1 + off + bj * 128) = v0; *(f32x4*)(x1 + off + bj * 128 + 4) = v1; *(v4u*)(x1b + off + bj * 128) = pack8(v0, v1);
                    q += (v0[0] * v0[0] + v0[1] * v0[1]) + (v0[2] * v0[2] + v0[3] * v0[3]) + (v1[0] * v1[0] + v1[1] * v1[1]) + (v1[2] * v1[2] + v1[3] * v1[3]); }
                q += __shfl_xor(q, 16); q += __shfl_xor(q, 32);
                if (fq == 0) ss1p[(size_t)row * 32 + u.pn * 4 + wc] = q; }
    }
};
struct EpiCQ { static constexpr bool PERM = true, MIDK = false; const float* ss1p; bf16* cq;
    __device__ __forceinline__ void operator()(const Acc& acc, const Unit& u, int wr, int wc, int fr, int fq) const {
        const int col0 = u.pn * 256 + wc * 32 + 8 * fq;
#pragma unroll
        for (int ai = 0; ai < 2; ++ai)
#pragma unroll
            for (int m = 0; m < 4; ++m) { const int row = EPI_ROWS(ai, m); const f32x4* sp = (const f32x4*)(ss1p + (size_t)row * 32); f32x4 t = sp[0];
#pragma unroll
                for (int j = 1; j < 8; ++j) t += sp[j];
                const float r = rsqrtf(((t[0] + t[1]) + (t[2] + t[3])) * (1.0f / DM) + EPS) * CQSCALE;
#pragma unroll
                for (int bj = 0; bj < 2; ++bj) *(v4u*)(cq + (size_t)row * XW + col0 + bj * 128) = pack8(acc[ai][bj][m][0] * r, acc[ai][bj][m][1] * r); }
    }
};
struct EpiX2 { static constexpr bool PERM = true, MIDK = false; float* x12; unsigned char* x2b;
    __device__ __forceinline__ void operator()(const Acc& acc, const Unit& u, int wr, int wc, int fr, int fq) const {
        const int col0 = u.pn * 256 + wc * 32 + 8 * fq;
#pragma unroll
        for (int ai = 0; ai < 2; ++ai)
#pragma unroll
            for (int m = 0; m < 4; ++m) { const size_t off = (size_t)EPI_ROWS(ai, m) * DM + col0;
#pragma unroll
                for (int bj = 0; bj < 2; ++bj) { const f32x4 v0 = *(const f32x4*)(x12 + off + bj * 128) + acc[ai][bj][m][0], v1 = *(const f32x4*)(x12 + off + bj * 128 + 4) + acc[ai][bj][m][1];
                    *(f32x4*)(x12 + off + bj * 128) = v0; *(f32x4*)(x12 + off + bj * 128 + 4) = v1; v2u w; w.x = pk4_fp8(v0[0], v0[1], v0[2], v0[3]); w.y = pk4_fp8(v1[0], v1[1], v1[2], v1[3]); *(v2u*)(x2b + off + bj * 128) = w; } }
    }
};
struct EpiAct { static constexpr bool PERM = true, MIDK = false; const LAS int* cnt; const int* list; const float* r2; const float* b_gu; unsigned char* act;
    __device__ __forceinline__ void operator()(const Acc& acc, const Unit& u, int wr, int wc, int fr, int fq) const {
        const int cb = u.pn * 128 + wc * 32 + 8 * fq, ce = cnt[u.e];
        const float* bg = b_gu + (size_t)u.e * 4096 + cb;
        const f32x4 bg0 = *(const f32x4*)bg, bg1 = *(const f32x4*)(bg + 4), bu0 = *(const f32x4*)(bg + 2048), bu1 = *(const f32x4*)(bg + 2052);
#pragma unroll
        for (int ai = 0; ai < 2; ++ai)
#pragma unroll
            for (int m = 0; m < 4; ++m) { const int r = ai * 128 + wr * 64 + m * 16 + fr, pos = u.tl * 256 + r; const int tok = pos < ce ? list[(size_t)u.e * NTOK + pos] : 0; const float s = r2[tok];
                f32x4 g0 = acc[ai][0][m][0] * s + bg0, g1 = acc[ai][0][m][1] * s + bg1, u0 = acc[ai][1][m][0] * s + bu0, u1 = acc[ai][1][m][1] * s + bu1;
#pragma unroll
                for (int j = 0; j < 4; ++j) { float g = fminf(g0[j], SW_LIMIT), uu = fminf(fmaxf(u0[j], -SW_LIMIT), SW_LIMIT); g0[j] = (uu + 1.0f) * g * __builtin_amdgcn_rcpf(1.0f + __expf(-SW_ALPHA * g));
                    g = fminf(g1[j], SW_LIMIT); uu = fminf(fmaxf(u1[j], -SW_LIMIT), SW_LIMIT); g1[j] = (uu + 1.0f) * g * __builtin_amdgcn_rcpf(1.0f + __expf(-SW_ALPHA * g)); }
                v2u w; w.x = pk4_fp8(g0[0], g0[1], g0[2], g0[3]); w.y = pk4_fp8(g1[0], g1[1], g1[2], g1[3]); *(v2u*)(act + (size_t)(u.pm * 256 + r) * DFF + cb) = w; }
    }
};
struct EpiY { static constexpr bool PERM = true, MIDK = false; const float* b_dn; bf16* y;
    __device__ __forceinline__ void operator()(const Acc& acc, const Unit& u, int wr, int wc, int fr, int fq) const {
        const int col0 = u.pn * 256 + wc * 32 + 8 * fq;
#pragma unroll
        for (int bj = 0; bj < 2; ++bj) { const float* bp = b_dn + (size_t)u.e * DM + col0 + bj * 128; const f32x4 b0 = *(const f32x4*)bp, b1 = *(const f32x4*)(bp + 4);
#pragma unroll
            for (int ai = 0; ai < 2; ++ai)
#pragma unroll
                for (int m = 0; m < 4; ++m) *(v4u*)(y + (size_t)EPI_ROWS(ai, m) * DM + col0 + bj * 128) = pack8(acc[ai][bj][m][0] + b0, acc[ai][bj][m][1] + b1); }
    }
};
#undef EPI_ROWS
}

#define GLDS16(gp, lp) __builtin_amdgcn_global_load_lds((const unsigned*)(gp), (LAS unsigned*)(lp), 16, 0, 0)
#define MFMA32(a, b, c) __builtin_amdgcn_mfma_f32_32x32x16_bf16((a), (b), (c), 0, 0, 0)
#define MFMA16(a, b, c) __builtin_amdgcn_mfma_f32_16x16x32_bf16((a), (b), (c), 0, 0, 0)
__device__ __forceinline__ bf16x8 pack_p(const f32x16& p, int s) {
    v4u w; w.x = pg8::cvt_pk_bf16(p[8 * s + 0], p[8 * s + 1]); w.y = pg8::cvt_pk_bf16(p[8 * s + 2], p[8 * s + 3]); w.z = pg8::cvt_pk_bf16(p[8 * s + 4], p[8 * s + 5]); w.w = pg8::cvt_pk_bf16(p[8 * s + 6], p[8 * s + 7]);
    return __builtin_bit_cast(bf16x8, w);
}
__device__ __forceinline__ int pi32(int r) { return (r & 0x13) | ((r & 4) << 1) | ((r & 8) >> 1); }
__device__ __forceinline__ float max16(const f32x16& p) { float a = fmaxf(fmaxf(p[0], p[1]), fmaxf(p[2], p[3])), b = fmaxf(fmaxf(p[4], p[5]), fmaxf(p[6], p[7])), c = fmaxf(fmaxf(p[8], p[9]), fmaxf(p[10], p[11])), d = fmaxf(fmaxf(p[12], p[13]), fmaxf(p[14], p[15])); return fmaxf(fmaxf(a, b), fmaxf(c, d)); }
__device__ __forceinline__ float sum16(const f32x16& p) { return ((p[0] + p[1]) + (p[2] + p[3])) + ((p[4] + p[5]) + (p[6] + p[7])) + ((p[8] + p[9]) + (p[10] + p[11])) + ((p[12] + p[13]) + (p[14] + p[15])); }

namespace battn {
constexpr int NS = 5, SLOT = 16384, TAB_OFF = NS * SLOT;
__device__ __forceinline__ void unit(LAS unsigned char* lds, const bf16* __restrict__ Q, const bf16* __restrict__ Kp, const bf16* __restrict__ VT, const float* __restrict__ rel, bf16* mix, float* ssa, int b, int h, int u) {
    const int tid = threadIdx.x, lane = tid & 63, wave = __builtin_amdgcn_readfirstlane(tid >> 6), r32 = lane & 31, hh = lane >> 5, j = wave >> 1, qh = wave & 1, c0 = 4 * u;
    LAS float* tab = (LAS float*)(lds + TAB_OFF);
    if (tid < RELW) tab[tid] = rel[h * RELW + tid] * LOG2E;
    const int lrow = tid >> 3, lchunk = (tid & 7) ^ ((lrow >> 1) & 7);
    const bf16* ksrc = Kp + ((size_t)b * SEQ + lrow) * 1024 + h * 64 + lchunk * 8;
    const bf16* vsrc = VT + (size_t)(h * 64 + lrow) * NTOK + (size_t)b * SEQ + lchunk * 8;
#define BA_LOAD(T) do { const int _sl = (((T) + 8) % NS) * SLOT + wave * 1024; GLDS16(ksrc + (size_t)(T) * 64 * 1024, lds + _sl); GLDS16(vsrc + (size_t)(T) * 64, lds + _sl + 8192); } while (0)
    const size_t tok = (size_t)b * SEQ + (c0 + j) * 64 + 32 * qh + r32;
    bf16x8 qf[4];
#pragma unroll
    for (int d0 = 0; d0 < 4; ++d0) qf[d0] = *(const bf16x8*)(Q + tok * 1024 + h * 64 + 16 * d0 + 8 * hh);
#pragma unroll
    for (int T = c0 - 8; T < c0 - 4; ++T) if (T >= 0) BA_LOAD(T);
    asm volatile("s_waitcnt vmcnt(0) lgkmcnt(0)" ::: "memory"); __builtin_amdgcn_s_barrier(); asm volatile("" ::: "memory");
    float mrun = -1e30f, lsum = 0.f; f32x16 o0 = {}, o1 = {};
    const int k0r = pi32(r32), k1r = 32 + k0r;
    const int ka0 = k0r * 128, ka1 = k1r * 128, ks0 = (k0r >> 1) & 7, ks1 = (k1r >> 1) & 7;
    const int v0r = r32, v1r = 32 + r32, vs0 = (v0r >> 1) & 7, vs1 = (v1r >> 1) & 7;
#pragma unroll 1
    for (int s = 0; s < 9; ++s) {
        if (s < 8) { const int Tn = c0 - 4 + s; if (Tn >= 0) BA_LOAD(Tn); }
        const int T = c0 + j - 8 + s;
        if (T >= 0) {
            const LAS unsigned char* sb = lds + ((T + 8) % NS) * SLOT;
            f32x16 p0 = {}, p1 = {};
#pragma unroll
            for (int d0 = 0; d0 < 4; ++d0) {
                const bf16x8 a0 = *(const LAS bf16x8*)(sb + ka0 + (((2 * d0 + hh) ^ ks0) << 4)), a1 = *(const LAS bf16x8*)(sb + ka1 + (((2 * d0 + hh) ^ ks1) << 4));
                p0 = MFMA32(a0, qf[d0], p0); p1 = MFMA32(a1, qf[d0], p1); }
            const int dj = 8 - s;
            if (dj >= 3) { const float c = tab[256];
#pragma unroll
                for (int r = 0; r < 16; ++r) { p0[r] += c; p1[r] += c; } }
            else { const int base = 64 * dj + 32 * qh + r32 + 128 - 8 * hh;
#pragma unroll
                for (int r = 0; r < 16; ++r) { const int i0 = base - (16 * (r >> 3) + (r & 7)); p0[r] += tab[i0 < 256 ? i0 : 256]; const int i1 = i0 - 32; p1[r] += tab[i1 < 256 ? i1 : 256]; } }
            float mx = fmaxf(max16(p0), max16(p1)); mx = fmaxf(mx, __shfl_xor(mx, 32));
            const float mnew = fmaxf(mrun, mx), corr = __builtin_amdgcn_exp2f(mrun - mnew); mrun = mnew;
#pragma unroll
            for (int r = 0; r < 16; ++r) { p0[r] = __builtin_amdgcn_exp2f(p0[r] - mnew); p1[r] = __builtin_amdgcn_exp2f(p1[r] - mnew); }
            lsum = lsum * corr + (sum16(p0) + sum16(p1));
#pragma unroll
            for (int r = 0; r < 16; ++r) { o0[r] *= corr; o1[r] *= corr; }
            const bf16x8 pf00 = pack_p(p0, 0), pf01 = pack_p(p0, 1), pf10 = pack_p(p1, 0), pf11 = pack_p(p1, 1);
            const LAS unsigned char* vb = sb + 8192;
#define BA_V(row, sw, c) (*(const LAS bf16x8*)(vb + (row) * 128 + ((((c) + hh) ^ (sw)) << 4)))
            o0 = MFMA32(BA_V(v0r, vs0, 0), pf00, o0); o0 = MFMA32(BA_V(v0r, vs0, 2), pf01, o0); o0 = MFMA32(BA_V(v0r, vs0, 4), pf10, o0); o0 = MFMA32(BA_V(v0r, vs0, 6), pf11, o0);
            o1 = MFMA32(BA_V(v1r, vs1, 0), pf00, o1); o1 = MFMA32(BA_V(v1r, vs1, 2), pf01, o1); o1 = MFMA32(BA_V(v1r, vs1, 4), pf10, o1); o1 = MFMA32(BA_V(v1r, vs1, 6), pf11, o1);
#undef BA_V
        }
        asm volatile("s_waitcnt vmcnt(0) lgkmcnt(0)" ::: "memory"); __builtin_amdgcn_s_barrier(); asm volatile("" ::: "memory");
    }
#undef BA_LOAD
    const float inv = 1.0f / (lsum + __shfl_xor(lsum, 32)); float ss = 0.f;
#pragma unroll
    for (int r = 0; r < 16; ++r) { o0[r] *= inv; o1[r] *= inv; ss += o0[r] * o0[r] + o1[r] * o1[r]; }
    ss += __shfl_xor(ss, 32); if (hh == 0) ssa[tok * 16 + h] = ss;
    bf16* op = mix + tok * DM + h * 64 + 4 * hh;
#pragma unroll
    for (int g = 0; g < 4; ++g) { v2u w; w.x = pg8::cvt_pk_bf16(o0[4 * g], o0[4 * g + 1]); w.y = pg8::cvt_pk_bf16(o0[4 * g + 2], o0[4 * g + 3]); *(v2u*)(op + 8 * g) = w;
        w.x = pg8::cvt_pk_bf16(o1[4 * g], o1[4 * g + 1]); w.y = pg8::cvt_pk_bf16(o1[4 * g + 2], o1[4 * g + 3]); *(v2u*)(op + 32 + 8 * g) = w; }
}
}

namespace xattn {
__device__ __forceinline__ void unit(LAS unsigned char* lds, const bf16* __restrict__ CQ, const bf16* __restrict__ CK, const bf16* __restrict__ CVT, bf16* ox, int b, int h, int qb, bool reload) {
    const int tid = threadIdx.x, lane = tid & 63, wave = __builtin_amdgcn_readfirstlane(tid >> 6), r32 = lane & 31, hh = lane >> 5;
    if (reload) {
#pragma unroll
        for (int i = 0; i < 8; ++i) { const int idx = i * 512 + tid;
            const int kr = idx >> 4, kc = (idx & 15) ^ (kr & 15); GLDS16(CK + ((size_t)b * MEML + kr) * XW + h * XHD + kc * 8, lds + i * 8192 + wave * 1024);
            const int vr = idx >> 5, vc = (idx & 31) ^ (vr & 15); GLDS16(CVT + (size_t)(h * XHD + vr) * NMEM + (size_t)b * MEML + vc * 8, lds + 65536 + i * 8192 + wave * 1024); }
    }
    const size_t tok = (size_t)b * SEQ + qb * 256 + wave * 32 + r32;
    bf16x8 qf[8];
#pragma unroll
    for (int d0 = 0; d0 < 8; ++d0) qf[d0] = *(const bf16x8*)(CQ + tok * XW + h * XHD + 16 * d0 + 8 * hh);
    asm volatile("s_waitcnt vmcnt(0)" ::: "memory"); __builtin_amdgcn_s_barrier(); asm volatile("" ::: "memory");
    float mrun = -1e30f, lsum = 0.f; f32x16 o[4] = {};
    const int kp = pi32(r32);
#pragma unroll 1
    for (int s = 0; s < 4; ++s) {
        f32x16 p0 = {}, p1 = {};
        const int k0r = 64 * s + kp, k1r = k0r + 32;
#pragma unroll
        for (int d0 = 0; d0 < 8; ++d0) {
            const bf16x8 a0 = *(const LAS bf16x8*)(lds + k0r * 256 + (((2 * d0 + hh) ^ (k0r & 15)) << 4)), a1 = *(const LAS bf16x8*)(lds + k1r * 256 + (((2 * d0 + hh) ^ (k1r & 15)) << 4));
            p0 = MFMA32(a0, qf[d0], p0); p1 = MFMA32(a1, qf[d0], p1); }
        float mx = fmaxf(max16(p0), max16(p1)); mx = fmaxf(mx, __shfl_xor(mx, 32));
        const float mnew = fmaxf(mrun, mx), corr = __builtin_amdgcn_exp2f(mrun - mnew); mrun = mnew;
#pragma unroll
        for (int r = 0; r < 16; ++r) { p0[r] = __builtin_amdgcn_exp2f(p0[r] - mnew); p1[r] = __builtin_amdgcn_exp2f(p1[r] - mnew); }
        lsum = lsum * corr + (sum16(p0) + sum16(p1));
        const bf16x8 pf00 = pack_p(p0, 0), pf01 = pack_p(p0, 1), pf10 = pack_p(p1, 0), pf11 = pack_p(p1, 1);
#pragma unroll
        for (int dh = 0; dh < 4; ++dh) { const int vr = 32 * dh + r32; const LAS unsigned char* vb = lds + 65536 + vr * 512;
#pragma unroll
            for (int r = 0; r < 16; ++r) o[dh][r] *= corr;
#define XA_V(c) (*(const LAS bf16x8*)(vb + ((((8 * s + (c) + hh)) ^ (vr & 15)) << 4)))
            o[dh] = MFMA32(XA_V(0), pf00, o[dh]); o[dh] = MFMA32(XA_V(2), pf01, o[dh]); o[dh] = MFMA32(XA_V(4), pf10, o[dh]); o[dh] = MFMA32(XA_V(6), pf11, o[dh]);
#undef XA_V
        }
    }
    const float inv = 1.0f / (lsum + __shfl_xor(lsum, 32));
    bf16* op = ox + tok * XW + h * XHD + 4 * hh;
#pragma unroll
    for (int dh = 0; dh < 4; ++dh)
#pragma unroll
        for (int g = 0; g < 4; ++g) { v2u w; w.x = pg8::cvt_pk_bf16(o[dh][4 * g] * inv, o[dh][4 * g + 1] * inv); w.y = pg8::cvt_pk_bf16(o[dh][4 * g + 2] * inv, o[dh][4 * g + 3] * inv); *(v2u*)(op + 32 * dh + 8 * g) = w; }
    asm volatile("s_waitcnt lgkmcnt(0)" ::: "memory"); __builtin_amdgcn_s_barrier(); asm volatile("" ::: "memory");
}
}

namespace lru {
constexpr int XA_P = 272, XA_OFF = 0, XF_OFF = 64 * XA_P, SA_OFF = XF_OFF + 64 * 64 * 4, SB_OFF = SA_OFF + 64 * 68 * 4, SC_OFF = SB_OFF + 64 * 68 * 4, HS_OFF = SC_OFF + 8 * 64 * 8, CW_OFF = HS_OFF + 256, END_OFF = CW_OFF + 5 * 128 * 4;
__device__ __forceinline__ void unit(LAS unsigned char* lds, const bf16* __restrict__ xr, const bf16* __restrict__ yg, const float* __restrict__ conv_w, const float* __restrict__ conv_b, const bf16* __restrict__ wga_t, const bf16* __restrict__ wgx_t,
                                     const float* __restrict__ b_ga, const float* __restrict__ b_gx, const float* __restrict__ lam, bf16* mix, float* ssl, int b, int g) {
    const int tid = threadIdx.x, lane = tid & 63, wave = __builtin_amdgcn_readfirstlane(tid >> 6), n = g >> 1, hf = g & 1;
    LAS float* XF = (LAS float*)(lds + XF_OFF); LAS float* SA = (LAS float*)(lds + SA_OFF); LAS float* SB = (LAS float*)(lds + SB_OFF); LAS f32x2* SC = (LAS f32x2*)(lds + SC_OFF); LAS float* HS = (LAS float*)(lds + HS_OFF); LAS float* CW = (LAS float*)(lds + CW_OFF);
    for (int i = tid; i < 5 * 128; i += 512) { const int jj = i >> 7, c = i & 127; CW[i] = jj < 4 ? conv_w[jj * LW + n * 128 + c] : conv_b[n * 128 + c]; }
    if (tid < 64) HS[tid] = 0.f;
    const int tb = wave & 3, dq = wave >> 2, l15 = lane & 15, l4 = lane >> 4;
    bf16x8 wf[2][2][4];
#pragma unroll
    for (int dt = 0; dt < 2; ++dt)
#pragma unroll
        for (int ks = 0; ks < 4; ++ks) { const size_t off = (size_t)(n * 128 + hf * 64 + dq * 32 + 16 * dt + l15) * 128 + 32 * ks + 8 * l4;
            wf[0][dt][ks] = *(const bf16x8*)(wga_t + off); wf[1][dt][ks] = *(const bf16x8*)(wgx_t + off); }
    float cba[2][4], cbx[2][4], csp[2][4];
#pragma unroll
    for (int dt = 0; dt < 2; ++dt)
#pragma unroll
        for (int r = 0; r < 4; ++r) { const int c = n * 128 + hf * 64 + dq * 32 + 16 * dt + 4 * l4 + r; cba[dt][r] = b_ga[c]; cbx[dt][r] = b_gx[c]; csp[dt][r] = -8.0f * log1pf(__expf(-lam[c])); }
    const int tt = tid >> 3, cg = tid & 7;
    const bf16* xrp = xr + ((size_t)b * SEQ + tt) * 1024 + n * 128 + cg * 16;
    const int cc = lane, sg = wave;
    const bf16* ygp = yg + ((size_t)b * SEQ + 8 * sg) * 1024 + n * 128 + hf * 64 + cc;
    bf16* outp = mix + ((size_t)b * SEQ + 8 * sg) * DM + 1024 + n * 128 + hf * 64 + cc;
    v4u xv[4][2]; bf16 yv[8];
#define LRU_LOADX(t0) do { _Pragma("unroll") for (int jj = 0; jj < 4; ++jj) { const int trow = (t0) + tt - 3 + jj; \
        if (trow >= 0) { const v4u* q_ = (const v4u*)(xrp + ((ptrdiff_t)((t0) - 3 + jj)) * 1024); xv[jj][0] = q_[0]; xv[jj][1] = q_[1]; } else { xv[jj][0] = (v4u){0u, 0u, 0u, 0u}; xv[jj][1] = (v4u){0u, 0u, 0u, 0u}; } } \
        _Pragma("unroll") for (int i = 0; i < 8; ++i) yv[i] = ygp[((size_t)(t0) + i) * 1024]; } while (0)
    LRU_LOADX(0);
    asm volatile("s_waitcnt lgkmcnt(0)" ::: "memory"); __builtin_amdgcn_s_barrier(); asm volatile("" ::: "memory");
#pragma unroll 1
    for (int t0 = 0; t0 < SEQ; t0 += 64) {
        {
            float xc[16];
#pragma unroll
            for (int i = 0; i < 16; ++i) xc[i] = CW[4 * 128 + cg * 16 + i];
#pragma unroll
            for (int jj = 0; jj < 4; ++jj)
#pragma unroll
                for (int i = 0; i < 16; ++i) { const unsigned w = xv[jj][i >> 3][(i >> 1) & 3]; const float xf = (i & 1) ? __uint_as_float(w & 0xffff0000u) : __uint_as_float(w << 16); xc[i] += CW[jj * 128 + cg * 16 + i] * xf; }
            v4u w0, w1; w0.x = pg8::cvt_pk_bf16(xc[0], xc[1]); w0.y = pg8::cvt_pk_bf16(xc[2], xc[3]); w0.z = pg8::cvt_pk_bf16(xc[4], xc[5]); w0.w = pg8::cvt_pk_bf16(xc[6], xc[7]);
            w1.x = pg8::cvt_pk_bf16(xc[8], xc[9]); w1.y = pg8::cvt_pk_bf16(xc[10], xc[11]); w1.z = pg8::cvt_pk_bf16(xc[12], xc[13]); w1.w = pg8::cvt_pk_bf16(xc[14], xc[15]);
            *(LAS v4u*)(lds + XA_OFF + tt * XA_P + cg * 32) = w0; *(LAS v4u*)(lds + XA_OFF + tt * XA_P + cg * 32 + 16) = w1;
            if ((cg >> 2) == hf) {
#pragma unroll
                for (int i = 0; i < 16; i += 4) *(LAS f32x4*)(XF + tt * 64 + (cg & 3) * 16 + i) = (f32x4){xc[i], xc[i + 1], xc[i + 2], xc[i + 3]}; }
        }
        bf16 ycur[8];
#pragma unroll
        for (int i = 0; i < 8; ++i) ycur[i] = yv[i];
        if (t0 + 64 < SEQ) LRU_LOADX(t0 + 64);
        asm volatile("s_waitcnt lgkmcnt(0)" ::: "memory"); __builtin_amdgcn_s_barrier(); asm volatile("" ::: "memory");
        {
            f32x4 ar[2] = {}, ai[2] = {};
#pragma unroll
            for (int ks = 0; ks < 4; ++ks) { const bf16x8 xfr = *(const LAS bf16x8*)(lds + XA_OFF + (16 * tb + l15) * XA_P + 64 * ks + 16 * l4);
#pragma unroll
                for (int dt = 0; dt < 2; ++dt) { ar[dt] = MFMA16(wf[0][dt][ks], xfr, ar[dt]); ai[dt] = MFMA16(wf[1][dt][ks], xfr, ai[dt]); } }
            const int tk = 16 * tb + l15;
#pragma unroll
            for (int dt = 0; dt < 2; ++dt) { const int dl = dq * 32 + 16 * dt + 4 * l4; const f32x4 xo = *(const LAS f32x4*)(XF + tk * 64 + dl); f32x4 av, bv;
#pragma unroll
                for (int r = 0; r < 4; ++r) { const float rg = sigmoidf_(ar[dt][r] + cba[dt][r]), ig = sigmoidf_(ai[dt][r] + cbx[dt][r]); const float la = rg * csp[dt][r];
                    av[r] = __expf(la); bv[r] = sqrtf(-expm1f(2.0f * la)) * (ig * xo[r]); }
                *(LAS f32x4*)(SA + tk * 68 + dl) = av; *(LAS f32x4*)(SB + tk * 68 + dl) = bv; }
        }
        asm volatile("s_waitcnt lgkmcnt(0)" ::: "memory"); __builtin_amdgcn_s_barrier(); asm volatile("" ::: "memory");
        float a8[8], b8[8];
        { float A = 1.f, B = 0.f;
#pragma unroll
            for (int i = 0; i < 8; ++i) { a8[i] = SA[(8 * sg + i) * 68 + cc]; b8[i] = SB[(8 * sg + i) * 68 + cc]; B = a8[i] * B + b8[i]; A *= a8[i]; }
            SC[sg * 64 + cc] = (f32x2){A, B}; }
        asm volatile("s_waitcnt lgkmcnt(0)" ::: "memory"); __builtin_amdgcn_s_barrier(); asm volatile("" ::: "memory");
        {
            float hcur = HS[cc];
#pragma unroll
            for (int s2 = 0; s2 < 7; ++s2) { const f32x2 ab = SC[s2 * 64 + cc]; if (s2 < sg) hcur = ab.x * hcur + ab.y; }
#pragma unroll
            for (int i = 0; i < 8; ++i) { hcur = a8[i] * hcur + b8[i]; const float y = hcur * gelu_tanh(bf2f(ycur[i])); outp[((size_t)t0 + i) * DM] = (bf16)f2bf(y);
                const float s = wave_sum(y * y); if (lane == 0) ssl[((size_t)b * SEQ + t0 + 8 * sg + i) * 16 + g] = s; }
            asm volatile("s_waitcnt lgkmcnt(0)" ::: "memory"); __builtin_amdgcn_s_barrier(); asm volatile("" ::: "memory");
            if (sg == 7) HS[cc] = hcur;
        }
    }
#undef LRU_LOADX
    asm volatile("s_waitcnt vmcnt(0) lgkmcnt(0)" ::: "memory"); __builtin_amdgcn_s_barrier(); asm volatile("" ::: "memory");
}
}

constexpr int NWAVES = 8, NPHASE = 12;
constexpr int RING_BYTES = 131072, LDSCTL_OFF = RING_BYTES, MISC_OFF = LDSCTL_OFF + 320, LDS_BYTES = 147456;
#define LDS_WAIT() asm volatile("s_waitcnt lgkmcnt(0)" ::: "memory")
#define VM_WAIT() asm volatile("s_waitcnt vmcnt(0)" ::: "memory")

__device__ __forceinline__ void tr_item(const float* W, int K, int N, bf16* WT, int drow0, const float* gain, LAS float* scr, int k0, int n0, int lane) {
#pragma unroll 8
    for (int i = 0; i < 32; ++i) { const int kk = 2 * i + (lane >> 5); scr[kk * 33 + (lane & 31)] = W[(size_t)(k0 + kk) * N + n0 + (lane & 31)]; }
    LDS_WAIT(); asm volatile("" ::: "memory");
    const int c = lane & 7;
    float g[8];
#pragma unroll
    for (int j = 0; j < 8; ++j) g[j] = gain ? gain[k0 + 8 * c + j] : 1.0f;
#pragma unroll
    for (int j = 0; j < 4; ++j) { const int n = (lane >> 3) + 8 * j; const LAS float* s = scr + (8 * c) * 33 + n;
        v4u o; o.x = pk2(s[0 * 33] * g[0], s[1 * 33] * g[1]); o.y = pk2(s[2 * 33] * g[2], s[3 * 33] * g[3]); o.z = pk2(s[4 * 33] * g[4], s[5 * 33] * g[5]); o.w = pk2(s[6 * 33] * g[6], s[7 * 33] * g[7]);
        *(GAS v4u*)(WT + (size_t)(drow0 + n) * K + k0 + 8 * c) = o; }
    LDS_WAIT(); asm volatile("" ::: "memory");
}
__device__ __forceinline__ void tr_item8(const float* W, int K, int N, unsigned char* WT, int drow0, const float* gain, LAS float* scr, int k0, int n0, int lane) {
#pragma unroll 8
    for (int i = 0; i < 32; ++i) { const int kk = 2 * i + (lane >> 5); scr[kk * 33 + (lane & 31)] = W[(size_t)(k0 + kk) * N + n0 + (lane & 31)]; }
    LDS_WAIT(); asm volatile("" ::: "memory");
    const int c = lane & 7;
    float g[8];
#pragma unroll
    for (int j = 0; j < 8; ++j) g[j] = (gain ? gain[k0 + 8 * c + j] : 1.0f) * W8_SCALE;
#pragma unroll
    for (int j = 0; j < 4; ++j) { const int n = (lane >> 3) + 8 * j; const LAS float* s = scr + (8 * c) * 33 + n;
        v2u o; o.x = pk4_fp8(s[0 * 33] * g[0], s[1 * 33] * g[1], s[2 * 33] * g[2], s[3 * 33] * g[3]); o.y = pk4_fp8(s[4 * 33] * g[4], s[5 * 33] * g[5], s[6 * 33] * g[6], s[7 * 33] * g[7]);
        *(GAS v2u*)(WT + (size_t)(drow0 + n) * K + k0 + 8 * c) = o; }
    LDS_WAIT(); asm volatile("" ::: "memory");
}
__device__ __forceinline__ void row_to_bf16(const float* xrow, bf16* orow, float* ss, int lane) {
    const GAS f32x4* xr = (const GAS f32x4*)xrow + lane; float s = 0.f;
    GAS v2u* o8 = (GAS v2u*)orow + lane;
#pragma unroll
    for (int j = 0; j < 8; ++j) { const f32x4 v = xr[64 * j]; s += (v.x * v.x + v.y * v.y) + (v.z * v.z + v.w * v.w); v2u w; w.x = pk2(v.x, v.y); w.y = pk2(v.z, v.w); o8[64 * j] = w; }
    s = wave_sum(s); if (lane == 0) *ss = s;
}
__device__ __forceinline__ void p0_prologue(const P& p, LAS unsigned char* lds, int gw, int NGW, int wave, int lane) {
    LAS float* scr = (LAS float*)(lds + wave * 16384);
    unsigned char* ws = p.ws;
    for (int m = gw; m < NTOK; m += NGW) row_to_bf16(p.x + (size_t)m * DM, (bf16*)(ws + WS_XB) + (size_t)m * DM, (float*)(ws + WS_SS0) + m, lane);
    for (int m = gw; m < NMEM; m += NGW) row_to_bf16(p.mem + (size_t)m * DM, (bf16*)(ws + WS_MEMB) + (size_t)m * DM, (float*)(ws + WS_SSM) + m, lane);
    for (int i = gw * 64 + lane; i < NE * DM; i += NGW * 64) { const int e = i >> 11, k = i & 2047; ((float*)(ws + WS_W_R))[i] = p.g_ffn[k] * p.w_r[k * NE + e]; }
    constexpr int I_IN = 32 * 160, I_OUT = 32 * 64, I_CQ = 32 * 16, I_CKV = 32 * 32, I_CO = 8 * 64, I_G = 8 * 2 * 4, I_GU = 32 * 32 * 128, I_DN = 32 * 32 * 64;
    constexpr int NITEMS = I_IN + I_OUT + I_CQ + I_CKV + I_CO + 2 * I_G + I_GU + I_DN;
    for (int it = gw; it < NITEMS; it += NGW) {
        int r = it;
        if (r < I_IN)  { const int kb = r / 160, nb = r % 160; tr_item(p.w_in, DM, 5120, (bf16*)(ws + WS_W_IN), nb * 32, p.g_mix, scr, kb * 64, nb * 32, lane); continue; } r -= I_IN;
        if (r < I_OUT) { const int kb = r / 64, nb = r % 64; tr_item(p.w_out, DM, DM, (bf16*)(ws + WS_W_OUT), nb * 32, kb < 16 ? p.g_att : p.g_lru - 1024, scr, kb * 64, nb * 32, lane); continue; } r -= I_OUT;
        if (r < I_CQ)  { const int kb = r / 16, nb = r % 16; tr_item(p.w_cq, DM, XW, (bf16*)(ws + WS_W_CQ), nb * 32, p.g_cross, scr, kb * 64, nb * 32, lane); continue; } r -= I_CQ;
        if (r < I_CKV) { const int kb = r / 32, nb = r % 32; tr_item(p.w_ckv, DM, 2 * XW, (bf16*)(ws + WS_W_CKV), nb * 32, p.g_mem, scr, kb * 64, nb * 32, lane); continue; } r -= I_CKV;
        if (r < I_CO)  { const int kb = r / 64, nb = r % 64; tr_item(p.w_co, XW, DM, (bf16*)(ws + WS_W_CO), nb * 32, nullptr, scr, kb * 64, nb * 32, lane); continue; } r -= I_CO;
        if (r < I_G)   { const int n = r >> 3, kb = (r >> 2) & 1, nb = r & 3; tr_item(p.w_ga + n * 16384, LBW, LBW, (bf16*)(ws + WS_W_GA) + n * 16384, nb * 32, nullptr, scr, kb * 64, nb * 32, lane); continue; } r -= I_G;
        if (r < I_G)   { const int n = r >> 3, kb = (r >> 2) & 1, nb = r & 3; tr_item(p.w_gx + n * 16384, LBW, LBW, (bf16*)(ws + WS_W_GX) + n * 16384, nb * 32, nullptr, scr, kb * 64, nb * 32, lane); continue; } r -= I_G;
        if (r < I_GU)  { const int e = r >> 12, q = r & 4095, kb = q >> 7, nb = q & 127, n0 = nb * 32; const int c = n0 & 2047, up = n0 >> 11;
                         tr_item8(p.w_gu + (size_t)e * DM * 4096, DM, 4096, (unsigned char*)(ws + WS_W_GU) + (size_t)e * 4096 * DM, 256 * (c >> 7) + (c & 127) + 128 * up, p.g_ffn, scr, kb * 64, n0, lane); continue; } r -= I_GU;
        { const int e = r >> 11, q = r & 2047, kb = q >> 6, nb = q & 63; tr_item8(p.w_dn + (size_t)e * DFF * DM, DFF, DM, (unsigned char*)(ws + WS_W_DN) + (size_t)e * DM * DFF, nb * 32, nullptr, scr, kb * 64, nb * 32, lane); }
    }
}
__device__ __forceinline__ void p3_scales(const P& p, int gtid, int NT) {
    const float* ssa = (const float*)(p.ws + WS_SSA); const float* ssl = (const float*)(p.ws + WS_SSL); float* scl = (float*)(p.ws + WS_SCL);
    for (int m = gtid; m < NTOK; m += NT) { float a = 0.f, l = 0.f;
#pragma unroll
        for (int i = 0; i < 16; ++i) { a += ssa[(size_t)m * 16 + i]; l += ssl[(size_t)m * 16 + i]; }
        const float ra = rsqrtf(a * (1.0f / AW) + EPS), rl = rsqrtf(l * (1.0f / LW) + EPS);
        scl[2 * m] = ra / rl; scl[2 * m + 1] = rl; }
}
__device__ __forceinline__ void p8_router(const P& p, int gw, int NGW, int lane) {
    const float* wrt = (const float*)(p.ws + WS_W_R); const float* x2 = p.out;
    int* cnt = (int*)(p.ws + WS_CTL) + CW_CNT; int* list = (int*)(p.ws + WS_LIST);
    int* tope = (int*)(p.ws + WS_TOPE); float* topg = (float*)(p.ws + WS_TOPG); int* tpos = (int*)(p.ws + WS_TPOS); float* r2 = (float*)(p.ws + WS_R2);
    for (int m = gw; m < NTOK; m += NGW) {
        const GAS f32x4* xr = (const GAS f32x4*)(x2 + (size_t)m * DM) + lane;
        f32x4 xv[8]; float ss = 0.f;
#pragma unroll
        for (int j = 0; j < 8; ++j) { xv[j] = xr[64 * j]; ss += (xv[j].x * xv[j].x + xv[j].y * xv[j].y) + (xv[j].z * xv[j].z + xv[j].w * xv[j].w); }
        ss = wave_sum(ss); const float r = rsqrtf(ss * (1.0f / DM) + EPS);
        float mylogit = 0.f;
#pragma unroll 4
        for (int e = 0; e < NE; ++e) { const GAS f32x4* wr = (const GAS f32x4*)(wrt + (size_t)e * DM) + lane; float a = 0.f;
#pragma unroll
            for (int j = 0; j < 8; ++j) { const f32x4 w = wr[64 * j]; a += (xv[j].x * w.x + xv[j].y * w.y) + (xv[j].z * w.z + xv[j].w * w.w); }
            a = wave_sum(a); if (lane == e) mylogit = a * r + p.b_r[e]; }
        float v = lane < NE ? mylogit : -INFINITY; float tv[4]; int te[4];
#pragma unroll
        for (int k = 0; k < TOPK; ++k) { float mxv = v;
#pragma unroll
            for (int o = 1; o < 64; o <<= 1) mxv = fmaxf(mxv, __shfl_xor(mxv, o));
            const unsigned long long bal = __ballot(v == mxv); const int idx = __ffsll((long long)bal) - 1; tv[k] = mxv; te[k] = idx; if (lane == idx) v = -INFINITY; }
        const float e1 = __expf(tv[1] - tv[0]), e2 = __expf(tv[2] - tv[0]), e3 = __expf(tv[3] - tv[0]); const float inv = 1.0f / (1.0f + e1 + e2 + e3);
        if (lane < TOPK) { const int e = lane == 0 ? te[0] : lane == 1 ? te[1] : lane == 2 ? te[2] : te[3]; const float g = (lane == 0 ? 1.0f : lane == 1 ? e1 : lane == 2 ? e2 : e3) * inv;
            const int pos = atomicAdd(&cnt[e], 1); list[(size_t)e * NTOK + pos] = m; tope[m * 4 + lane] = e; topg[m * 4 + lane] = g; tpos[m * 4 + lane] = pos; }
        if (lane == 0) r2[m] = r;
    }
}
__device__ __forceinline__ void p11_combine(const P& p, int gw, int NGW, int lane) {
    const int* cnt = (const int*)(p.ws + WS_CTL) + CW_CNT; const bf16* Y = (const bf16*)(p.ws + WS_Y);
    const int* tope = (const int*)(p.ws + WS_TOPE); const float* topg = (const float*)(p.ws + WS_TOPG); const int* tpos = (const int*)(p.ws + WS_TPOS);
    int pad = lane < NE ? ((cnt[lane & 31] + 255) >> 8) : 0; int inc = pad;
#pragma unroll
    for (int o = 1; o < 32; o <<= 1) { const int t = __shfl_up(inc, o); if ((lane & 31) >= o) inc += t; }
    const int toff_l = inc - pad;
    for (int m = gw; m < NTOK; m += NGW) {
        GAS f32x4* xr = (GAS f32x4*)(p.out + (size_t)m * DM) + lane;
        f32x4 a[8];
#pragma unroll
        for (int j = 0; j < 8; ++j) a[j] = xr[64 * j];
#pragma unroll
        for (int k = 0; k < TOPK; ++k) { const int e = tope[m * 4 + k]; const float g = topg[m * 4 + k]; const int slot = 256 * __shfl(toff_l, e) + tpos[m * 4 + k];
            const GAS v2u* yr = (const GAS v2u*)(Y + (size_t)slot * DM) + lane;
#pragma unroll
            for (int j = 0; j < 8; ++j) { const v2u w = yr[64 * j]; a[j].x += g * __uint_as_float(w.x << 16); a[j].y += g * __uint_as_float(w.x & 0xffff0000u); a[j].z += g * __uint_as_float(w.y << 16); a[j].w += g * __uint_as_float(w.y & 0xffff0000u); } }
        float ss = 0.f;
#pragma unroll
        for (int j = 0; j < 8; ++j) ss += (a[j].x * a[j].x + a[j].y * a[j].y) + (a[j].z * a[j].z + a[j].w * a[j].w);
        ss = wave_sum(ss); const float r = rsqrtf(ss * (1.0f / DM) + EPS);
        const GAS f32x4* gf = (const GAS f32x4*)p.g_fin + lane;
#pragma unroll
        for (int j = 0; j < 8; ++j) { const f32x4 g = gf[64 * j]; xr[64 * j] = a[j] * r * g; }
    }
}

#ifndef FAST_MASK
#define FAST_MASK 0xFFFu
#endif
#ifndef DUP_MASK
#define DUP_MASK 0u
#endif
#ifndef SUB2_MASK
#define SUB2_MASK 0x7u
#endif
__global__ void __launch_bounds__(NWAVES * 64, 2) fwd(P p) {
    extern __shared__ __attribute__((aligned(16))) unsigned char lds_raw[];
    LAS unsigned char* lds = (LAS unsigned char*)lds_raw;
    volatile LAS unsigned* MISC = (volatile LAS unsigned*)(lds + MISC_OFF);
    const int tid = threadIdx.x, lane = tid & 63, wave = __builtin_amdgcn_readfirstlane(tid >> 6);
    const int G = gridDim.x, bx = blockIdx.x; const int vcu = (G % 8 == 0) ? (bx % 8) * (G / 8) + bx / 8 : bx;
    const int gw = vcu * NWAVES + wave, NGW = G * NWAVES;
    for (int u = tid; u < (LDS_BYTES - LDSCTL_OFF) / 4; u += NWAVES * 64) ((LAS unsigned*)(lds + LDSCTL_OFF))[u] = 0u;
    __syncthreads();
    unsigned* ctl = (unsigned*)(p.ws + WS_CTL);
    const int lo = p.ph_lo, hi = p.ph_hi;
    XcdBarrier bar; bar.bar = ctl + CW_BAR + p.li * XCD_BAR_WORDS; bar.x = 0; bar.st = nullptr;
    if (hi - lo > 1) bar = xcd_barrier_post(ctl + CW_BAR + p.li * XCD_BAR_WORDS, MISC + 8);
#define IN(k) (lo <= (k) && (k) < hi)
#define SEAM(k) do { if (IN(k) && IN((k) + 1)) xcd_barrier(bar); } while (0)
    unsigned char* ws = p.ws;
    LAS int* l_toff = (LAS int*)(lds + LDSCTL_OFF + 512); LAS int* l_cnt = (LAS int*)(lds + LDSCTL_OFF + 768);
#define RUN(k, BODY) do { if (IN(k)) { BODY; if ((DUP_MASK >> (k)) & 1u) { xcd_barrier(bar); BODY; } } } while (0)
#define PH0 p0_prologue(p, lds, gw, NGW, wave, lane)
#define PH1 do {   \
        { pg8::SchedReg S{(const char*)(ws + WS_XB), (const char*)(ws + WS_W_IN), NTOK / 256, 16, G, bx, 4096, 8, 1024}; \
          pg8::EpiRowScale E{(const float*)(ws + WS_SS0), (bf16*)(ws + WS_QKXY), 1024, 1024, (size_t)NTOK * 1024, QSCALE}; \
          pg8::gemm_phase(lds, 2 * DM, S, E); } \
        { pg8::SchedReg S{(const char*)(ws + WS_W_IN) + (size_t)2048 * 4096, (const char*)(ws + WS_XB), 4, NTOK / 256, G, bx, 4096, 1 << 30, 0}; \
          pg8::EpiColScale E{(const float*)(ws + WS_SS0), (bf16*)(ws + WS_VT), (size_t)NTOK}; \
          pg8::gemm_phase(lds, 2 * DM, S, E); } } while (0)
#define PH2 do { \
        if (SUB2_MASK & 1u) {     \
            { pg8::SchedReg S{(const char*)(ws + WS_MEMB), (const char*)(ws + WS_W_CKV), NMEM / 256, 2, G, bx, 4096, 1 << 30, 0}; \
              pg8::EpiRowScale E{(const float*)(ws + WS_SSM), (bf16*)(ws + WS_CK), XW, 0, 0, 1.0f}; \
              pg8::gemm_phase(lds, 2 * DM, S, E); } \
            { pg8::SchedReg S{(const char*)(ws + WS_W_CKV) + (size_t)512 * 4096, (const char*)(ws + WS_MEMB), 2, NMEM / 256, G, (bx + 32) % G, 4096, 1 << 30, 0}; \
              pg8::EpiColScale E{(const float*)(ws + WS_SSM), (bf16*)(ws + WS_CVT), (size_t)NMEM}; \
              pg8::gemm_phase(lds, 2 * DM, S, E); } \
        } \
        const bf16* QKXY = (const bf16*)(ws + WS_QKXY); \
        if (SUB2_MASK & 4u) { \
            for (int U = vcu; U < BATCH * 16; U += G) \
                lru::unit(lds, QKXY + (size_t)2 * NTOK * 1024, QKXY + (size_t)3 * NTOK * 1024, p.conv_w, p.conv_b, (const bf16*)(ws + WS_W_GA), (const bf16*)(ws + WS_W_GX), p.b_ga, p.b_gx, p.lam, (bf16*)(ws + WS_MIX), (float*)(ws + WS_SSL), U >> 4, U & 15); \
        } \
        if (SUB2_MASK & 2u) { \
            for (int U = vcu; U < BATCH * AH * 8; U += G) \
                battn::unit(lds, QKXY, QKXY + (size_t)NTOK * 1024, (const bf16*)(ws + WS_VT), p.rel, (bf16*)(ws + WS_MIX), (float*)(ws + WS_SSA), U >> 7, (U >> 3) & 15, U & 7); \
        } } while (0)
#define PH3 p3_scales(p, gw * 64 + lane, NGW * 64)
#define PH4 do { \
        pg8::SchedReg S{(const char*)(ws + WS_MIX), (const char*)(ws + WS_W_OUT), NTOK / 256, 8, G, bx, 4096, 1 << 30, 0}; \
        pg8::EpiX1 E{(const float*)(ws + WS_SCL), p.x, p.out, (bf16*)(ws + WS_X1B), (float*)(ws + WS_SS1P)}; \
        pg8::gemm_phase(lds, 2 * DM, S, E); } while (0)
#define PH5 do { \
        pg8::SchedReg S{(const char*)(ws + WS_X1B), (const char*)(ws + WS_W_CQ), NTOK / 256, 2, G, bx, 4096, 1 << 30, 0}; \
        pg8::EpiCQ E{(const float*)(ws + WS_SS1P), (bf16*)(ws + WS_CQ)}; \
        pg8::gemm_phase(lds, 2 * DM, S, E); } while (0)
#define PH6 do { int prev = -1; \
        for (int U = vcu; U < BATCH * XH * 8; U += G) { const int bh = U >> 3; \
            xattn::unit(lds, (const bf16*)(ws + WS_CQ), (const bf16*)(ws + WS_CK), (const bf16*)(ws + WS_CVT), (bf16*)(ws + WS_OX), bh >> 2, bh & 3, U & 7, bh != prev); prev = bh; } } while (0)
#define PH7 do { \
        pg8::SchedReg S{(const char*)(ws + WS_OX), (const char*)(ws + WS_W_CO), NTOK / 256, 8, G, bx, 1024, 1 << 30, 0}; \
        pg8::EpiX2 E{p.out, (unsigned char*)(ws + WS_X2B)}; \
        pg8::gemm_phase(lds, 2 * XW, S, E); } while (0)
#define PH8 p8_router(p, gw, NGW, lane)
#define PH9 do { \
        pg8::SchedMoE<true> S{l_toff, l_cnt, (const int*)(ws + WS_LIST), (const char*)(ws + WS_X2B), (const char*)(ws + WS_W_GU), 16, 4096, G, bx}; \
        pg8::EpiAct E{l_cnt, (const int*)(ws + WS_LIST), (const float*)(ws + WS_R2), p.b_gu, (unsigned char*)(ws + WS_ACT)}; \
        pg8::gemm_phase(lds, DM, S, E); } while (0)
#define PH10 do { \
        pg8::SchedMoE<false> S{l_toff, l_cnt, nullptr, (const char*)(ws + WS_ACT), (const char*)(ws + WS_W_DN), 8, 2048, G, bx}; \
        pg8::EpiY E{p.b_dn, (bf16*)(ws + WS_Y)}; \
        pg8::gemm_phase(lds, DFF, S, E); } while (0)
#define PH11 p11_combine(p, gw, NGW, lane)
    RUN(0, PH0); SEAM(0);
    RUN(1, PH1); SEAM(1);
    RUN(2, PH2); SEAM(2);
    RUN(3, PH3); SEAM(3);
    RUN(4, PH4); SEAM(4);
    RUN(5, PH5); SEAM(5);
    RUN(6, PH6); SEAM(6);
    if (IN(7)) { PH7; } SEAM(7);
    if (IN(8)) { PH8; } SEAM(8);
    if (IN(9) || IN(10)) {
        if (tid < NE) l_cnt[tid] = ((const int*)ctl)[CW_CNT + tid];
        __syncthreads();
        if (tid == 0) { int a = 0; for (int e = 0; e < NE; ++e) { l_toff[e] = a; a += (l_cnt[e] + 255) >> 8; } l_toff[NE] = a; }
        __syncthreads();
    }
    RUN(9, PH9); SEAM(9);
    RUN(10, PH10); SEAM(10);
    if (IN(11)) { PH11; }
#undef IN
#undef SEAM
}

extern "C" void kernel_launch(void* const* d_in, const int* in_sizes, int n_in, void* d_out, int out_size, void* d_ws, size_t ws_size, hipStream_t stream) {
    static int grid = 0;
    if (grid == 0) {
        if (n_in != 28 || in_sizes[0] != NTOK * DM || out_size != NTOK * DM || ws_size < WS_END) { fprintf(stderr, "kernel_launch: unexpected shapes (n_in %d, ws %zu)\n", n_in, ws_size); grid = -1; return; }
        int dev = 0, cus = 0;
        if (hipGetDevice(&dev) != hipSuccess || hipDeviceGetAttribute(&cus, hipDeviceAttributeMultiprocessorCount, dev) != hipSuccess) { grid = -1; return; }
        if (hipFuncSetAttribute((const void*)fwd, hipFuncAttributeMaxDynamicSharedMemorySize, LDS_BYTES) != hipSuccess) { fprintf(stderr, "kernel_launch: hipFuncSetAttribute failed\n"); grid = -1; return; }
        int per_cu = 0; (void)hipOccupancyMaxActiveBlocksPerMultiprocessor(&per_cu, (const void*)fwd, NWAVES * 64, LDS_BYTES); (void)hipGetLastError();
        grid = cus;
    }
    if (grid < 0) return;
    (void)hipMemsetAsync((char*)d_ws + WS_CTL, 0, CTL_ZERO_BYTES, stream);
    P p{};
    const float** pp = (const float**)&p;
    for (int i = 0; i < 28; ++i) pp[i] = (const float*)d_in[i];
    p.out = (float*)d_out; p.ws = (unsigned char*)d_ws;
    unsigned char* ws = (unsigned char*)d_ws;
    bf16* QKXY = (bf16*)(ws + WS_QKXY); int* ctl = (int*)(ws + WS_CTL);
    int li = 0;
    auto isfast = [](int ph) { return ph == 2 ? (SUB2_MASK != 0u) : (((FAST_MASK >> ph) & 1u) != 0u); };
    for (int ph = 0; ph < NPHASE;) {
        if (ph == 2) {
            if (!(SUB2_MASK & 1u)) { F1b f{}; f.A = (bf16*)(ws + WS_MEMB); f.Bt = (bf16*)(ws + WS_W_CKV); f.ssm = (float*)(ws + WS_SSM); f.ck = (bf16*)(ws + WS_CK); f.cvt = (bf16*)(ws + WS_CVT);
                  hipLaunchKernelGGL(ngemm<F1b>, dim3(1024 / 64, NMEM / 64), dim3(256), 0, stream, f); }
            if (!(SUB2_MASK & 2u)) hipLaunchKernelGGL(n_attn, dim3(BATCH * AH * 8), dim3(256), 0, stream, QKXY, (const bf16*)(ws + WS_VT), p.rel, (bf16*)(ws + WS_MIX), (float*)(ws + WS_SSA));
            if (!(SUB2_MASK & 4u)) {
                  hipLaunchKernelGGL(n_lru_a, dim3(NTOK * 4), dim3(256), 0, stream, QKXY + (size_t)2 * NTOK * 1024, p.conv_w, p.conv_b, (const bf16*)(ws + WS_W_GA), p.b_ga, (const bf16*)(ws + WS_W_GX), p.b_gx, p.lam, (float*)(ws + WS_NA), (float*)(ws + WS_NB));
                  hipLaunchKernelGGL(n_lru_b, dim3(256), dim3(64), 0, stream, (const float*)(ws + WS_NA), (const float*)(ws + WS_NB), QKXY + (size_t)3 * NTOK * 1024, (bf16*)(ws + WS_MIX), (float*)(ws + WS_SSL)); }
        }
        if (isfast(ph)) { int hi = ph + 1; while (hi < NPHASE && isfast(hi) && !(hi == 2 && SUB2_MASK != 7u)) ++hi;
            p.ph_lo = ph; p.ph_hi = hi; p.li = li++; hipLaunchKernelGGL(fwd, dim3(grid), dim3(NWAVES * 64), LDS_BYTES, stream, p); ph = hi; continue; }
        switch (ph) {
        case 1: { F1 f{}; f.A = (bf16*)(ws + WS_XB); f.Bt = (bf16*)(ws + WS_W_IN); f.ss0 = (float*)(ws + WS_SS0); f.qkxy = QKXY; f.vt = (bf16*)(ws + WS_VT);
                  hipLaunchKernelGGL(ngemm<F1>, dim3(5120 / 64, NTOK / 64), dim3(256), 0, stream, f); } break;
        case 4: { F4 f{}; f.A = (bf16*)(ws + WS_MIX); f.Bt = (bf16*)(ws + WS_W_OUT); f.scl = (float*)(ws + WS_SCL); f.x = p.x; f.x1 = p.out; f.x1b = (bf16*)(ws + WS_X1B); f.ss1p = (float*)(ws + WS_SS1P);
                  hipLaunchKernelGGL(ngemm<F4>, dim3(DM / 64, NTOK / 64), dim3(256), 0, stream, f); } break;
        case 5: { F5 f{}; f.A = (bf16*)(ws + WS_X1B); f.Bt = (bf16*)(ws + WS_W_CQ); f.ss1p = (float*)(ws + WS_SS1P); f.cq = (bf16*)(ws + WS_CQ);
                  hipLaunchKernelGGL(ngemm<F5>, dim3(XW / 64, NTOK / 64), dim3(256), 0, stream, f); } break;
        case 6: hipLaunchKernelGGL(n_xattn, dim3(BATCH * XH * 8 * 2), dim3(256), 0, stream, (const bf16*)(ws + WS_CQ), (const bf16*)(ws + WS_CK), (const bf16*)(ws + WS_CVT), (bf16*)(ws + WS_OX)); break;
        case 7: { F7 f{}; f.A = (bf16*)(ws + WS_OX); f.Bt = (bf16*)(ws + WS_W_CO); f.x12 = p.out; f.x2b = (unsigned char*)(ws + WS_X2B);
                  hipLaunchKernelGGL(ngemm<F7>, dim3(DM / 64, NTOK / 64), dim3(256), 0, stream, f); } break;
        case 9: { hipLaunchKernelGGL(n_toff, dim3(1), dim3(64), 0, stream, (const int*)(ctl + CW_CNT), ctl + CW_TOFF);
                  F9 f{}; f.x2b = (unsigned char*)(ws + WS_X2B); f.wgu = (unsigned char*)(ws + WS_W_GU); f.toff = ctl + CW_TOFF; f.cnt = ctl + CW_CNT; f.list = (int*)(ws + WS_LIST); f.r2 = (float*)(ws + WS_R2); f.b_gu = p.b_gu; f.act = (unsigned char*)(ws + WS_ACT);
                  hipLaunchKernelGGL(ngemm<F9>, dim3(DFF / 32, NSLOT / 64), dim3(256), 0, stream, f); } break;
        case 10: { hipLaunchKernelGGL(n_toff, dim3(1), dim3(64), 0, stream, (const int*)(ctl + CW_CNT), ctl + CW_TOFF);
                  F10 f{}; f.act = (unsigned char*)(ws + WS_ACT); f.wdn = (unsigned char*)(ws + WS_W_DN); f.toff = ctl + CW_TOFF; f.b_dn = p.b_dn; f.y = (bf16*)(ws + WS_Y);
                  hipLaunchKernelGGL(ngemm<F10>, dim3(DM / 64, NSLOT / 64), dim3(256), 0, stream, f); } break;
        default: break;
        }
        ++ph;
    }
}
```

```cpp
#include <hip/hip_runtime.h>
#include <cstdio>
#include <cstdint>
#include <cmath>

#define GAS __attribute__((address_space(1)))
#define LAS __attribute__((address_space(3)))
typedef unsigned short bf16;
typedef unsigned v4u __attribute__((ext_vector_type(4)));
typedef unsigned v2u __attribute__((ext_vector_type(2)));
typedef float f32x4 __attribute__((ext_vector_type(4)));
typedef float f32x2 __attribute__((ext_vector_type(2)));
typedef float f32x16 __attribute__((ext_vector_type(16)));
typedef short bf16x8 __attribute__((ext_vector_type(8)));

constexpr int BATCH = 16, SEQ = 2048, DM = 2048, NTOK = BATCH * SEQ;
constexpr int CHUNK = 64, LEFTC = 8, AW = 1024, AH = 16, AHD = 64, MAXREL = 128, RELW = 2 * MAXREL + 1;
constexpr int LW = 1024, LB = 8, LBW = 128;
constexpr int MEML = 256, NMEM = BATCH * MEML, XH = 4, XHD = 128, XW = 512;
constexpr int NE = 32, TOPK = 4, DFF = 2048;
constexpr int NSLOT = NTOK * TOPK + NE * 256;
constexpr float EPS = 1e-6f, LOG2E = 1.4426950408889634f;
constexpr float QSCALE = 0.125f * LOG2E;
constexpr float CQSCALE = 0.08838834764831845f * LOG2E;
constexpr float SW_ALPHA = 1.702f, SW_LIMIT = 7.0f;

constexpr size_t MiB = 1u << 20;
constexpr size_t WS_CTL = 0, CTL_ZERO_BYTES = 1 * MiB;
constexpr size_t WS_W_IN = 2 * MiB, WS_W_OUT = 22 * MiB, WS_W_CQ = 30 * MiB, WS_W_CKV = 32 * MiB, WS_W_CO = 36 * MiB;
constexpr size_t WS_W_GA = 38 * MiB, WS_W_GX = WS_W_GA + 256 * 1024, WS_W_R = WS_W_GX + 256 * 1024;
constexpr size_t WS_SS0 = 39 * MiB, WS_SSM = WS_SS0 + 128 * 1024, WS_R2 = WS_SS0 + 256 * 1024;
constexpr size_t WS_SSA = 40 * MiB, WS_SSL = 42 * MiB, WS_SCL = 44 * MiB, WS_SS1P = 45 * MiB;
constexpr size_t WS_TOPE = 49 * MiB, WS_TOPG = WS_TOPE + 512 * 1024, WS_TPOS = 50 * MiB;
constexpr size_t WS_LIST = 3008 * MiB  , WS_CK = 55 * MiB, WS_CVT = 59 * MiB, WS_MEMB = 64 * MiB;
constexpr size_t WS_W_GU = 128 * MiB, WS_W_DN = 640 * MiB;
constexpr size_t WS_XB = 896 * MiB, WS_MIX = 2496 * MiB;
constexpr size_t WS_QKXY = 1024 * MiB, WS_VT = 1280 * MiB, WS_X1B = 1344 * MiB, WS_CQ = 1472 * MiB, WS_OX = 1504 * MiB, WS_X2B = 1536 * MiB;
constexpr size_t WS_X2H = 2752 * MiB;
constexpr size_t WS_ACT = 1664 * MiB, WS_Y = 2208 * MiB, WS_NA = 2752 * MiB, WS_NB = 2880 * MiB, WS_END = 3016 * MiB;
constexpr int CW_CNT = 64;
constexpr int CW_TOFF = 128;
constexpr int CW_BAR = 4096;

struct P {
    const float *x, *mem, *g_mix, *w_in, *rel, *conv_w, *conv_b, *w_ga, *b_ga, *w_gx, *b_gx, *lam, *g_att, *g_lru, *w_out, *g_cross, *g_mem,
        *w_cq, *w_ckv, *w_co, *g_ffn, *w_r, *b_r, *w_gu, *b_gu, *w_dn, *b_dn, *g_fin;
    float* out; unsigned char* ws;
    int ph_lo, ph_hi, li, pad;
};

__device__ __forceinline__ float bf2f(bf16 b) { return __uint_as_float(((unsigned)b) << 16); }
__device__ __forceinline__ unsigned f2bf(float f) { unsigned u = __float_as_uint(f); return (u + 0x7fffu + ((u >> 16) & 1u)) >> 16; }
__device__ __forceinline__ unsigned pk2(float lo, float hi) { return f2bf(lo) | (f2bf(hi) << 16); }
constexpr float W8_SCALE = 64.0f, W8_INV = 1.0f / 64.0f;
__device__ __forceinline__ unsigned pk4_fp8(float a, float b, float c, float d) { int w = 0; w = __builtin_amdgcn_cvt_pk_fp8_f32(a, b, w, false); w = __builtin_amdgcn_cvt_pk_fp8_f32(c, d, w, true); return (unsigned)w; }
__device__ __forceinline__ float fp8_to_f(unsigned b) { const unsigned s = (b >> 7) & 1u, e = (b >> 3) & 15u, m = b & 7u; const float v = e ? ldexpf(1.0f + (float)m * 0.125f, (int)e - 7) : ldexpf((float)m * 0.125f, -6); return s ? -v : v; }
__device__ __forceinline__ float wave_sum(float v) {
#pragma unroll
    for (int o = 1; o < 64; o <<= 1) v += __shfl_xor(v, o);
    return v;
}
__device__ __forceinline__ float sigmoidf_(float x) { return 1.0f / (1.0f + __expf(-x)); }
__device__ __forceinline__ float gelu_tanh(float x) { const float u = 0.7978845608028654f * (x + 0.044715f * x * x * x); return 0.5f * x * (1.0f + tanhf(u)); }
__device__ __forceinline__ int find_expert(const int* toff, int tile) { int e = 0;
#pragma unroll 1
    for (int i = 1; i < NE; ++i) e += (tile >= toff[i]) ? 1 : 0;
    return e; }

template <class F>
__global__ void __launch_bounds__(256) ngemm(F f) {
    __shared__ float As[16][68], Bs[16][68];
    const int tx = threadIdx.x & 15, ty = threadIdx.x >> 4, bm = blockIdx.y, bn = blockIdx.x;
    if (!f.valid(bm)) return;
    const int lr = threadIdx.x >> 2, lk = (threadIdx.x & 3) * 4;
    const unsigned char* ap = (const unsigned char*)f.aptr(bm * 64 + lr);
    const unsigned char* bp = (const unsigned char*)f.bptr(bm, bn, lr);
    float acc[4][4];
#pragma unroll
    for (int i = 0; i < 4; ++i)
#pragma unroll
        for (int j = 0; j < 4; ++j) acc[i][j] = 0.f;
    for (int k0 = 0; k0 < F::K; k0 += 16) {
        f.mid(k0, bm, ty, acc);
        if constexpr (F::FP8) { const unsigned av = *(const unsigned*)(ap + k0 + lk), bv = *(const unsigned*)(bp + k0 + lk);
#pragma unroll
            for (int q = 0; q < 4; ++q) { As[lk + q][lr] = fp8_to_f((av >> (8 * q)) & 255u); Bs[lk + q][lr] = fp8_to_f((bv >> (8 * q)) & 255u) * W8_INV; } }
        else { const v2u av = *(const v2u*)(ap + 2 * (k0 + lk)), bv = *(const v2u*)(bp + 2 * (k0 + lk));
        As[lk + 0][lr] = __uint_as_float(av.x << 16); As[lk + 1][lr] = __uint_as_float(av.x & 0xffff0000u);
        As[lk + 2][lr] = __uint_as_float(av.y << 16); As[lk + 3][lr] = __uint_as_float(av.y & 0xffff0000u);
        Bs[lk + 0][lr] = __uint_as_float(bv.x << 16); Bs[lk + 1][lr] = __uint_as_float(bv.x & 0xffff0000u);
        Bs[lk + 2][lr] = __uint_as_float(bv.y << 16); Bs[lk + 3][lr] = __uint_as_float(bv.y & 0xffff0000u); }
        __syncthreads();
#pragma unroll
        for (int kk = 0; kk < 16; ++kk) {
            const f32x4 a = *(const f32x4*)&As[kk][ty * 4], b = *(const f32x4*)&Bs[kk][tx * 4];
#pragma unroll
            for (int i = 0; i < 4; ++i)
#pragma unroll
                for (int j = 0; j < 4; ++j) acc[i][j] += a[i] * b[j];
        }
        __syncthreads();
    }
    f.out(bm, bn, ty, tx, acc);
}
struct FBase { static constexpr bool FP8 = false;
    __device__ bool valid(int) const { return true; }
    __device__ void mid(int, int, int, float (&)[4][4]) const {}
};
struct F1 : FBase { static constexpr int K = 2048; const bf16* A; const bf16* Bt; const float* ss0; bf16* qkxy; bf16* vt;
    __device__ const bf16* aptr(int row) const { return A + (size_t)row * K; }
    __device__ const bf16* bptr(int, int bn, int j) const { return Bt + (size_t)(bn * 64 + j) * K; }
    __device__ void out(int bm, int bn, int ty, int tx, float (&acc)[4][4]) const {
        for (int i = 0; i < 4; ++i) { const int m = bm * 64 + ty * 4 + i; const float r0 = rsqrtf(ss0[m] * (1.0f / DM) + EPS);
            for (int j = 0; j < 4; ++j) { const int n = bn * 64 + tx * 4 + j, t = n >> 10, c = n & 1023; float v = acc[i][j] * r0;
                if (t == 2) vt[(size_t)c * NTOK + m] = (bf16)f2bf(v);
                else { const int slot = t < 2 ? t : t - 1; if (t == 0) v *= QSCALE; qkxy[(size_t)slot * NTOK * 1024 + (size_t)m * 1024 + c] = (bf16)f2bf(v); } } }
    }
};
struct F1b : FBase { static constexpr int K = 2048; const bf16* A; const bf16* Bt; const float* ssm; bf16* ck; bf16* cvt;
    __device__ const bf16* aptr(int row) const { return A + (size_t)row * K; }
    __device__ const bf16* bptr(int, int bn, int j) const { return Bt + (size_t)(bn * 64 + j) * K; }
    __device__ void out(int bm, int bn, int ty, int tx, float (&acc)[4][4]) const {
        for (int i = 0; i < 4; ++i) { const int m = bm * 64 + ty * 4 + i; const float r = rsqrtf(ssm[m] * (1.0f / DM) + EPS);
            for (int j = 0; j < 4; ++j) { const int n = bn * 64 + tx * 4 + j; const float v = acc[i][j] * r;
                if (n < XW) ck[(size_t)m * XW + n] = (bf16)f2bf(v); else cvt[(size_t)(n - XW) * NMEM + m] = (bf16)f2bf(v); } }
    }
};
struct F4 : FBase { static constexpr int K = 2048; const bf16* A; const bf16* Bt; const float* scl; const float* x; float* x1; bf16* x1b; float* ss1p;
    __device__ const bf16* aptr(int row) const { return A + (size_t)row * K; }
    __device__ const bf16* bptr(int, int bn, int j) const { return Bt + (size_t)(bn * 64 + j) * K; }
    __device__ void mid(int k0, int bm, int ty, float (&acc)[4][4]) const { if (k0 == 1024) { for (int i = 0; i < 4; ++i) { const float s = scl[2 * (bm * 64 + ty * 4 + i)]; for (int j = 0; j < 4; ++j) acc[i][j] *= s; } } }
    __device__ void out(int bm, int bn, int ty, int tx, float (&acc)[4][4]) const {
        for (int i = 0; i < 4; ++i) { const int m = bm * 64 + ty * 4 + i; const float s = scl[2 * m + 1]; float q = 0.f;
            for (int j = 0; j < 4; ++j) { const int n = bn * 64 + tx * 4 + j; const float v = x[(size_t)m * DM + n] + acc[i][j] * s; x1[(size_t)m * DM + n] = v; x1b[(size_t)m * DM + n] = (bf16)f2bf(v); q += v * v; }
            q += __shfl_xor(q, 1); q += __shfl_xor(q, 2); q += __shfl_xor(q, 4); q += __shfl_xor(q, 8);
            if (tx == 0) ss1p[(size_t)m * 32 + bn] = q; }
    }
};
struct F5 : FBase { static constexpr int K = 2048; const bf16* A; const bf16* Bt; const float* ss1p; bf16* cq;
    __device__ const bf16* aptr(int row) const { return A + (size_t)row * K; }
    __device__ const bf16* bptr(int, int bn, int j) const { return Bt + (size_t)(bn * 64 + j) * K; }
    __device__ void out(int bm, int bn, int ty, int tx, float (&acc)[4][4]) const {
        for (int i = 0; i < 4; ++i) { const int m = bm * 64 + ty * 4 + i; float q = 0.f; for (int p = 0; p < 32; ++p) q += ss1p[(size_t)m * 32 + p];
            const float r1 = rsqrtf(q * (1.0f / DM) + EPS) * CQSCALE;
            for (int j = 0; j < 4; ++j) { const int n = bn * 64 + tx * 4 + j; cq[(size_t)m * XW + n] = (bf16)f2bf(acc[i][j] * r1); } }
    }
};
struct F7 : FBase { static constexpr int K = 512; const bf16* A; const bf16* Bt; float* x12; unsigned char* x2b;
    __device__ const bf16* aptr(int row) const { return A + (size_t)row * K; }
    __device__ const bf16* bptr(int, int bn, int j) const { return Bt + (size_t)(bn * 64 + j) * K; }
    __device__ void out(int bm, int bn, int ty, int tx, float (&acc)[4][4]) const {
        for (int i = 0; i < 4; ++i) { const int m = bm * 64 + ty * 4 + i;
            for (int j = 0; j < 4; ++j) { const int n = bn * 64 + tx * 4 + j; const float v = x12[(size_t)m * DM + n] + acc[i][j]; x12[(size_t)m * DM + n] = v; x2b[(size_t)m * DM + n] = (unsigned char)(pk4_fp8(v, 0.f, 0.f, 0.f) & 255u); } }
    }
};
struct F9 { static constexpr int K = 2048; static constexpr bool FP8 = true; const unsigned char* x2b; const unsigned char* wgu; const int* toff; const int* cnt; const int* list; const float* r2; const float* b_gu; unsigned char* act;
    __device__ bool valid(int bm) const { return (bm >> 2) < toff[NE]; }
    __device__ void mid(int, int, int, float (&)[4][4]) const {}
    __device__ int tok_of(int slot, int& e) const { const int tile = slot >> 8; e = find_expert(toff, tile); const int pos = slot - 256 * toff[e]; return pos < cnt[e] ? list[2 * (e * NTOK + pos)] : 0; }
    __device__ const unsigned char* aptr(int slot) const { int e; const int tok = tok_of(slot, e); return x2b + (size_t)tok * K; }
    __device__ const unsigned char* bptr(int bm, int bn, int j) const { const int e = find_expert(toff, bm >> 2); const int a = bn * 32 + (j >> 2) * 2 + (j & 1), up = (j >> 1) & 1;
        const int row = 256 * (a >> 7) + (a & 127) + 128 * up; return wgu + ((size_t)e * 4096 + row) * K; }
    __device__ void out(int bm, int bn, int ty, int tx, float (&acc)[4][4]) const {
        for (int i = 0; i < 4; ++i) { const int slot = bm * 64 + ty * 4 + i; int e; const int tok = tok_of(slot, e); const float r = r2[tok];
            for (int j = 0; j < 2; ++j) { const int a = bn * 32 + tx * 2 + j;
                float g = acc[i][j] * r + b_gu[e * 4096 + a], u = acc[i][2 + j] * r + b_gu[e * 4096 + 2048 + a];
                g = fminf(g, SW_LIMIT); u = fminf(fmaxf(u, -SW_LIMIT), SW_LIMIT);
                act[(size_t)slot * DFF + a] = (unsigned char)(pk4_fp8((u + 1.0f) * g * sigmoidf_(SW_ALPHA * g), 0.f, 0.f, 0.f) & 255u); } }
    }
};
struct F10 { static constexpr int K = 2048; static constexpr bool FP8 = true; const unsigned char* act; const unsigned char* wdn; const int* toff; const float* b_dn; unsigned char* y;
    __device__ bool valid(int bm) const { return (bm >> 2) < toff[NE]; }
    __device__ void mid(int, int, int, float (&)[4][4]) const {}
    __device__ const unsigned char* aptr(int slot) const { return act + (size_t)slot * K; }
    __device__ const unsigned char* bptr(int bm, int bn, int j) const { const int e = find_expert(toff, bm >> 2); return wdn + ((size_t)e * DM + bn * 64 + j) * K; }
    __device__ void out(int bm, int bn, int ty, int tx, float (&acc)[4][4]) const { const int e = find_expert(toff, bm >> 2);
        for (int i = 0; i < 4; ++i) { const int slot = bm * 64 + ty * 4 + i;
            for (int j = 0; j < 4; ++j) { const int n = bn * 64 + tx * 4 + j; y[(size_t)slot * DM + n] = (unsigned char)(pk4_fp8(acc[i][j] + b_dn[e * DM + n], 0.f, 0.f, 0.f) & 255u); } }
    }
};

__global__ void __launch_bounds__(256) n_attn(const bf16* __restrict__ qkxy, const bf16* __restrict__ vt, const float* __restrict__ rel, bf16* mix, float* ssa) {
    const int blk = blockIdx.x, tq = (blk & 7) * 256 + threadIdx.x, bh = blk >> 3, h = bh & 15, b = bh >> 4;
    const size_t m = (size_t)b * SEQ + tq;
    const bf16* Q = qkxy; const bf16* Kp = qkxy + (size_t)NTOK * 1024;
    float q[64], o[64];
#pragma unroll
    for (int d = 0; d < 64; ++d) { q[d] = bf2f(Q[m * 1024 + h * 64 + d]); o[d] = 0.f; }
    float mx = -INFINITY, l = 0.f;
    const int c = tq >> 6, k0 = (c > LEFTC ? c - LEFTC : 0) * 64, k1 = (c + 1) * 64;
    const float* tab = rel + h * RELW;
    for (int key = k0; key < k1; ++key) {
        const bf16* kr = Kp + ((size_t)b * SEQ + key) * 1024 + h * 64;
        float s = 0.f;
#pragma unroll
        for (int d = 0; d < 64; ++d) s += q[d] * bf2f(kr[d]);
        int r = tq - key; r = (r < -MAXREL ? -MAXREL : (r > MAXREL ? MAXREL : r)) + MAXREL;
        s += tab[r] * LOG2E;
        const float mn = fmaxf(mx, s), corr = exp2f(mx - mn), pe = exp2f(s - mn);
        l = l * corr + pe;
        const bf16* vp = vt + (size_t)(h * 64) * NTOK + (size_t)b * SEQ + key;
#pragma unroll
        for (int d = 0; d < 64; ++d) o[d] = o[d] * corr + pe * bf2f(vp[(size_t)d * NTOK]);
        mx = mn;
    }
    const float il = 1.0f / l; float ss = 0.f;
#pragma unroll
    for (int d = 0; d < 64; ++d) { const float v = o[d] * il; ss += v * v; mix[m * DM + h * 64 + d] = (bf16)f2bf(v); }
    ssa[m * 16 + h] = ss;
}
__global__ void __launch_bounds__(256) n_xattn(const bf16* __restrict__ cq, const bf16* __restrict__ ck, const bf16* __restrict__ cvt, bf16* ox) {
    const int blk = blockIdx.x, dh = blk & 1, tq = ((blk >> 1) & 7) * 256 + threadIdx.x, bh = blk >> 4, h = bh & 3, b = bh >> 2;
    const size_t m = (size_t)b * SEQ + tq;
    float q[128], o[64];
#pragma unroll
    for (int d = 0; d < 128; ++d) q[d] = bf2f(cq[m * XW + h * XHD + d]);
#pragma unroll
    for (int d = 0; d < 64; ++d) o[d] = 0.f;
    float mx = -INFINITY, l = 0.f;
    for (int key = 0; key < MEML; ++key) {
        const bf16* kr = ck + ((size_t)b * MEML + key) * XW + h * XHD;
        float s = 0.f;
#pragma unroll
        for (int d = 0; d < 128; ++d) s += q[d] * bf2f(kr[d]);
        const float mn = fmaxf(mx, s), corr = exp2f(mx - mn), pe = exp2f(s - mn);
        l = l * corr + pe;
        const bf16* vp = cvt + (size_t)(h * XHD + dh * 64) * NMEM + (size_t)b * MEML + key;
#pragma unroll
        for (int d = 0; d < 64; ++d) o[d] = o[d] * corr + pe * bf2f(vp[(size_t)d * NMEM]);
        mx = mn;
    }
    const float il = 1.0f / l;
#pragma unroll
    for (int d = 0; d < 64; ++d) ox[m * XW + h * XHD + dh * 64 + d] = (bf16)f2bf(o[d] * il);
}
__global__ void __launch_bounds__(256) n_lru_a(const bf16* __restrict__ xr, const float* __restrict__ conv_w, const float* __restrict__ conv_b, const bf16* __restrict__ wga_t, const float* __restrict__ b_ga,
                                              const bf16* __restrict__ wgx_t, const float* __restrict__ b_gx, const float* __restrict__ lam, float* na, float* nb) {
    const size_t idx = (size_t)blockIdx.x * 256 + threadIdx.x; const int c = (int)(idx & 1023); const size_t m = idx >> 10; const int t = (int)(m & (SEQ - 1)), n = c >> 7, d = c & 127;
    float rp = b_ga[c], ip = b_gx[c], xown = 0.f;
    const bf16* wa = wga_t + (size_t)(n * 128 + d) * 128; const bf16* wx = wgx_t + (size_t)(n * 128 + d) * 128;
    for (int cp = 0; cp < 128; ++cp) { const int cc = n * 128 + cp; float xc = conv_b[cc];
#pragma unroll
        for (int j = 0; j < 4; ++j) { const int tt = t - 3 + j; if (tt >= 0) xc += conv_w[j * LW + cc] * bf2f(xr[(m - 3 + j) * 1024 + cc]); }
        rp += xc * bf2f(wa[cp]); ip += xc * bf2f(wx[cp]); if (cp == d) xown = xc; }
    const float r = sigmoidf_(rp), ig = sigmoidf_(ip);
    const float la = -8.0f * r * log1pf(__expf(-lam[c]));
    na[idx] = __expf(la); nb[idx] = sqrtf(-expm1f(2.0f * la)) * (ig * xown);
}
__global__ void __launch_bounds__(64) n_lru_b(const float* __restrict__ na, const float* __restrict__ nb, const bf16* __restrict__ yg, bf16* mix, float* ssl) {
    const int b = blockIdx.x >> 4, g = blockIdx.x & 15, c = g * 64 + threadIdx.x; float h = 0.f;
    for (int t = 0; t < SEQ; ++t) { const size_t m = (size_t)b * SEQ + t; h = na[m * 1024 + c] * h + nb[m * 1024 + c];
        const float y = h * gelu_tanh(bf2f(yg[m * 1024 + c])); mix[m * DM + 1024 + c] = (bf16)f2bf(y);
        const float s = wave_sum(y * y); if (threadIdx.x == 0) ssl[m * 16 + g] = s; }
}
__global__ void n_toff(const int* cnt, int* toff) { if (threadIdx.x == 0 && blockIdx.x == 0) { int a = 0; for (int e = 0; e < NE; ++e) { toff[e] = a; a += (cnt[e] + 255) >> 8; } toff[NE] = a; } }

#define XB_TMO      128
#define XB_XCNT(j)  (256  + 64 * (j))
#define XB_XSUB(j)  (1280 + 64 * (j))
#define XB_XGEN(j)  (2304 + 64 * (j))
#define XB_TOP      3328
#define XB_TOPGEN   3392
#define XCD_BAR_WORDS 3456
#define XB_SPIN_CAP (1u << 18)
__device__ __forceinline__ unsigned xb_ld(unsigned* p)              { return __hip_atomic_load(p, __ATOMIC_RELAXED, __HIP_MEMORY_SCOPE_AGENT); }
__device__ __forceinline__ unsigned xb_add(unsigned* p, unsigned v) { return __hip_atomic_fetch_add(p, v, __ATOMIC_RELAXED, __HIP_MEMORY_SCOPE_AGENT); }
__device__ __forceinline__ unsigned xb_xcc_id() { return (unsigned)__builtin_amdgcn_s_getreg((3 << 11) | 20) & 0xFu; }
#define XB_SPIN(cond, bar) do { unsigned _sp = 0; while (cond) { __builtin_amdgcn_s_sleep(1); \
    if ((++_sp & 255u) == 0u) { if (xb_ld(&(bar)[XB_TMO])) break; if (_sp > XB_SPIN_CAP) { atomicAdd(&(bar)[XB_TMO], 1u); break; } } } } while (0)
struct XcdBarrier { unsigned* bar; unsigned x; volatile LAS unsigned* st; };
__device__ __forceinline__ XcdBarrier xcd_barrier_post(unsigned* bar, volatile LAS unsigned* st) {
    XcdBarrier b; b.bar = bar; b.x = xb_xcc_id(); b.st = st;
    if (threadIdx.x == 0) (void)xb_add(&bar[XB_XCNT(b.x)], 1u);
    return b;
}
__device__ __forceinline__ void xcd_barrier_complete(unsigned* bar, unsigned x, unsigned& nloc, unsigned& nx) {
    const unsigned G = gridDim.x * gridDim.y * gridDim.z;
    unsigned sum, cnt, mine, sp = 0u;
    for (;;) {
        sum = 0u; cnt = 0u; mine = 0u;
#pragma unroll
        for (unsigned j = 0; j < 16; ++j) { const unsigned c = xb_ld(&bar[XB_XCNT(j)]); sum += c; cnt += (c > 0u) ? 1u : 0u; mine = (j == x) ? c : mine; }
        if (sum == G) break;
        __builtin_amdgcn_s_sleep(1);
        if ((++sp & 255u) == 0u) { if (xb_ld(&bar[XB_TMO])) break; if (sp > XB_SPIN_CAP) { atomicAdd(&bar[XB_TMO], 1u); break; } }
    }
    nloc = mine > 0u ? mine : 1u; nx = cnt > 0u ? cnt : 1u;
}
__device__ __forceinline__ void xcd_barrier(const XcdBarrier& b) {
    asm volatile("s_waitcnt vmcnt(0)" ::: "memory");
    __syncthreads();
    if (threadIdx.x == 0) {
        unsigned* bar = b.bar;
        __builtin_amdgcn_s_waitcnt(0);
        unsigned nloc = b.st[0], nx = b.st[1];
        if (nloc == 0u) { xcd_barrier_complete(bar, b.x, nloc, nx); b.st[0] = nloc; b.st[1] = nx; }
        const unsigned old = xb_add(&bar[XB_XSUB(b.x)], 1u);
        const unsigned gen = old / nloc;
        if (old + 1u == (gen + 1u) * nloc) {
            __builtin_amdgcn_fence(__ATOMIC_RELEASE, "agent");
            asm volatile("s_waitcnt vmcnt(0)" ::: "memory");
            const unsigned og = xb_add(&bar[XB_TOP], 1u);
            const unsigned tg = og / nx;
            if (og + 1u == (tg + 1u) * nx) xb_add(&bar[XB_TOPGEN], 1u);
            else XB_SPIN(xb_ld(&bar[XB_TOPGEN]) == tg, bar);
            __builtin_amdgcn_fence(__ATOMIC_ACQUIRE, "agent");
            xb_add(&bar[XB_XGEN(b.x)], 1u);
            asm volatile("s_waitcnt vmcnt(0)" ::: "memory");
        } else {
            XB_SPIN(xb_ld(&bar[XB_XGEN(b.x)]) == gen, bar);
            __builtin_amdgcn_fence(__ATOMIC_ACQUIRE, "agent");
            asm volatile("s_waitcnt vmcnt(0)" ::: "memory");
        }
    }
    __syncthreads();
}

#ifndef EPI_TWICE
#define EPI_TWICE 0
#endif
namespace pg8 {
constexpr int BM = 256, BK = 64, HALF = 128, HTB = HALF * BK * 2, STAGE_BYTES = 8 * HTB;
__host__ __device__ __forceinline__ int lds_byte(int r, int c) { const int st = (r >> 4) * 2 + (c >> 5), rr = r & 15, cc = c & 31, ob = rr * 64 + cc * 2; return st * 1024 + (ob ^ (((ob >> 9) & 1) << 5)); }
__host__ __device__ __forceinline__ void stage_rc(int b, int& R, int& C) { const int st = b / 1024, sb = b % 1024, swz = sb ^ (((sb >> 9) & 1) << 5); R = (st >> 1) * 16 + swz / 64; C = (st & 1) * 32 + (swz % 64) / 2; }
__host__ __device__ __forceinline__ int perm32(int rho) { const int n = rho >> 4, i = rho & 15; return 8 * (i >> 2) + 4 * n + (i & 3); }
__device__ __forceinline__ unsigned cvt_pk_bf16(float lo, float hi) { unsigned r; asm volatile("v_cvt_pk_bf16_f32 %0, %1, %2" : "=v"(r) : "v"(lo), "v"(hi)); return r; }
struct Unit { const char* a; const char* b; int pm, pn, e, tl, idx; };
typedef f32x4 Acc[2][2][4][2];
typedef int v8i __attribute__((ext_vector_type(8)));
__device__ __forceinline__ v8i cat8(const bf16x8 lo, const bf16x8 hi) { const v4u a = __builtin_bit_cast(v4u, lo), b = __builtin_bit_cast(v4u, hi); return (v8i){(int)a.x, (int)a.y, (int)a.z, (int)a.w, (int)b.x, (int)b.y, (int)b.z, (int)b.w}; }
template <class Epi, class Sched>
__device__ __forceinline__ void gemm_phase(LAS unsigned char* lds, const int KB  , const Sched& S, const Epi& E, const int stagger = 0) {
    if (stagger) { const unsigned long long t0 = __builtin_amdgcn_s_memrealtime(), d = (unsigned long long)(((blockIdx.x >> 3) & 3u) * (unsigned)stagger);
        while (__builtin_amdgcn_s_memrealtime() - t0 < d) __builtin_amdgcn_s_sleep(8); }
    const int tid = threadIdx.x, wid = __builtin_amdgcn_readfirstlane(tid >> 6), lane = tid & 63, wr = wid >> 2, wc = wid & 3, fr = lane & 15, fq = lane >> 4;
    const int nt = KB / 128;
    unsigned voffA[2], voffB[2];
#pragma unroll
    for (int i = 0; i < 2; ++i) { int R, C; stage_rc(tid * 16 + i * 8192, R, C); const int Rb = Epi::PERM ? ((R & ~31) + perm32(R & 31)) : R;
        voffA[i] = Sched::GATHER ? (unsigned)(C * 2) : (unsigned)(R * KB + C * 2); voffB[i] = (unsigned)(Rb * KB + C * 2); }
    const size_t kstep = (size_t)(BK * 2);
    const size_t hstep = (size_t)HALF * KB;
    const unsigned ldsw = (unsigned)wid * 1024u;
    const int aoff = lds_byte(wr * 64 + fr, fq * 8), boff = lds_byte(wc * 32 + fr, fq * 8);
#define PG8_SA(b, h) (((b) * 2 + (h)) * HTB)
#define PG8_SB(b, h) ((4 + (b) * 2 + (h)) * HTB)
#define PG8_STAGE(bufoff, gbase, voff) do { _Pragma("unroll") for (int _i = 0; _i < 2; ++_i) { unsigned _vo = (voff)[_i]; asm volatile("" : "+v"(_vo)); \
        __builtin_amdgcn_global_load_lds((const unsigned*)((const char*)(gbase) + _vo), (LAS unsigned*)(lds + (bufoff) + ldsw + _i * 8192), 16, 0, 0); } } while (0)
#define PG8_STAGE_A(bufoff, gbase, h, go) do { if constexpr (Sched::GATHER) { PG8_STAGE(bufoff, gbase, go[h]); } else { PG8_STAGE(bufoff, (gbase) + (h) * hstep, voffA); } } while (0)
#define PG8_LDA(dst, b, h) do { _Pragma("unroll") for (int m = 0; m < 4; ++m) _Pragma("unroll") for (int k = 0; k < 2; ++k) dst[m][k] = *(const LAS bf16x8*)(lds + PG8_SA(b, h) + aoff + m * 2048 + k * 1024); } while (0)
#define PG8_LDB(dst, b, h) do { _Pragma("unroll") for (int n = 0; n < 2; ++n) _Pragma("unroll") for (int k = 0; k < 2; ++k) dst[n][k] = *(const LAS bf16x8*)(lds + PG8_SB(b, h) + boff + n * 2048 + k * 1024); } while (0)
#define PG8_MMA(ai, bj, At, Bt) do { __builtin_amdgcn_s_setprio(1); _Pragma("unroll") for (int m = 0; m < 4; ++m) _Pragma("unroll") for (int n = 0; n < 2; ++n) { \
        if constexpr (Sched::FP8) acc[ai][bj][m][n] = __builtin_amdgcn_mfma_scale_f32_16x16x128_f8f6f4(cat8(Bt[n][0], Bt[n][1]), cat8(At[m][0], At[m][1]), acc[ai][bj][m][n], 0, 0, 0, 0x7C7C7C7C, 0, 0x7C7C7C7C);     \
        else { _Pragma("unroll") for (int k = 0; k < 2; ++k) acc[ai][bj][m][n] = __builtin_amdgcn_mfma_f32_16x16x32_bf16(Bt[n][k], At[m][k], acc[ai][bj][m][n], 0, 0, 0); } } __builtin_amdgcn_s_setprio(0); } while (0)
#define PG8_WAIT_V(n) asm volatile("s_waitcnt vmcnt(" #n ")" ::: "memory")
#define PG8_WAIT_L(n) asm volatile("s_waitcnt lgkmcnt(" #n ")" ::: "memory")
#define PG8_BAR __builtin_amdgcn_s_barrier()
#define PG8_SCHED __builtin_amdgcn_sched_barrier(0)
    Unit cur, nxt; int ui = 0;
    if (!S.next(0, cur)) return;
    Acc acc;
#pragma unroll
    for (int a = 0; a < 2; ++a)
#pragma unroll
        for (int b = 0; b < 2; ++b)
#pragma unroll
            for (int m = 0; m < 4; ++m)
#pragma unroll
                for (int n = 0; n < 2; ++n) acc[a][b][m][n] = (f32x4){0.f, 0.f, 0.f, 0.f};
    bf16x8 At[4][2], B0[2][2], B1[2][2];
    const char* cA = cur.a; const char* cB = cur.b;
    unsigned gc[2][2], gn[2][2];
    if constexpr (Sched::GATHER) { S.gather(cur, voffA, gc); }
    if constexpr (Epi::PREF) E.prefetch(cur);
    PG8_STAGE(PG8_SB(0, 0), cB, voffB); PG8_STAGE(PG8_SB(0, 1), cB + hstep, voffB); PG8_STAGE_A(PG8_SA(0, 0), cA, 0, gc); PG8_STAGE_A(PG8_SA(0, 1), cA, 1, gc);
    if (wr == 1) PG8_BAR;
    PG8_WAIT_V(2); PG8_BAR;
    PG8_STAGE(PG8_SB(1, 0), cB + kstep, voffB); PG8_STAGE_A(PG8_SA(1, 0), cA + kstep, 0, gc); PG8_STAGE(PG8_SB(1, 1), cB + hstep + kstep, voffB);
    PG8_WAIT_V(6); PG8_BAR;
    for (;;) {
        const bool has_next = S.next(ui + 1, nxt);
        const char* nA = has_next ? nxt.a : cA; const char* nB = has_next ? nxt.b : cB;
        if constexpr (Sched::GATHER) { if (has_next) S.gather(nxt, voffA, gn); else {
#pragma unroll
            for (int h = 0; h < 2; ++h)
#pragma unroll
                for (int i = 0; i < 2; ++i) gn[h][i] = gc[h][i]; } }
        for (int t = 0; t < nt; t += 2) {
            const bool last = (t == nt - 2);
            if constexpr (Epi::MIDK) { if (t == nt / 2) { int fr_e = fr; asm volatile("" : "+v"(fr_e)); E.midk(acc, cur, wr, fr_e); } }
            const char* a1 = cA + (size_t)(t + 1) * kstep;
            const char* a2 = last ? nA : cA + (size_t)(t + 2) * kstep; const char* b2 = last ? nB : cB + (size_t)(t + 2) * kstep;
            const char* a3 = a2 + kstep; const char* b3 = b2 + kstep;
            PG8_LDB(B0, 0, 0); PG8_LDB(B1, 0, 1); PG8_SCHED; PG8_LDA(At, 0, 0); PG8_STAGE_A(PG8_SA(1, 1), a1, 1, gc);
            if constexpr (Sched::GATHER) { if (last) {
#pragma unroll
                for (int h = 0; h < 2; ++h)
#pragma unroll
                    for (int i = 0; i < 2; ++i) gc[h][i] = gn[h][i]; } }
            PG8_WAIT_V(8); PG8_WAIT_L(0); PG8_BAR; PG8_MMA(0, 0, At, B0); PG8_MMA(0, 1, At, B1); PG8_BAR; PG8_SCHED;
            PG8_LDA(At, 0, 1); PG8_STAGE(PG8_SB(0, 0), b2, voffB); PG8_STAGE(PG8_SB(0, 1), b2 + hstep, voffB); PG8_STAGE_A(PG8_SA(0, 0), a2, 0, gc);
            PG8_WAIT_V(8); PG8_WAIT_L(0); PG8_BAR; PG8_MMA(1, 0, At, B0); PG8_MMA(1, 1, At, B1); PG8_BAR; PG8_SCHED;
            PG8_LDB(B0, 1, 0); PG8_LDB(B1, 1, 1); PG8_SCHED; PG8_LDA(At, 1, 0); PG8_STAGE_A(PG8_SA(0, 1), a2, 1, gc);
            PG8_WAIT_V(8); PG8_WAIT_L(0); PG8_BAR; PG8_MMA(0, 0, At, B0); PG8_MMA(0, 1, At, B1); PG8_BAR; PG8_SCHED;
            PG8_LDA(At, 1, 1); PG8_STAGE(PG8_SB(1, 0), b3, voffB); PG8_STAGE(PG8_SB(1, 1), b3 + hstep, voffB); PG8_STAGE_A(PG8_SA(1, 0), a3, 0, gc);
            PG8_WAIT_V(8); PG8_WAIT_L(0); PG8_BAR; PG8_MMA(1, 0, At, B0); PG8_MMA(1, 1, At, B1); PG8_BAR; PG8_SCHED;
        }
        if (wr == 0) PG8_BAR;
        { int fr_e = fr, fq_e = fq; asm volatile("" : "+v"(fr_e), "+v"(fq_e));
          E(acc, cur, wr, wc, fr_e, fq_e);
          if constexpr (EPI_TWICE != 0 && !Epi::INPLACE) { asm volatile("" : "+v"(fr_e), "+v"(fq_e)); E(acc, cur, wr, wc, fr_e, fq_e); } }
        if (!has_next) break;
#pragma unroll
        for (int a = 0; a < 2; ++a)
#pragma unroll
            for (int b = 0; b < 2; ++b)
#pragma unroll
                for (int m = 0; m < 4; ++m)
#pragma unroll
                    for (int n = 0; n < 2; ++n) acc[a][b][m][n] = (f32x4){0.f, 0.f, 0.f, 0.f};
        cur = nxt; cA = nA; cB = nB; ++ui;
        if constexpr (Epi::PREF) E.prefetch(cur);
        if (wr == 1) PG8_BAR;
    }
    PG8_WAIT_V(0);
    PG8_BAR;
#undef PG8_SA
#undef PG8_SB
#undef PG8_STAGE
#undef PG8_STAGE_A
#undef PG8_LDA
#undef PG8_LDB
#undef PG8_MMA
#undef PG8_WAIT_V
#undef PG8_WAIT_L
#undef PG8_BAR
#undef PG8_SCHED
}
}

namespace pg8 {
__device__ __forceinline__ void tile_of(int L, int nM, int nN, int& pm, int& pn) {
    const int nwg = nM * nN; int wgid = L; { const int q = nwg / 8, r = nwg % 8, xcd = wgid % 8, off = wgid / 8; wgid = (xcd < r ? xcd * (q + 1) : r * (q + 1) + (xcd - r) * q) + off; }
    const int nig = 8 * nN, gid = wgid / nig, fm = gid * 8, gsz = (nM - fm) < 8 ? (nM - fm) : 8;
    pm = fm + ((wgid % nig) % gsz); pn = (wgid % nig) / gsz;
}
struct SchedReg { static constexpr bool GATHER = false, FP8 = false;
    const char* A; const char* Bt; int nM, nN, G, c, rowbytes, bskip_from, bskip_rows;
    __device__ __forceinline__ bool next(int i, Unit& u) const { const int L = i * G + c; if (L >= nM * nN) return false; tile_of(L, nM, nN, u.pm, u.pn); u.e = 0; u.tl = 0; u.idx = i;
        u.a = A + (size_t)u.pm * 256 * rowbytes; const int brow = u.pn * 256 + (u.pn >= bskip_from ? bskip_rows : 0); u.b = Bt + (size_t)brow * rowbytes; return true; }
    __device__ __forceinline__ void gather(const Unit&, const unsigned (&)[2], unsigned (&)[2][2]) const {}
};
__device__ __forceinline__ void moe_unit_table(const LAS int* toff, LAS int* utab, int npn, int G, int c, int tid) {
    if (tid < 64) { int v = -1; const int ttot = toff[NE];
        int tile = -1, pn = 0;
        if (G == 256) { const int x = c & 7, j = c >> 3;
            if (npn == 16) { tile = 16 * tid + (j & 15); pn = 2 * x + (j >> 4); } else { tile = 32 * tid + x + 8 * (j >> 3); pn = j & 7; }
            if (tile >= ttot) tile = -1; }
        else { const int L = tid * G + c; if (L < ttot * npn) { int e = 0;
#pragma unroll 1
                for (int jj = 1; jj < NE; ++jj) e += (L >= toff[jj] * npn) ? 1 : 0;
                const int t0 = toff[e], ne = toff[e + 1] - t0, Ll = L - t0 * npn; pn = Ll / ne; tile = t0 + (Ll - pn * ne); } }
        if (tile >= 0) { int e = 0;
#pragma unroll 1
            for (int jj = 1; jj < NE; ++jj) e += (tile >= toff[jj]) ? 1 : 0;
            v = e | ((tile - toff[e]) << 8) | (pn << 16) | (tile << 21); }
        utab[tid] = v; }
}
template <bool G_> struct SchedMoE { static constexpr bool GATHER = G_, FP8 = true;
    const LAS int* utab; const LAS int* cnt; const int* list; const char* A; const char* Bt; int brows;
    __device__ __forceinline__ bool next(int i, Unit& u) const { if (i >= 64) return false; const int v = utab[i]; if (v < 0) return false; u.idx = i;
        u.e = v & 255; u.tl = (v >> 8) & 255; u.pn = (v >> 16) & 31; u.pm = (int)((unsigned)v >> 21);
        u.a = GATHER ? A : A + (size_t)u.pm * 256 * 2048; u.b = Bt + ((size_t)u.e * brows + u.pn * 256) * 2048; return true; }
    __device__ __forceinline__ void gather(const Unit& u, const unsigned (&voffA)[2], unsigned (&g)[2][2]) const {
        const int ce = cnt[u.e];
#pragma unroll
        for (int i = 0; i < 2; ++i) { int R, C; stage_rc((int)threadIdx.x * 16 + i * 8192, R, C);
#pragma unroll
            for (int h = 0; h < 2; ++h) { const int pos = u.tl * 256 + h * 128 + R; const int pc = pos < ce ? pos : ce - 1; const int tok = list[2 * ((size_t)u.e * NTOK + pc)]; g[h][i] = (unsigned)tok * 2048u + voffA[i]; } }
    }
};
struct SchedP1 { static constexpr bool GATHER = false, FP8 = false;
    const char* XB; const char* WIN; int G, c;
    __device__ __forceinline__ bool next(int i, Unit& u) const { const int L = i * G + c; if (L >= 2560) return false; u.tl = 0; u.idx = i;
        if (L < 2048) { tile_of(L, NTOK / 256, 16, u.pm, u.pn); u.e = 0; u.a = XB + (size_t)u.pm * 256 * 4096; u.b = WIN + (size_t)(u.pn * 256 + (u.pn >= 8 ? 1024 : 0)) * 4096; }
        else { tile_of(L - 2048, 4, NTOK / 256, u.pm, u.pn); u.e = 1; u.a = WIN + (size_t)(2048 + u.pm * 256) * 4096; u.b = XB + (size_t)u.pn * 256 * 4096; }
        return true; }
    __device__ __forceinline__ void gather(const Unit&, const unsigned (&)[2], unsigned (&)[2][2]) const {}
};
#define EPI_ROWS(ai, m) (u.pm * 256 + (ai) * 128 + wr * 64 + (m) * 16 + fr)
__device__ __forceinline__ v4u pack8(const f32x4 a, const f32x4 b) { v4u w; w.x = cvt_pk_bf16(a[0], a[1]); w.y = cvt_pk_bf16(a[2], a[3]); w.z = cvt_pk_bf16(b[0], b[1]); w.w = cvt_pk_bf16(b[2], b[3]); return w; }
struct EpiRowScale { static constexpr bool PERM = true, MIDK = false, INPLACE = false, PREF = true; const float* ss; bf16* out; int ld, split_cols; size_t split_stride; float mul0; LAS float* slots;
    __device__ __forceinline__ void prefetch(const Unit& u) const { const int tid = threadIdx.x, w = __builtin_amdgcn_readfirstlane(tid >> 6);
        if (w < 4) __builtin_amdgcn_global_load_lds((const unsigned*)(ss + u.pm * 256 + tid), (LAS unsigned*)(slots + (u.idx & 1) * 512 + w * 64), 4, 0, 0); }
    __device__ __forceinline__ void operator()(const Acc& acc, const Unit& u, int wr, int wc, int fr, int fq) const {
        int colt = u.pn * 256; bf16* base = out; float mul = mul0;
        if (split_cols) { const int t = colt / split_cols; base += (size_t)t * split_stride; colt -= t * split_cols; mul = t == 0 ? mul0 : 1.0f; }
        const int col0 = colt + wc * 32 + 8 * fq;
        float rs[2][4]; const LAS float* sl = slots + (u.idx & 1) * 512 + wr * 64 + fr;
#pragma unroll
        for (int ai = 0; ai < 2; ++ai)
#pragma unroll
            for (int m = 0; m < 4; ++m) rs[ai][m] = sl[ai * 128 + m * 16];
#pragma unroll
        for (int ai = 0; ai < 2; ++ai)
#pragma unroll
            for (int m = 0; m < 4; ++m) { const int row = EPI_ROWS(ai, m); const float r = rsqrtf(rs[ai][m] * (1.0f / DM) + EPS) * mul; bf16* rowp = base + (size_t)row * ld + col0;
#pragma unroll
                for (int bj = 0; bj < 2; ++bj) *(v4u*)(rowp + bj * 128) = pack8(acc[ai][bj][m][0] * r, acc[ai][bj][m][1] * r); }
    }
};
struct EpiColScale { static constexpr bool PERM = true, MIDK = false, INPLACE = false, PREF = true; const float* ss; bf16* out; size_t ld; LAS float* slots;
    __device__ __forceinline__ void prefetch(const Unit& u) const { const int tid = threadIdx.x, w = __builtin_amdgcn_readfirstlane(tid >> 6);
        if (w < 4) __builtin_amdgcn_global_load_lds((const unsigned*)(ss + u.pn * 256 + tid), (LAS unsigned*)(slots + (u.idx & 1) * 512 + w * 64), 4, 0, 0); }
    __device__ __forceinline__ void operator()(const Acc& acc, const Unit& u, int wr, int wc, int fr, int fq) const {
        f32x4 sc[2][2];
#pragma unroll
        for (int bj = 0; bj < 2; ++bj) { const LAS float* sl = slots + (u.idx & 1) * 512 + bj * 128 + wc * 32 + 8 * fq; sc[bj][0] = *(const LAS f32x4*)sl; sc[bj][1] = *(const LAS f32x4*)(sl + 4); }
#pragma unroll
        for (int bj = 0; bj < 2; ++bj) { const int c0 = u.pn * 256 + bj * 128 + wc * 32 + 8 * fq; f32x4 s0 = sc[bj][0], s1 = sc[bj][1];
#pragma unroll
            for (int j = 0; j < 4; ++j) { s0[j] = rsqrtf(s0[j] * (1.0f / DM) + EPS); s1[j] = rsqrtf(s1[j] * (1.0f / DM) + EPS); }
#pragma unroll
            for (int ai = 0; ai < 2; ++ai)
#pragma unroll
                for (int m = 0; m < 4; ++m) { const int row = EPI_ROWS(ai, m); *(v4u*)(out + (size_t)row * ld + c0) = pack8(acc[ai][bj][m][0] * s0, acc[ai][bj][m][1] * s1); } }
    }
};
struct EpiP1 { static constexpr bool PERM = true, MIDK = false, INPLACE = false, PREF = true; EpiRowScale rs; EpiColScale cs;
    __device__ __forceinline__ void prefetch(const Unit& u) const { if (u.e == 0) rs.prefetch(u); else cs.prefetch(u); }
    __device__ __forceinline__ void operator()(const Acc& acc, const Unit& u, int wr, int wc, int fr, int fq) const { if (u.e == 0) rs(acc, u, wr, wc, fr, fq); else cs(acc, u, wr, wc, fr, fq); }
};
struct EpiX1 { static constexpr bool PERM = true, MIDK = true, INPLACE = false, PREF = true; const float* scl; const bf16* x; float* x1; bf16* x1b; float* ss1p; LAS float* slots;
    __device__ __forceinline__ void prefetch(const Unit& u) const { const int tid = threadIdx.x, w = __builtin_amdgcn_readfirstlane(tid >> 6);
        __builtin_amdgcn_global_load_lds((const unsigned*)(scl + 2 * (size_t)(u.pm * 256 + (tid & 255)) + (tid >> 8)), (LAS unsigned*)(slots + (u.idx & 1) * 512 + w * 64), 4, 0, 0); }
    __device__ __forceinline__ void midk(Acc& acc, const Unit& u, int wr, int fr) const { const LAS float* sl = slots + (u.idx & 1) * 512 + wr * 64 + fr;
#pragma unroll
        for (int ai = 0; ai < 2; ++ai)
#pragma unroll
            for (int m = 0; m < 4; ++m) { const float s = sl[ai * 128 + m * 16];
#pragma unroll
                for (int bj = 0; bj < 2; ++bj) { acc[ai][bj][m][0] *= s; acc[ai][bj][m][1] *= s; } }
    }
    __device__ __forceinline__ void operator()(const Acc& acc, const Unit& u, int wr, int wc, int fr, int fq) const {
        const int col0 = u.pn * 256 + wc * 32 + 8 * fq; const LAS float* sl = slots + (u.idx & 1) * 512 + 256 + wr * 64 + fr;
#pragma unroll
        for (int ai = 0; ai < 2; ++ai) {
            v4u xw[4][2]; float sv[4];
#pragma unroll
            for (int m = 0; m < 4; ++m) { const int row = EPI_ROWS(ai, m); const size_t off = (size_t)row * DM + col0; sv[m] = sl[ai * 128 + m * 16];
#pragma unroll
                for (int bj = 0; bj < 2; ++bj) xw[m][bj] = *(const v4u*)(x + off + bj * 128); }
#pragma unroll
            for (int m = 0; m < 4; ++m) { const int row = EPI_ROWS(ai, m); const float s = sv[m]; const size_t off = (size_t)row * DM + col0; float q = 0.f;
#pragma unroll
                for (int bj = 0; bj < 2; ++bj) { const v4u w = xw[m][bj];
                    const f32x4 v0 = (f32x4){__uint_as_float(w.x << 16), __uint_as_float(w.x & 0xffff0000u), __uint_as_float(w.y << 16), __uint_as_float(w.y & 0xffff0000u)} + acc[ai][bj][m][0] * s,
                                v1 = (f32x4){__uint_as_float(w.z << 16), __uint_as_float(w.z & 0xffff0000u), __uint_as_float(w.w << 16), __uint_as_float(w.w & 0xffff0000u)} + acc[ai][bj][m][1] * s;
                    *(v4u*)(x1b + off + bj * 128) = pack8(v0, v1);
                    q += (v0[0] * v0[0] + v0[1] * v0[1]) + (v0[2] * v0[2] + v0[3] * v0[3]) + (v1[0] * v1[0] + v1[1] * v1[1]) + (v1[2] * v1[2] + v1[3] * v1[3]); }
                q += __shfl_xor(q, 16); q += __shfl_xor(q, 32);
                if (fq == 0) ss1p[(size_t)row * 32 + u.pn * 4 + wc] = q; } }
    }
};
struct EpiCQ { static constexpr bool PERM = true, MIDK = false, INPLACE = false, PREF = true; const float* ss1p; bf16* cq; LAS float* slots;
    __device__ __forceinline__ void prefetch(const Unit& u) const { const int tid = threadIdx.x;
        if (tid < 256) { const f32x4* sp = (const f32x4*)(ss1p + (size_t)(u.pm * 256 + tid) * 32); f32x4 t = sp[0];
#pragma unroll
            for (int j = 1; j < 8; ++j) t += sp[j];
            slots[(u.idx & 1) * 512 + tid] = rsqrtf(((t[0] + t[1]) + (t[2] + t[3])) * (1.0f / DM) + EPS) * CQSCALE; } }
    __device__ __forceinline__ void operator()(const Acc& acc, const Unit& u, int wr, int wc, int fr, int fq) const {
        const int col0 = u.pn * 256 + wc * 32 + 8 * fq; const LAS float* sl = slots + (u.idx & 1) * 512 + wr * 64 + fr;
        float rr[2][4];
#pragma unroll
        for (int ai = 0; ai < 2; ++ai)
#pragma unroll
            for (int m = 0; m < 4; ++m) rr[ai][m] = sl[ai * 128 + m * 16];
#pragma unroll
        for (int ai = 0; ai < 2; ++ai)
#pragma unroll
            for (int m = 0; m < 4; ++m) { const int row = EPI_ROWS(ai, m); const float r = rr[ai][m];
#pragma unroll
                for (int bj = 0; bj < 2; ++bj) *(v4u*)(cq + (size_t)row * XW + col0 + bj * 128) = pack8(acc[ai][bj][m][0] * r, acc[ai][bj][m][1] * r); }
    }
};
struct EpiX2 { static constexpr bool PERM = true, MIDK = false, INPLACE = false, PREF = false; const bf16* x1b; bf16* x2; unsigned char* x2b;
    __device__ __forceinline__ void operator()(const Acc& acc, const Unit& u, int wr, int wc, int fr, int fq) const {
        const int col0 = u.pn * 256 + wc * 32 + 8 * fq;
#pragma unroll
        for (int ai = 0; ai < 2; ++ai) { v4u xv[4][2];
#pragma unroll
            for (int m = 0; m < 4; ++m) { const size_t off = (size_t)EPI_ROWS(ai, m) * DM + col0;
#pragma unroll
                for (int bj = 0; bj < 2; ++bj) xv[m][bj] = *(const v4u*)(x1b + off + bj * 128); }
#pragma unroll
            for (int m = 0; m < 4; ++m) { const size_t off = (size_t)EPI_ROWS(ai, m) * DM + col0;
#pragma unroll
                for (int bj = 0; bj < 2; ++bj) { const v4u w = xv[m][bj];
                    const f32x4 v0 = (f32x4){__uint_as_float(w.x << 16), __uint_as_float(w.x & 0xffff0000u), __uint_as_float(w.y << 16), __uint_as_float(w.y & 0xffff0000u)} + acc[ai][bj][m][0],
                                v1 = (f32x4){__uint_as_float(w.z << 16), __uint_as_float(w.z & 0xffff0000u), __uint_as_float(w.w << 16), __uint_as_float(w.w & 0xffff0000u)} + acc[ai][bj][m][1];
                    *(v4u*)(x2 + off + bj * 128) = pack8(v0, v1); v2u o; o.x = pk4_fp8(v0[0], v0[1], v0[2], v0[3]); o.y = pk4_fp8(v1[0], v1[1], v1[2], v1[3]); *(v2u*)(x2b + off + bj * 128) = o; } } }
    }
};
struct EpiAct { static constexpr bool PERM = true, MIDK = false, INPLACE = false, PREF = true; const LAS int* cnt; const int* list; const float* r2; const float* b_gu; unsigned char* act; LAS float* slots;
    __device__ __forceinline__ void prefetch(const Unit& u) const { const int tid = threadIdx.x, w = __builtin_amdgcn_readfirstlane(tid >> 6); LAS float* s = slots + (u.idx & 1) * 512 + w * 64; const float* g;
        if (w < 4) { const int ce = cnt[u.e], pos = u.tl * 256 + tid, pc = pos < ce ? pos : ce - 1; g = (const float*)(list + 2 * ((size_t)u.e * NTOK + pc) + 1); }
        else { const int c = tid - 256; g = b_gu + (size_t)u.e * 4096 + (c >> 7) * 2048 + u.pn * 128 + (c & 127); }
        __builtin_amdgcn_global_load_lds((const unsigned*)g, (LAS unsigned*)s, 4, 0, 0); }
    __device__ __forceinline__ void operator()(const Acc& acc, const Unit& u, int wr, int wc, int fr, int fq) const {
        const int cb = u.pn * 128 + wc * 32 + 8 * fq; const LAS float* sl = slots + (u.idx & 1) * 512; const LAS float* bl = sl + 256 + wc * 32 + 8 * fq;
        const f32x4 bg0 = *(const LAS f32x4*)bl, bg1 = *(const LAS f32x4*)(bl + 4), bu0 = *(const LAS f32x4*)(bl + 128) + 1.0f, bu1 = *(const LAS f32x4*)(bl + 132) + 1.0f;
        float sv[2][4];
#pragma unroll
        for (int ai = 0; ai < 2; ++ai)
#pragma unroll
            for (int m = 0; m < 4; ++m) sv[ai][m] = sl[ai * 128 + wr * 64 + m * 16 + fr];
#pragma unroll
        for (int ai = 0; ai < 2; ++ai)
#pragma unroll
            for (int m = 0; m < 4; ++m) { const int r = ai * 128 + wr * 64 + m * 16 + fr; const float s = sv[ai][m];
                f32x4 g0 = acc[ai][0][m][0] * s + bg0, g1 = acc[ai][0][m][1] * s + bg1, u0 = acc[ai][1][m][0] * s + bu0, u1 = acc[ai][1][m][1] * s + bu1;
#pragma unroll
                for (int j = 0; j < 4; ++j) { g0[j] = fminf(g0[j], SW_LIMIT); g1[j] = fminf(g1[j], SW_LIMIT); u0[j] = __builtin_amdgcn_fmed3f(u0[j], 1.0f - SW_LIMIT, 1.0f + SW_LIMIT); u1[j] = __builtin_amdgcn_fmed3f(u1[j], 1.0f - SW_LIMIT, 1.0f + SW_LIMIT); }
                f32x4 z0 = g0 * (-SW_ALPHA * LOG2E), z1 = g1 * (-SW_ALPHA * LOG2E);
#pragma unroll
                for (int j = 0; j < 4; ++j) { z0[j] = __builtin_amdgcn_exp2f(z0[j]); z1[j] = __builtin_amdgcn_exp2f(z1[j]); }
                z0 = z0 + 1.0f; z1 = z1 + 1.0f;
#pragma unroll
                for (int j = 0; j < 4; ++j) { z0[j] = __builtin_amdgcn_rcpf(z0[j]); z1[j] = __builtin_amdgcn_rcpf(z1[j]); }
                g0 = u0 * (g0 * z0); g1 = u1 * (g1 * z1);
                v2u w; w.x = pk4_fp8(g0[0], g0[1], g0[2], g0[3]); w.y = pk4_fp8(g1[0], g1[1], g1[2], g1[3]); *(v2u*)(act + (size_t)(u.pm * 256 + r) * DFF + cb) = w; }
    }
};
struct EpiY { static constexpr bool PERM = true, MIDK = false, INPLACE = false, PREF = true; const float* b_dn; unsigned char* y; LAS float* slots;
    __device__ __forceinline__ void prefetch(const Unit& u) const { const int tid = threadIdx.x, w = __builtin_amdgcn_readfirstlane(tid >> 6);
        if (w < 4) __builtin_amdgcn_global_load_lds((const unsigned*)(b_dn + (size_t)u.e * DM + u.pn * 256 + tid), (LAS unsigned*)(slots + (u.idx & 1) * 512 + 256 + w * 64), 4, 0, 0); }
    __device__ __forceinline__ void operator()(const Acc& acc, const Unit& u, int wr, int wc, int fr, int fq) const {
        const int col0 = u.pn * 256 + wc * 32 + 8 * fq; const LAS float* bl = slots + (u.idx & 1) * 512 + 256 + wc * 32 + 8 * fq;
        f32x4 bb[2][2];
#pragma unroll
        for (int bj = 0; bj < 2; ++bj) { bb[bj][0] = *(const LAS f32x4*)(bl + bj * 128); bb[bj][1] = *(const LAS f32x4*)(bl + bj * 128 + 4); }
#pragma unroll
        for (int bj = 0; bj < 2; ++bj) { const f32x4 b0 = bb[bj][0], b1 = bb[bj][1];
#pragma unroll
            for (int ai = 0; ai < 2; ++ai)
#pragma unroll
                for (int m = 0; m < 4; ++m) { const f32x4 v0 = acc[ai][bj][m][0] + b0, v1 = acc[ai][bj][m][1] + b1; v2u w; w.x = pk4_fp8(v0[0], v0[1], v0[2], v0[3]); w.y = pk4_fp8(v1[0], v1[1], v1[2], v1[3]);
                    *(v2u*)(y + (size_t)EPI_ROWS(ai, m) * DM + col0 + bj * 128) = w; } }
    }
};
#undef EPI_ROWS
}

#define GLDS16(gp, lp) __builtin_amdgcn_global_load_lds((const unsigned*)(gp), (LAS unsigned*)(lp), 16, 0, 0)
#define MFMA32(a, b, c) __builtin_amdgcn_mfma_f32_32x32x16_bf16((a), (b), (c), 0, 0, 0)
#define MFMA16(a, b, c) __builtin_amdgcn_mfma_f32_16x16x32_bf16((a), (b), (c), 0, 0, 0)
typedef __bf16 bf16x2_t __attribute__((ext_vector_type(2)));
__device__ __forceinline__ unsigned cvtpk(float lo, float hi) { const f32x2 v = {lo, hi}; return __builtin_bit_cast(unsigned, __builtin_convertvector(v, bf16x2_t)); }
__device__ __forceinline__ bf16x8 pack_p(const f32x16& p, int s) {
    v4u w; w.x = cvtpk(p[8 * s + 0], p[8 * s + 1]); w.y = cvtpk(p[8 * s + 2], p[8 * s + 3]); w.z = cvtpk(p[8 * s + 4], p[8 * s + 5]); w.w = cvtpk(p[8 * s + 6], p[8 * s + 7]);
    return __builtin_bit_cast(bf16x8, w);
}
__device__ __forceinline__ int pi32(int r) { return (r & 0x13) | ((r & 4) << 1) | ((r & 8) >> 1); }
__device__ __forceinline__ float max3f(float a, float b, float c) { float r; asm("v_max3_f32 %0, %1, %2, %3" : "=v"(r) : "v"(a), "v"(b), "v"(c)); return r; }
__device__ __forceinline__ float max32(const f32x16& p, const f32x16& q) {
    float a = max3f(p[0], p[1], p[2]), b = max3f(p[3], p[4], p[5]), c = max3f(p[6], p[7], p[8]), d = max3f(p[9], p[10], p[11]);
    a = max3f(a, p[12], p[13]); b = max3f(b, p[14], p[15]); c = max3f(c, q[0], q[1]); d = max3f(d, q[2], q[3]);
    a = max3f(a, q[4], q[5]); b = max3f(b, q[6], q[7]); c = max3f(c, q[8], q[9]); d = max3f(d, q[10], q[11]);
    a = max3f(a, q[12], q[13]); b = max3f(b, q[14], q[15]); return max3f(max3f(a, b, c), d, d); }
__device__ __forceinline__ float max16(const f32x16& p) { float a = fmaxf(fmaxf(p[0], p[1]), fmaxf(p[2], p[3])), b = fmaxf(fmaxf(p[4], p[5]), fmaxf(p[6], p[7])), c = fmaxf(fmaxf(p[8], p[9]), fmaxf(p[10], p[11])), d = fmaxf(fmaxf(p[12], p[13]), fmaxf(p[14], p[15])); return fmaxf(fmaxf(a, b), fmaxf(c, d)); }
__device__ __forceinline__ float sum16(const f32x16& p) { return ((p[0] + p[1]) + (p[2] + p[3])) + ((p[4] + p[5]) + (p[6] + p[7])) + ((p[8] + p[9]) + (p[10] + p[11])) + ((p[12] + p[13]) + (p[14] + p[15])); }

namespace battn {
constexpr int NS = 6, SLOT = 16384, TAB_OFF = NS * SLOT;
__device__ __forceinline__ void unit(LAS unsigned char* lds, const bf16* __restrict__ Q, const bf16* __restrict__ Kp, const bf16* __restrict__ VT, const float* __restrict__ rel, bf16* mix, float* ssa, int b, int h, int u) {
    const int tid = threadIdx.x, lane = tid & 63, wave = __builtin_amdgcn_readfirstlane(tid >> 6), r32 = lane & 31, hh = lane >> 5, j = wave >> 1, qh = wave & 1, c0 = 4 * u;
    LAS float* tab = (LAS float*)(lds + TAB_OFF);
    const int tix = tid < RELW ? tid : RELW - 1; const float trel = rel[h * RELW + tix], tfar = rel[h * RELW + RELW - 1];
    const int lrow = tid >> 3, lchunk = (tid & 7) ^ ((lrow >> 1) & 7);
    const bf16* ksrc = Kp + ((size_t)b * SEQ + lrow) * 1024 + h * 64 + lchunk * 8;
    const bf16* vsrc = VT + (size_t)(h * 64 + lrow) * NTOK + (size_t)b * SEQ + lchunk * 8;
#define BA_LOAD(T) do { const int _sl = (((T) + 12) % NS) * SLOT + wave * 1024; const int _t = (T) < 0 ? 0 : (T); GLDS16(ksrc + (size_t)_t * 64 * 1024, lds + _sl); GLDS16(vsrc + (size_t)_t * 64, lds + _sl + 8192); } while (0)
    const size_t tok = (size_t)b * SEQ + (c0 + j) * 64 + 32 * qh + r32;
    bf16x8 qf[4];
#pragma unroll
    for (int d0 = 0; d0 < 4; ++d0) qf[d0] = *(const bf16x8*)(Q + tok * 1024 + h * 64 + 16 * d0 + 8 * hh);
#pragma unroll
    for (int T = c0 - 8; T < c0 - 3; ++T) BA_LOAD(T);
    if (tid < 320) tab[tid] = (trel - tfar) * LOG2E;
    asm volatile("s_waitcnt vmcnt(2) lgkmcnt(0)" ::: "memory"); __builtin_amdgcn_s_barrier(); asm volatile("" ::: "memory");
    float mrun = 0.f; f32x16 o0 = {}, o1 = {}, o2 = {}; bool first = true;
    f32x16 cfarv;
    const bf16x8 onesf = (r32 == 0) ? (bf16x8){0x3f80, 0x3f80, 0x3f80, 0x3f80, 0x3f80, 0x3f80, 0x3f80, 0x3f80} : (bf16x8){0, 0, 0, 0, 0, 0, 0, 0};
    constexpr float THR = 8.0f;
    const float cfar = rel[h * RELW + RELW - 1] * LOG2E;
#pragma unroll
    for (int r = 0; r < 16; ++r) cfarv[r] = cfar;
    const int k0r = pi32(r32), ks0 = (k0r >> 1) & 7, vs0 = (r32 >> 1) & 7;
    unsigned kof[4], vof[4];
#pragma unroll
    for (int d0 = 0; d0 < 4; ++d0) { kof[d0] = (unsigned)(k0r * 128 + (((2 * d0 + hh) ^ ks0) << 4)); vof[d0] = (unsigned)(8192 + r32 * 128 + (((2 * d0 + hh) ^ vs0) << 4)); asm volatile("" : "+v"(kof[d0]), "+v"(vof[d0])); }
#pragma unroll 1
    for (int s = 0; s < 9; ++s) {
        if (s < 7) BA_LOAD(c0 - 3 + s);
        const int T = c0 + j - 8 + s;
        if (T >= 0) {
            unsigned sbo = (unsigned)(((T + 12) % NS) * SLOT); asm volatile("" : "+s"(sbo));
            const int dj = 8 - s;
            bf16x8 kf0[4], kf1[4], vf0[4], vf1[4];
#pragma unroll
            for (int d0 = 0; d0 < 4; ++d0) { const LAS unsigned char* kp_ = lds + (kof[d0] + sbo); kf0[d0] = *(const LAS bf16x8*)kp_; kf1[d0] = *(const LAS bf16x8*)(kp_ + 4096); }
#pragma unroll
            for (int d0 = 0; d0 < 4; ++d0) { const LAS unsigned char* vp_ = lds + (vof[d0] + sbo); vf0[d0] = *(const LAS bf16x8*)vp_; vf1[d0] = *(const LAS bf16x8*)(vp_ + 4096); }
            f32x16 p0 = MFMA32(kf0[0], qf[0], cfarv), p1 = MFMA32(kf1[0], qf[0], cfarv);
#pragma unroll
            for (int d0 = 1; d0 < 4; ++d0) { p0 = MFMA32(kf0[d0], qf[d0], p0); p1 = MFMA32(kf1[d0], qf[d0], p1); }
            if (dj < 3) { const LAS float* tb = tab + (64 * dj + 32 * qh + r32 + 128 - 8 * hh - 55); asm volatile("" : "+v"(tb));
#pragma unroll
                for (int r = 0; r < 16; ++r) { p0[r] += tb[55 - (16 * (r >> 3) + (r & 7))]; p1[r] += tb[23 - (16 * (r >> 3) + (r & 7))]; } }
            asm volatile("s_nop 15\n\ts_nop 7" : "+v"(p0), "+v"(p1));
            float mx = max32(p0, p1); mx = fmaxf(mx, __shfl_xor(mx, 32));
            if (first || __any(mx > THR)) {
                const float dl = first ? mx : fmaxf(mx, 0.f); mrun += dl;
                const float corr = first ? 1.0f : __builtin_amdgcn_exp2f(-dl); first = false;
#pragma unroll
                for (int r = 0; r < 16; ++r) { p0[r] -= dl; p1[r] -= dl; o0[r] *= corr; o1[r] *= corr; cfarv[r] = cfar - mrun; }
                o2[0] *= corr; }
#pragma unroll
            for (int r = 0; r < 16; ++r) { p0[r] = __builtin_amdgcn_exp2f(p0[r]); p1[r] = __builtin_amdgcn_exp2f(p1[r]); }
            const bf16x8 pf00 = pack_p(p0, 0), pf01 = pack_p(p0, 1), pf10 = pack_p(p1, 0), pf11 = pack_p(p1, 1);
#define BA_V(c, hi) ((hi) ? vf1[c] : vf0[c])
            o0 = MFMA32(BA_V(0, 0), pf00, o0); o0 = MFMA32(BA_V(1, 0), pf01, o0); o0 = MFMA32(BA_V(2, 0), pf10, o0); o0 = MFMA32(BA_V(3, 0), pf11, o0);
            o1 = MFMA32(BA_V(0, 1), pf00, o1); o1 = MFMA32(BA_V(1, 1), pf01, o1); o1 = MFMA32(BA_V(2, 1), pf10, o1); o1 = MFMA32(BA_V(3, 1), pf11, o1);
            o2 = MFMA32(onesf, pf00, o2); o2 = MFMA32(onesf, pf01, o2); o2 = MFMA32(onesf, pf10, o2); o2 = MFMA32(onesf, pf11, o2);
#undef BA_V
        }
        if (s < 7) asm volatile("s_waitcnt vmcnt(2) lgkmcnt(0)" ::: "memory"); else asm volatile("s_waitcnt vmcnt(0) lgkmcnt(0)" ::: "memory");
        __builtin_amdgcn_s_barrier(); asm volatile("" ::: "memory");
    }
#undef BA_LOAD
    const float lden = hh == 0 ? o2[0] : 0.f;
    const float inv = 1.0f / (lden + __shfl_xor(lden, 32)); float ss = 0.f;
#pragma unroll
    for (int r = 0; r < 16; ++r) { o0[r] *= inv; o1[r] *= inv; ss += o0[r] * o0[r] + o1[r] * o1[r]; }
    ss += __shfl_xor(ss, 32); if (hh == 0) ssa[tok * 16 + h] = ss;
    bf16* op = mix + tok * DM + h * 64 + 4 * hh;
#pragma unroll
    for (int g = 0; g < 4; ++g) { v2u w; w.x = pg8::cvt_pk_bf16(o0[4 * g], o0[4 * g + 1]); w.y = pg8::cvt_pk_bf16(o0[4 * g + 2], o0[4 * g + 3]); *(v2u*)(op + 8 * g) = w;
        w.x = pg8::cvt_pk_bf16(o1[4 * g], o1[4 * g + 1]); w.y = pg8::cvt_pk_bf16(o1[4 * g + 2], o1[4 * g + 3]); *(v2u*)(op + 32 + 8 * g) = w; }
}
}

namespace xattn {
__device__ __forceinline__ void unit(LAS unsigned char* lds, const bf16* __restrict__ CQ, const bf16* __restrict__ CK, const bf16* __restrict__ CVT, bf16* ox, int b, int h, int qb, bool reload) {
    const int tid = threadIdx.x, lane = tid & 63, wave = __builtin_amdgcn_readfirstlane(tid >> 6), r32 = lane & 31, hh = lane >> 5;
    if (reload) {
#pragma unroll
        for (int i = 0; i < 8; ++i) { const int idx = i * 512 + tid;
            const int kr = idx >> 4, kc = (idx & 15) ^ (kr & 15); GLDS16(CK + ((size_t)b * MEML + kr) * XW + h * XHD + kc * 8, lds + i * 8192 + wave * 1024);
            const int vr = idx >> 5, vc = (idx & 31) ^ (vr & 15); GLDS16(CVT + (size_t)(h * XHD + vr) * NMEM + (size_t)b * MEML + vc * 8, lds + 65536 + i * 8192 + wave * 1024); }
    }
    const size_t tok = (size_t)b * SEQ + qb * 256 + wave * 32 + r32;
    bf16x8 qf[8];
#pragma unroll
    for (int d0 = 0; d0 < 8; ++d0) qf[d0] = *(const bf16x8*)(CQ + tok * XW + h * XHD + 16 * d0 + 8 * hh);
    asm volatile("s_waitcnt vmcnt(0)" ::: "memory"); __builtin_amdgcn_s_barrier(); asm volatile("" ::: "memory");
    float mrun = -1e30f, lsum = 0.f; f32x16 o[4] = {};
    const int kp = pi32(r32);
    unsigned xkof[8];
#pragma unroll
    for (int d0 = 0; d0 < 8; ++d0) { xkof[d0] = (unsigned)(kp * 256 + (((2 * d0 + hh) ^ (kp & 15)) << 4)); asm volatile("" : "+v"(xkof[d0])); }
#pragma unroll 1
    for (int s = 0; s < 4; ++s) {
        f32x16 p0 = {}, p1 = {};
        unsigned so = (unsigned)(s * 16384); asm volatile("" : "+s"(so));
        bf16x8 kf0[8], kf1[8];
#pragma unroll
        for (int d0 = 0; d0 < 8; ++d0) { const LAS unsigned char* kp_ = lds + (xkof[d0] + so); kf0[d0] = *(const LAS bf16x8*)kp_; kf1[d0] = *(const LAS bf16x8*)(kp_ + 8192); }
#pragma unroll
        for (int d0 = 0; d0 < 8; ++d0) { p0 = MFMA32(kf0[d0], qf[d0], p0); p1 = MFMA32(kf1[d0], qf[d0], p1); }
        asm volatile("s_nop 15\n\ts_nop 7" : "+v"(p0), "+v"(p1));
        float mx = max32(p0, p1); mx = fmaxf(mx, __shfl_xor(mx, 32));
        const float mnew = fmaxf(mrun, mx), corr = __builtin_amdgcn_exp2f(mrun - mnew); mrun = mnew;
#pragma unroll
        for (int r = 0; r < 16; ++r) { p0[r] = __builtin_amdgcn_exp2f(p0[r] - mnew); p1[r] = __builtin_amdgcn_exp2f(p1[r] - mnew); }
        lsum = lsum * corr + (sum16(p0) + sum16(p1));
        const bf16x8 pf00 = pack_p(p0, 0), pf01 = pack_p(p0, 1), pf10 = pack_p(p1, 0), pf11 = pack_p(p1, 1);
#pragma unroll
        for (int dh = 0; dh < 4; ++dh) { const int vr = 32 * dh + r32; const LAS unsigned char* vb = lds + 65536 + vr * 512;
#pragma unroll
            for (int r = 0; r < 16; ++r) o[dh][r] *= corr;
#define XA_V(c) (*(const LAS bf16x8*)(vb + ((((8 * s + (c) + hh)) ^ (vr & 15)) << 4)))
            o[dh] = MFMA32(XA_V(0), pf00, o[dh]); o[dh] = MFMA32(XA_V(2), pf01, o[dh]); o[dh] = MFMA32(XA_V(4), pf10, o[dh]); o[dh] = MFMA32(XA_V(6), pf11, o[dh]);
#undef XA_V
        }
    }
    const float inv = 1.0f / (lsum + __shfl_xor(lsum, 32));
    bf16* op = ox + tok * XW + h * XHD + 4 * hh;
#pragma unroll
    for (int dh = 0; dh < 4; ++dh)
#pragma unroll
        for (int g = 0; g < 4; ++g) { v2u w; w.x = pg8::cvt_pk_bf16(o[dh][4 * g] * inv, o[dh][4 * g + 1] * inv); w.y = pg8::cvt_pk_bf16(o[dh][4 * g + 2] * inv, o[dh][4 * g + 3] * inv); *(v2u*)(op + 32 * dh + 8 * g) = w; }
    asm volatile("s_waitcnt lgkmcnt(0)" ::: "memory"); __builtin_amdgcn_s_barrier(); asm volatile("" ::: "memory");
}
}

namespace lru {
constexpr int XA_P = 272, XA_OFF = 0, XF_OFF = 64 * XA_P, SA_OFF = XF_OFF + 64 * 64 * 4, SB_OFF = SA_OFF + 64 * 68 * 4, SC_OFF = SB_OFF + 64 * 68 * 4, HS_OFF = SC_OFF + 8 * 64 * 8, END_OFF = HS_OFF + 256;
__device__ __forceinline__ float fsig(float x) { return __builtin_amdgcn_rcpf(1.0f + __builtin_amdgcn_exp2f(-LOG2E * x)); }
__device__ __forceinline__ void unit(LAS unsigned char* lds, const bf16* __restrict__ xr, const bf16* __restrict__ yg, const float* __restrict__ conv_w, const float* __restrict__ conv_b, const bf16* __restrict__ wga_t, const bf16* __restrict__ wgx_t,
                                     const float* __restrict__ b_ga, const float* __restrict__ b_gx, const float* __restrict__ lam, bf16* mix, float* ssl, int b, int g) {
    const int tid = threadIdx.x, lane = tid & 63, wave = __builtin_amdgcn_readfirstlane(tid >> 6), n = g >> 1, hf = g & 1;
    LAS float* XF = (LAS float*)(lds + XF_OFF); LAS float* SA = (LAS float*)(lds + SA_OFF); LAS float* SB = (LAS float*)(lds + SB_OFF); LAS f32x2* SC = (LAS f32x2*)(lds + SC_OFF); LAS float* HS = (LAS float*)(lds + HS_OFF);
    if (tid < 64) HS[tid] = 0.f;
    const int tb = wave & 3, dq = wave >> 2, l15 = lane & 15, l4 = lane >> 4;
    bf16x8 wf[2][2][4];
#pragma unroll
    for (int dt = 0; dt < 2; ++dt)
#pragma unroll
        for (int ks = 0; ks < 4; ++ks) { const size_t off = (size_t)(n * 128 + hf * 64 + dq * 32 + 16 * dt + l15) * 128 + 32 * ks + 8 * l4;
            wf[0][dt][ks] = *(const bf16x8*)(wga_t + off); wf[1][dt][ks] = *(const bf16x8*)(wgx_t + off); }
    float cba[2][4], cbx[2][4], csp[2][4];
#pragma unroll
    for (int dt = 0; dt < 2; ++dt)
#pragma unroll
        for (int r = 0; r < 4; ++r) { const int c = n * 128 + hf * 64 + dq * 32 + 16 * dt + 4 * l4 + r; cba[dt][r] = -LOG2E * b_ga[c]; cbx[dt][r] = -LOG2E * b_gx[c]; csp[dt][r] = LOG2E * (-8.0f * log1pf(__expf(-lam[c]))); }
    float cw0[4], cw1[4];
#pragma unroll
    for (int jj = 0; jj < 4; ++jj) { cw0[jj] = conv_w[jj * LW + n * 128 + 2 * lane]; cw1[jj] = conv_w[jj * LW + n * 128 + 2 * lane + 1]; }
    const float cb0 = conv_b[n * 128 + 2 * lane], cb1 = conv_b[n * 128 + 2 * lane + 1];
#define LRU_UNI(p) ({ const unsigned long long _p = (unsigned long long)(p); (GAS char*)(((unsigned long long)(unsigned)__builtin_amdgcn_readfirstlane((int)(_p >> 32)) << 32) | (unsigned)__builtin_amdgcn_readfirstlane((int)_p)); })
#define LRU_VO(v) ({ unsigned _v = (v); asm volatile("" : "+v"(_v)); _v; })
#define LRU_SP(p) ({ GAS char* _q = (GAS char*)(p); asm volatile("" : "+s"(_q)); _q; })
    const GAS char* xru = LRU_UNI(xr + ((size_t)b * SEQ + 8 * wave) * 1024 + n * 128);
    const unsigned lo4 = 4u * (unsigned)lane, lo2 = 2u * (unsigned)lane;
    const int cc = lane, sg = wave;
    const GAS char* ygu = LRU_UNI(yg + ((size_t)b * SEQ + 8 * sg) * 1024 + n * 128 + hf * 64);
    GAS char* outu = LRU_UNI(mix + ((size_t)b * SEQ + 8 * sg) * DM + 1024 + n * 128 + hf * 64);
    unsigned xq[11]; bf16 yv[8];
#define LRU_LOADX(t0) do { _Pragma("unroll") for (int k = 0; k < 11; ++k) { const int trow = (t0) + 8 * wave - 3 + k; xq[k] = trow >= 0 ? *(const GAS unsigned*)(LRU_SP(xru + ((ptrdiff_t)((t0) - 3 + k)) * 2048) + LRU_VO(lo4)) : 0u; } \
        _Pragma("unroll") for (int i = 0; i < 8; ++i) yv[i] = *(const GAS bf16*)(LRU_SP(ygu + ((size_t)(t0) + i) * 2048) + LRU_VO(lo2)); } while (0)
    LRU_LOADX(0);
    asm volatile("s_waitcnt lgkmcnt(0)" ::: "memory"); __builtin_amdgcn_s_barrier(); asm volatile("" ::: "memory");
#pragma unroll 1
    for (int t0 = 0; t0 < SEQ; t0 += 64) {
        { f32x2 xe[11];
#pragma unroll
          for (int k = 0; k < 11; ++k) xe[k] = (f32x2){__uint_as_float(xq[k] << 16), __uint_as_float(xq[k] & 0xffff0000u)};
#pragma unroll
          for (int i = 0; i < 8; ++i) { f32x2 xc2 = (f32x2){cb0, cb1};
#pragma unroll
            for (int jj = 0; jj < 4; ++jj) xc2 += (f32x2){cw0[jj], cw1[jj]} * xe[i + jj];
            *(LAS unsigned*)(lds + XA_OFF + (8 * wave + i) * XA_P + 4 * lane) = cvtpk(xc2.x, xc2.y);
            if ((lane >> 5) == hf) *(LAS f32x2*)(XF + (8 * wave + i) * 64 + 2 * (lane & 31)) = xc2; } }
        bf16 ycur[8];
#pragma unroll
        for (int i = 0; i < 8; ++i) ycur[i] = yv[i];
        if (t0 + 64 < SEQ) LRU_LOADX(t0 + 64);
        asm volatile("s_waitcnt lgkmcnt(0)" ::: "memory"); __builtin_amdgcn_s_barrier(); asm volatile("" ::: "memory");
        {
            f32x4 ar[2] = {}, ai[2] = {};
#pragma unroll
            for (int ks = 0; ks < 4; ++ks) { const bf16x8 xfr = *(const LAS bf16x8*)(lds + XA_OFF + (16 * tb + l15) * XA_P + 64 * ks + 16 * l4);
#pragma unroll
                for (int dt = 0; dt < 2; ++dt) { ar[dt] = MFMA16(wf[0][dt][ks], xfr, ar[dt]); ai[dt] = MFMA16(wf[1][dt][ks], xfr, ai[dt]); } }
            const int tk = 16 * tb + l15;
#pragma unroll
            for (int dt = 0; dt < 2; ++dt) { const int dl = dq * 32 + 16 * dt + 4 * l4; const f32x4 xo = *(const LAS f32x4*)(XF + tk * 64 + dl); f32x4 av, bv;
#pragma unroll
                for (int r = 0; r < 4; ++r) { const float rg = __builtin_amdgcn_rcpf(1.0f + __builtin_amdgcn_exp2f(fmaf(ar[dt][r], -LOG2E, cba[dt][r]))), ig = __builtin_amdgcn_rcpf(1.0f + __builtin_amdgcn_exp2f(fmaf(ai[dt][r], -LOG2E, cbx[dt][r])));
                    const float a_ = __builtin_amdgcn_exp2f(rg * csp[dt][r]); av[r] = a_;
                    bv[r] = __builtin_amdgcn_sqrtf(fmaxf(1.0f - a_ * a_, 0.f)) * (ig * xo[r]); }
                *(LAS f32x4*)(SA + tk * 68 + dl) = av; *(LAS f32x4*)(SB + tk * 68 + dl) = bv; }
        }
        asm volatile("s_waitcnt lgkmcnt(0)" ::: "memory"); __builtin_amdgcn_s_barrier(); asm volatile("" ::: "memory");
        float a8[8], b8[8];
        { float A = 1.f, B = 0.f;
#pragma unroll
            for (int i = 0; i < 8; ++i) { a8[i] = SA[(8 * sg + i) * 68 + cc]; b8[i] = SB[(8 * sg + i) * 68 + cc]; B = a8[i] * B + b8[i]; A *= a8[i]; }
            SC[sg * 64 + cc] = (f32x2){A, B}; }
        asm volatile("s_waitcnt lgkmcnt(0)" ::: "memory"); __builtin_amdgcn_s_barrier(); asm volatile("" ::: "memory");
        {
            float hcur = HS[cc];
#pragma unroll
            for (int s2 = 0; s2 < 7; ++s2) { const f32x2 ab = SC[s2 * 64 + cc]; if (s2 < sg) hcur = ab.x * hcur + ab.y; }
            float ysq[8];
#pragma unroll
            for (int i = 0; i < 8; ++i) { hcur = a8[i] * hcur + b8[i]; const float x = bf2f(ycur[i]);
                const float zg = x * fmaf(x * x, -LOG2E * 1.5957691216f * 0.044715f, -LOG2E * 1.5957691216f);
                const float y = hcur * (x * __builtin_amdgcn_rcpf(1.0f + __builtin_amdgcn_exp2f(zg))); *(GAS bf16*)(LRU_SP(outu + ((size_t)t0 + i) * (DM * 2)) + LRU_VO(lo2)) = (bf16)(cvtpk(y, 0.f) & 0xffffu); ysq[i] = y * y; }
#pragma unroll
            for (int i = 0; i < 8; ++i) { float v = ysq[i];
                v += __builtin_bit_cast(float, __builtin_amdgcn_update_dpp(0, __builtin_bit_cast(int, v), 0xB1, 0xf, 0xf, true));
                v += __builtin_bit_cast(float, __builtin_amdgcn_update_dpp(0, __builtin_bit_cast(int, v), 0x4E, 0xf, 0xf, true));
                v += __builtin_bit_cast(float, __builtin_amdgcn_update_dpp(0, __builtin_bit_cast(int, v), 0x141, 0xf, 0xf, true));
                v += __builtin_bit_cast(float, __builtin_amdgcn_update_dpp(0, __builtin_bit_cast(int, v), 0x140, 0xf, 0xf, true));
                v += __builtin_bit_cast(float, __builtin_amdgcn_update_dpp(0, __builtin_bit_cast(int, v), 0x142, 0xa, 0xf, false));
                v += __builtin_bit_cast(float, __builtin_amdgcn_update_dpp(0, __builtin_bit_cast(int, v), 0x143, 0xc, 0xf, false));
                ysq[i] = v; }
            if (lane == 63) {
#pragma unroll
                for (int i = 0; i < 8; ++i) ssl[((size_t)b * SEQ + t0 + 8 * sg + i) * 16 + g] = ysq[i]; }
            asm volatile("s_waitcnt lgkmcnt(0)" ::: "memory"); __builtin_amdgcn_s_barrier(); asm volatile("" ::: "memory");
            if (sg == 7) HS[cc] = hcur;
        }
    }
#undef LRU_LOADX
#undef LRU_VO
#undef LRU_SP
#undef LRU_UNI
    asm volatile("s_waitcnt vmcnt(0) lgkmcnt(0)" ::: "memory"); __builtin_amdgcn_s_barrier(); asm volatile("" ::: "memory");
}
}

constexpr int NWAVES = 8, NPHASE = 12;
constexpr int RING_BYTES = 131072, LDSCTL_OFF = RING_BYTES, MISC_OFF = LDSCTL_OFF + 320, LDS_BYTES = 147456;
#define LDS_WAIT() asm volatile("s_waitcnt lgkmcnt(0)" ::: "memory")
#define VM_WAIT() asm volatile("s_waitcnt vmcnt(0)" ::: "memory")

struct TrItem { const float* W; const float* gain; unsigned char* WT; int N, K, k0, n0, drow0, is8; };
__device__ __forceinline__ void tr_load(const TrItem& d, f32x4 (&v)[16], int lane) {
    const int g = lane & 7, r0 = lane >> 3;
#pragma unroll
    for (int i = 0; i < 8; ++i) v[i] = __builtin_nontemporal_load((const GAS f32x4*)(d.W + (size_t)(d.k0 + r0 + 8 * i) * d.N + d.n0 + 4 * g));
    if (d.is8) {
#pragma unroll
        for (int i = 8; i < 16; ++i) v[i] = __builtin_nontemporal_load((const GAS f32x4*)(d.W + (size_t)(d.k0 + r0 + 8 * i) * d.N + d.n0 + 4 * g)); }
}
__device__ __forceinline__ void tr_finish(const TrItem& d, const f32x4 (&v)[16], LAS float* scr, int lane_) {
    int lane = lane_; asm volatile("" : "+v"(lane));
    const int c = lane & 7;
    if (d.is8) {
        { const int g = lane & 7, r0 = lane >> 3;
#pragma unroll
          for (int i = 0; i < 16; ++i) { const float gs = (d.gain ? d.gain[d.k0 + r0 + 8 * i] : 1.0f) * W8_SCALE; *(LAS f32x4*)(scr + (r0 + 8 * i) * 32 + ((g ^ (i >> 1)) << 2)) = v[i] * gs;
              if ((i & 3) == 3) asm volatile("" ::: "memory"); } }
        LDS_WAIT(); asm volatile("" ::: "memory");
#pragma unroll
        for (int j = 0; j < 4; ++j) { const int n = (lane >> 3) + 8 * j; const LAS float* s = scr + (16 * c) * 32 + ((((n >> 2) ^ c) << 2) + (n & 3));
            v4u o; o.x = pk4_fp8(s[0 * 32], s[1 * 32], s[2 * 32], s[3 * 32]); o.y = pk4_fp8(s[4 * 32], s[5 * 32], s[6 * 32], s[7 * 32]); o.z = pk4_fp8(s[8 * 32], s[9 * 32], s[10 * 32], s[11 * 32]); o.w = pk4_fp8(s[12 * 32], s[13 * 32], s[14 * 32], s[15 * 32]);
            __builtin_nontemporal_store(o, (GAS v4u*)(d.WT + (size_t)(d.drow0 + n) * d.K + d.k0 + 16 * c)); }
    } else {
        { const int g = lane & 7, r0 = lane >> 3;
#pragma unroll
          for (int i = 0; i < 8; ++i) *(LAS f32x4*)(scr + (r0 + 8 * i) * 32 + ((g ^ i) << 2)) = v[i]; }
        LDS_WAIT(); asm volatile("" ::: "memory");
        float g[8];
#pragma unroll
        for (int j = 0; j < 8; ++j) g[j] = d.gain ? d.gain[d.k0 + 8 * c + j] : 1.0f;
#pragma unroll
        for (int j = 0; j < 4; ++j) { const int n = (lane >> 3) + 8 * j; const LAS float* s = scr + (8 * c) * 32 + ((((n >> 2) ^ c) << 2) + (n & 3));
            v4u o; o.x = pk2(s[0 * 32] * g[0], s[1 * 32] * g[1]); o.y = pk2(s[2 * 32] * g[2], s[3 * 32] * g[3]); o.z = pk2(s[4 * 32] * g[4], s[5 * 32] * g[5]); o.w = pk2(s[6 * 32] * g[6], s[7 * 32] * g[7]);
            *(GAS v4u*)(d.WT + ((size_t)(d.drow0 + n) * d.K + d.k0 + 8 * c) * 2) = o; }
    }
    LDS_WAIT(); asm volatile("" ::: "memory");
}
__device__ __forceinline__ void row_to_bf16(const float* xrow, bf16* orow, float* ss, int lane) {
    const GAS f32x4* xr = (const GAS f32x4*)xrow + lane; float s = 0.f;
    GAS v2u* o8 = (GAS v2u*)orow + lane;
#pragma unroll
    for (int j = 0; j < 8; ++j) { const f32x4 v = xr[64 * j]; s += (v.x * v.x + v.y * v.y) + (v.z * v.z + v.w * v.w); v2u w; w.x = pk2(v.x, v.y); w.y = pk2(v.z, v.w); o8[64 * j] = w; }
    s = wave_sum(s); if (lane == 0) *ss = s;
}
constexpr int P0_I_IN = 32 * 160, P0_I_OUT = 32 * 64, P0_I_CQ = 32 * 16, P0_I_CKV = 32 * 32, P0_I_CO = 8 * 64, P0_I_G = 8 * 2 * 4, P0_I_GU = 32 * 16 * 128, P0_I_DN = 32 * 16 * 64;
constexpr int P0_NONMOE = P0_I_IN + P0_I_OUT + P0_I_CQ + P0_I_CKV + P0_I_CO + 2 * P0_I_G, P0_NITEMS = P0_NONMOE + P0_I_GU + P0_I_DN;
__device__ __forceinline__ void p0_rows(const P& p, int gw, int NGW, int lane) {
    unsigned char* ws = p.ws;
    for (int m = gw; m < NTOK; m += NGW) row_to_bf16(p.x + (size_t)m * DM, (bf16*)(ws + WS_XB) + (size_t)m * DM, (float*)(ws + WS_SS0) + m, lane);
    for (int m = gw; m < NMEM; m += NGW) row_to_bf16(p.mem + (size_t)m * DM, (bf16*)(ws + WS_MEMB) + (size_t)m * DM, (float*)(ws + WS_SSM) + m, lane);
    for (int i = gw * 64 + lane; i < NE * DM; i += NGW * 64) { const int e = i >> 11, k = i & 2047; ((float*)(ws + WS_W_R))[i] = p.g_ffn[k] * p.w_r[k * NE + e]; }
}
__device__ __forceinline__ void p0_items(const P& p, LAS unsigned char* lds, int first, int last, int gw, int NGW, int wave, int lane) {
    LAS float* scr = (LAS float*)(lds + wave * 16384);
    unsigned char* ws = p.ws;
    constexpr int I_IN = P0_I_IN, I_OUT = P0_I_OUT, I_CQ = P0_I_CQ, I_CKV = P0_I_CKV, I_CO = P0_I_CO, I_G = P0_I_G, I_GU = P0_I_GU;
#define P0_DESC(d, it) do { int r = (it); \
        if (r < I_IN)  { const int kb = r / 160, nb = r % 160; d = TrItem{p.w_in, p.g_mix, ws + WS_W_IN, 5120, DM, kb * 64, nb * 32, nb * 32, 0}; break; } r -= I_IN; \
        if (r < I_OUT) { const int kb = r / 64, nb = r % 64; d = TrItem{p.w_out, kb < 16 ? p.g_att : p.g_lru - 1024, ws + WS_W_OUT, DM, DM, kb * 64, nb * 32, nb * 32, 0}; break; } r -= I_OUT; \
        if (r < I_CQ)  { const int kb = r / 16, nb = r % 16; d = TrItem{p.w_cq, p.g_cross, ws + WS_W_CQ, XW, DM, kb * 64, nb * 32, nb * 32, 0}; break; } r -= I_CQ; \
        if (r < I_CKV) { const int kb = r / 32, nb = r % 32; d = TrItem{p.w_ckv, p.g_mem, ws + WS_W_CKV, 2 * XW, DM, kb * 64, nb * 32, nb * 32, 0}; break; } r -= I_CKV; \
        if (r < I_CO)  { const int kb = r / 64, nb = r % 64; d = TrItem{p.w_co, nullptr, ws + WS_W_CO, DM, XW, kb * 64, nb * 32, nb * 32, 0}; break; } r -= I_CO; \
        if (r < I_G)   { const int n = r >> 3, kb = (r >> 2) & 1, nb = r & 3; d = TrItem{p.w_ga + n * 16384, nullptr, ws + WS_W_GA + n * 32768, LBW, LBW, kb * 64, nb * 32, nb * 32, 0}; break; } r -= I_G; \
        if (r < I_G)   { const int n = r >> 3, kb = (r >> 2) & 1, nb = r & 3; d = TrItem{p.w_gx + n * 16384, nullptr, ws + WS_W_GX + n * 32768, LBW, LBW, kb * 64, nb * 32, nb * 32, 0}; break; } r -= I_G; \
        if (r < I_GU)  { const int e = r >> 11, q = r & 2047, kb = q >> 7, nb = q & 127, n0 = nb * 32; const int c = n0 & 2047, up = n0 >> 11; \
                         d = TrItem{p.w_gu + (size_t)e * DM * 4096, p.g_ffn, ws + WS_W_GU + (size_t)e * 4096 * DM, 4096, DM, kb * 128, n0, 256 * (c >> 7) + (c & 127) + 128 * up, 1}; break; } r -= I_GU; \
        { const int e = r >> 10, q = r & 1023, kb = q >> 6, nb = q & 63; d = TrItem{p.w_dn + (size_t)e * DFF * DM, nullptr, ws + WS_W_DN + (size_t)e * DM * DFF, DM, DFF, kb * 128, nb * 32, nb * 32, 1}; } } while (0)
    const int it0 = first + gw, st = NGW;
    if (it0 < last) {
        TrItem d0, d1, d2; f32x4 v0[16], v1[16], v2[16];
        P0_DESC(d0, it0); tr_load(d0, v0, lane); d1 = d0; d2 = d0;
        if (it0 + st < last) { P0_DESC(d1, it0 + st); tr_load(d1, v1, lane); }
        for (int it = it0; it < last; it += 3 * st) {
            if (it + 2 * st < last) { P0_DESC(d2, it + 2 * st); tr_load(d2, v2, lane); }
            tr_finish(d0, v0, scr, lane);
            if (it + st >= last) break;
            if (it + 3 * st < last) { P0_DESC(d0, it + 3 * st); tr_load(d0, v0, lane); }
            tr_finish(d1, v1, scr, lane);
            if (it + 2 * st >= last) break;
            if (it + 4 * st < last) { P0_DESC(d1, it + 4 * st); tr_load(d1, v1, lane); }
            tr_finish(d2, v2, scr, lane);
        }
    }
#undef P0_DESC
}
__device__ __forceinline__ void p3_scales(const P& p, int gtid, int NT) {
    const float* ssa = (const float*)(p.ws + WS_SSA); const float* ssl = (const float*)(p.ws + WS_SSL); float* scl = (float*)(p.ws + WS_SCL);
    for (int m = gtid; m < NTOK; m += NT) { float a = 0.f, l = 0.f;
#pragma unroll
        for (int i = 0; i < 16; ++i) { a += ssa[(size_t)m * 16 + i]; l += ssl[(size_t)m * 16 + i]; }
        const float ra = rsqrtf(a * (1.0f / AW) + EPS), rl = rsqrtf(l * (1.0f / LW) + EPS);
        scl[2 * m] = ra / rl; scl[2 * m + 1] = rl; }
}
__device__ __forceinline__ void p8_router(const P& p, LAS unsigned char* lds, int bx, int G, int tid, int lane, int wave) {
    const float* wrt = (const float*)(p.ws + WS_W_R); const bf16* x2 = (const bf16*)(p.ws + WS_X2H);
    int* cnt = (int*)(p.ws + WS_CTL) + CW_CNT; int* list = (int*)(p.ws + WS_LIST);
    int* tope = (int*)(p.ws + WS_TOPE); float* topg = (float*)(p.ws + WS_TOPG); int* tpos = (int*)(p.ws + WS_TPOS); float* r2 = (float*)(p.ws + WS_R2);
    LAS int* lcnt = (LAS int*)lds; LAS int* lbase = lcnt + 32;
    const int r32 = lane & 31, hh = lane >> 5;
    for (int tb = bx; tb < NTOK / 128; tb += G) {
        if (tid < 64) lcnt[tid] = 0;
        __syncthreads();
        const int t = tb * 128 + (wave & 3) * 32 + r32;
        float tv[4]; int te[4], posl[4]; float rr = 0.f, g0 = 0.f, g1 = 0.f, g2 = 0.f, g3 = 0.f;
        f32x16 acc = {}; float ss = 0.f;
        {
            const GAS v4u* xp = (const GAS v4u*)(x2 + (size_t)t * DM + 16 * hh);
            const GAS f32x4* wp = (const GAS f32x4*)(wrt + (size_t)r32 * DM + 16 * hh);
            f32x4 xa[4], wa[4], xb[4], wb[4]; const int m0 = (wave >> 2) * 32;
#define RT_LOAD(X, W, m) do { const v4u w0_ = xp[4 * (m)], w1_ = xp[4 * (m) + 1]; \
        X[0] = (f32x4){__uint_as_float(w0_.x << 16), __uint_as_float(w0_.x & 0xffff0000u), __uint_as_float(w0_.y << 16), __uint_as_float(w0_.y & 0xffff0000u)}; \
        X[1] = (f32x4){__uint_as_float(w0_.z << 16), __uint_as_float(w0_.z & 0xffff0000u), __uint_as_float(w0_.w << 16), __uint_as_float(w0_.w & 0xffff0000u)}; \
        X[2] = (f32x4){__uint_as_float(w1_.x << 16), __uint_as_float(w1_.x & 0xffff0000u), __uint_as_float(w1_.y << 16), __uint_as_float(w1_.y & 0xffff0000u)}; \
        X[3] = (f32x4){__uint_as_float(w1_.z << 16), __uint_as_float(w1_.z & 0xffff0000u), __uint_as_float(w1_.w << 16), __uint_as_float(w1_.w & 0xffff0000u)}; \
        _Pragma("unroll") for (int q = 0; q < 4; ++q) W[q] = wp[8 * (m) + q]; } while (0)
#define RT_MMA(X, W) do { _Pragma("unroll") for (int q = 0; q < 4; ++q) _Pragma("unroll") for (int jj = 0; jj < 4; ++jj) { acc = __builtin_amdgcn_mfma_f32_32x32x2f32(W[q][jj], X[q][jj], acc, 0, 0, 0); ss += X[q][jj] * X[q][jj]; } } while (0)
            RT_LOAD(xa, wa, m0);
#pragma unroll 1
            for (int m = m0; m < m0 + 32; m += 2) {
                RT_LOAD(xb, wb, m + 1);
                RT_MMA(xa, wa);
                if (m + 2 < m0 + 32) RT_LOAD(xa, wa, m + 2);
                RT_MMA(xb, wb);
            }
#undef RT_LOAD
#undef RT_MMA
        }
        LAS float* part = (LAS float*)(lds + 1024);
        if (wave >= 4) {
#pragma unroll
            for (int r = 0; r < 16; ++r) part[((wave & 3) * 17 + r) * 64 + lane] = acc[r];
            part[((wave & 3) * 17 + 16) * 64 + lane] = ss; }
        __syncthreads();
        if (wave < 4) {
#pragma unroll
            for (int r = 0; r < 16; ++r) acc[r] += part[(wave * 17 + r) * 64 + lane];
            ss += part[(wave * 17 + 16) * 64 + lane];
            ss += __shfl_xor(ss, 32); rr = rsqrtf(ss * (1.0f / DM) + EPS);
            float l[16];
#pragma unroll
            for (int r = 0; r < 16; ++r) l[r] = acc[r] * rr + p.b_r[(r & 3) + 8 * (r >> 2) + 4 * hh];
#pragma unroll
            for (int k = 0; k < TOPK; ++k) { float bv = l[0]; int bi = 0;
#pragma unroll
                for (int r = 1; r < 16; ++r) if (l[r] > bv) { bv = l[r]; bi = r; }
                const int be = (bi & 3) + 8 * (bi >> 2) + 4 * hh; const float pv = __shfl_xor(bv, 32); const int pe = __shfl_xor(be, 32);
                const bool win = (bv > pv) || (bv == pv && be < pe);
                tv[k] = win ? bv : pv; te[k] = win ? be : pe;
#pragma unroll
                for (int r = 0; r < 16; ++r) l[r] = (win && r == bi) ? -INFINITY : l[r]; }
            const float e1 = __expf(tv[1] - tv[0]), e2 = __expf(tv[2] - tv[0]), e3 = __expf(tv[3] - tv[0]); const float inv = 1.0f / (1.0f + e1 + e2 + e3);
            g0 = inv; g1 = e1 * inv; g2 = e2 * inv; g3 = e3 * inv;
            if (hh == 0) {
#pragma unroll
                for (int k = 0; k < TOPK; ++k) posl[k] = __hip_atomic_fetch_add(&lcnt[te[k]], 1, __ATOMIC_RELAXED, __HIP_MEMORY_SCOPE_WORKGROUP); }
        }
        __syncthreads();
        if (tid < NE) lbase[tid] = atomicAdd(&cnt[tid], lcnt[tid]);
        __syncthreads();
        if (wave < 4 && hh == 0) {
#pragma unroll
            for (int k = 0; k < TOPK; ++k) { const int e = te[k], pos = lbase[e] + posl[k]; *(v2u*)(list + 2 * ((size_t)e * NTOK + pos)) = (v2u){(unsigned)t, __float_as_uint(rr)}; tope[t * 4 + k] = e; tpos[t * 4 + k] = pos; }
            *(f32x4*)(topg + (size_t)t * 4) = (f32x4){g0, g1, g2, g3}; r2[t] = rr;
        }
        __syncthreads();
    }
}
__device__ __forceinline__ void p11_combine(const P& p, int gw, int NGW, int lane, float oscale) {
    const int* cnt = (const int*)(p.ws + WS_CTL) + CW_CNT; const unsigned char* Y = (const unsigned char*)(p.ws + WS_Y);
    const int* tope = (const int*)(p.ws + WS_TOPE); const float* topg = (const float*)(p.ws + WS_TOPG); const int* tpos = (const int*)(p.ws + WS_TPOS);
    int pad = lane < NE ? ((cnt[lane & 31] + 255) >> 8) : 0; int inc = pad;
#pragma unroll
    for (int o = 1; o < 32; o <<= 1) { const int t = __shfl_up(inc, o); if ((lane & 31) >= o) inc += t; }
    const int toff_l = inc - pad;
    for (int m = gw; m < NTOK; m += NGW) {
        GAS f32x4* xr = (GAS f32x4*)(p.out + (size_t)m * DM) + lane;
        const GAS v2u* x2r = (const GAS v2u*)((const bf16*)(p.ws + WS_X2H) + (size_t)m * DM) + lane;
        f32x4 a[8];
#pragma unroll
        for (int j = 0; j < 8; ++j) { const v2u w = x2r[64 * j]; a[j] = (f32x4){__uint_as_float(w.x << 16), __uint_as_float(w.x & 0xffff0000u), __uint_as_float(w.y << 16), __uint_as_float(w.y & 0xffff0000u)}; }
#pragma unroll
        for (int k = 0; k < TOPK; ++k) { const int e = tope[m * 4 + k]; const float g = topg[m * 4 + k]; const int slot = 256 * __shfl(toff_l, e) + tpos[m * 4 + k];
            const GAS unsigned* yr = (const GAS unsigned*)(Y + (size_t)slot * DM) + lane;
#pragma unroll
            for (int j = 0; j < 8; ++j) { const int w = (int)yr[64 * j]; const f32x2 lo = __builtin_amdgcn_cvt_pk_f32_fp8(w, false), hi = __builtin_amdgcn_cvt_pk_f32_fp8(w, true);
                a[j].x += g * lo.x; a[j].y += g * lo.y; a[j].z += g * hi.x; a[j].w += g * hi.y; } }
        float ss = 0.f;
#pragma unroll
        for (int j = 0; j < 8; ++j) ss += (a[j].x * a[j].x + a[j].y * a[j].y) + (a[j].z * a[j].z + a[j].w * a[j].w);
        ss = wave_sum(ss); const float r = rsqrtf(ss * (1.0f / DM) + EPS) * oscale;
        const GAS f32x4* gf = (const GAS f32x4*)p.g_fin + lane;
#pragma unroll
        for (int j = 0; j < 8; ++j) { const f32x4 g = gf[64 * j]; xr[64 * j] = a[j] * r * g; }
    }
}

#ifndef FAST_MASK
#define FAST_MASK 0xFFFu
#endif
#ifndef STAG1
#define STAG1 0
#define STAG9 0
#define STAG10 0
#define STAG4 0
#define STAG7 0
#endif
#ifndef PROBE_PH
#define PROBE_PH (-1)
#define PROBE_US 2000.0f
#define PROBE_OFF 0.0f
#define PROBE_MB 0
#define PROBE_STEPS 4.0f
#define PROBE_CLK 0
#endif
#ifndef NHELP
#define NHELP 40
#define P0_SPLIT (P0_NONMOE + 62000)
#endif
#ifndef DUP_MASK
#define DUP_MASK 0u
#endif
#ifndef SUB2_MASK
#define SUB2_MASK 0x7u
#endif
__global__ void __launch_bounds__(NWAVES * 64, 2) fwd(P p) {
    extern __shared__ __attribute__((aligned(16))) unsigned char lds_raw[];
    LAS unsigned char* lds = (LAS unsigned char*)lds_raw;
    volatile LAS unsigned* MISC = (volatile LAS unsigned*)(lds + MISC_OFF);
    const int tid = threadIdx.x, lane = tid & 63, wave = __builtin_amdgcn_readfirstlane(tid >> 6);
    const int G = gridDim.x, bx = blockIdx.x; const int vcu = (G % 8 == 0) ? (bx % 8) * (G / 8) + bx / 8 : bx;
    const int gw = vcu * NWAVES + wave, NGW = G * NWAVES;
    for (int u = tid; u < (LDS_BYTES - LDSCTL_OFF) / 4; u += NWAVES * 64) ((LAS unsigned*)(lds + LDSCTL_OFF))[u] = 0u;
    __syncthreads();
    unsigned* ctl = (unsigned*)(p.ws + WS_CTL);
    const int lo = p.ph_lo, hi = p.ph_hi;
    XcdBarrier bar; bar.bar = ctl + CW_BAR + p.li * XCD_BAR_WORDS; bar.x = 0; bar.st = nullptr;
    if (hi - lo > 1) bar = xcd_barrier_post(ctl + CW_BAR + p.li * XCD_BAR_WORDS, MISC + 8);
#define IN(k) (lo <= (k) && (k) < hi)
#define SEAM(k) do { if (PROBE_CLK && PROBE_PH >= 0 && bx == 0 && tid == 0) { const unsigned long long c_ = __builtin_amdgcn_s_memtime(), t_ = __builtin_amdgcn_s_memrealtime();   \
            if ((k) == PROBE_PH) { const unsigned long long c0_ = ((unsigned long long)CLK[1] << 32) | CLK[0], t0_ = ((unsigned long long)MISC[17 + 2 * (k)] << 32) | MISC[16 + 2 * (k)]; \
                __hip_atomic_store(ctl + 32, (unsigned)(1000.0f * (float)(c_ - c0_) / (float)(t_ - t0_)), __ATOMIC_RELAXED, __HIP_MEMORY_SCOPE_AGENT); } } \
        if (IN(k) && IN((k) + 1)) xcd_barrier(bar); if (PROBE_PH >= 0 && bx == 0 && tid == 0) { const unsigned long long t_ = __builtin_amdgcn_s_memrealtime(), c_ = __builtin_amdgcn_s_memtime(); MISC[16 + 2 * ((k) + 1)] = (unsigned)t_; MISC[17 + 2 * ((k) + 1)] = (unsigned)(t_ >> 32); CLK[0] = (unsigned)c_; CLK[1] = (unsigned)(c_ >> 32); \
        if (!PROBE_CLK && (k) == PROBE_PH) { const unsigned long long t0_ = ((unsigned long long)MISC[17 + 2 * (k)] << 32) | MISC[16 + 2 * (k)]; __hip_atomic_store(ctl + 32, (unsigned)(t_ - t0_), __ATOMIC_RELAXED, __HIP_MEMORY_SCOPE_AGENT); } } } while (0)
    unsigned char* ws = p.ws;
    LAS int* l_toff = (LAS int*)(lds + LDSCTL_OFF + 512); LAS int* l_cnt = (LAS int*)(lds + LDSCTL_OFF + 768);
    LAS int* l_utab9 = (LAS int*)(lds + LDSCTL_OFF + 1280); LAS int* l_utab10 = (LAS int*)(lds + LDSCTL_OFF + 1536);
    LAS float* l_slots = (LAS float*)(lds + LDSCTL_OFF + 2048);
#define RUN(k, BODY) do { if (IN(k)) { BODY; if ((DUP_MASK >> (k)) & 1u) { xcd_barrier(bar); BODY; } } } while (0)
    const int GP1 = (G == 256) ? G - NHELP : G, p0_last = (G == 256) ? P0_SPLIT : P0_NITEMS;
#define PH0 do { p0_rows(p, gw, NGW, lane); p0_items(p, lds, 0, p0_last, gw, NGW, wave, lane); } while (0)
#define PH1 do {   \
        if (bx < GP1) { pg8::SchedP1 S{(const char*)(ws + WS_XB), (const char*)(ws + WS_W_IN), GP1, bx}; \
          pg8::EpiP1 E{pg8::EpiRowScale{(const float*)(ws + WS_SS0), (bf16*)(ws + WS_QKXY), 1024, 1024, (size_t)NTOK * 1024, QSCALE, l_slots}, pg8::EpiColScale{(const float*)(ws + WS_SS0), (bf16*)(ws + WS_VT), (size_t)NTOK, l_slots}}; \
          pg8::gemm_phase(lds, 2 * DM, S, E, STAG1); } \
        else p0_items(p, lds, p0_last, P0_NITEMS, (bx - GP1) * NWAVES + wave, (G - GP1) * NWAVES, wave, lane); } while (0)
#define PH2 do { \
        if (SUB2_MASK & 1u) {     \
            { pg8::SchedReg S{(const char*)(ws + WS_MEMB), (const char*)(ws + WS_W_CKV), NMEM / 256, 2, G, bx, 4096, 1 << 30, 0}; \
              pg8::EpiRowScale E{(const float*)(ws + WS_SSM), (bf16*)(ws + WS_CK), XW, 0, 0, 1.0f, l_slots}; \
              pg8::gemm_phase(lds, 2 * DM, S, E); } \
            { pg8::SchedReg S{(const char*)(ws + WS_W_CKV) + (size_t)512 * 4096, (const char*)(ws + WS_MEMB), 2, NMEM / 256, G, (bx + 32) % G, 4096, 1 << 30, 0}; \
              pg8::EpiColScale E{(const float*)(ws + WS_SSM), (bf16*)(ws + WS_CVT), (size_t)NMEM, l_slots}; \
              pg8::gemm_phase(lds, 2 * DM, S, E); } \
        } \
        const bf16* QKXY = (const bf16*)(ws + WS_QKXY); \
        if (SUB2_MASK & 4u) { \
            for (int U = vcu; U < BATCH * 16; U += G) \
                lru::unit(lds, QKXY + (size_t)2 * NTOK * 1024, QKXY + (size_t)3 * NTOK * 1024, p.conv_w, p.conv_b, (const bf16*)(ws + WS_W_GA), (const bf16*)(ws + WS_W_GX), p.b_ga, p.b_gx, p.lam, (bf16*)(ws + WS_MIX), (float*)(ws + WS_SSL), U >> 4, U & 15); \
        } \
        if (SUB2_MASK & 2u) {     \
            if (G == 256) { const bool ckvb = (bx < 32) || (bx >= 224); const int idx = ckvb ? (bx < 32 ? bx : bx - 192) : bx - 32, nu = ckvb ? 6 : (idx < 128 ? 9 : 8), u0 = ckvb ? idx * 6 : 384 + (idx < 128 ? idx * 9 : 1152 + (idx - 128) * 8); \
                for (int q = 0; q < nu; ++q) { const int U = u0 + q; \
                    battn::unit(lds, QKXY, QKXY + (size_t)NTOK * 1024, (const bf16*)(ws + WS_VT), p.rel, (bf16*)(ws + WS_MIX), (float*)(ws + WS_SSA), U >> 7, (U >> 3) & 15, U & 7); } } \
            else for (int U = vcu; U < BATCH * AH * 8; U += G) \
                battn::unit(lds, QKXY, QKXY + (size_t)NTOK * 1024, (const bf16*)(ws + WS_VT), p.rel, (bf16*)(ws + WS_MIX), (float*)(ws + WS_SSA), U >> 7, (U >> 3) & 15, U & 7); \
        } } while (0)
#define PH3 p3_scales(p, gw * 64 + lane, NGW * 64)
#define PH4 do { \
        pg8::SchedReg S{(const char*)(ws + WS_MIX), (const char*)(ws + WS_W_OUT), NTOK / 256, 8, G, bx, 4096, 1 << 30, 0}; \
        pg8::EpiX1 E{(const float*)(ws + WS_SCL), (const bf16*)(ws + WS_XB), p.out, (bf16*)(ws + WS_X1B), (float*)(ws + WS_SS1P), l_slots}; \
        pg8::gemm_phase(lds, 2 * DM, S, E, STAG4); } while (0)
#define PH5 do { \
        pg8::SchedReg S{(const char*)(ws + WS_X1B), (const char*)(ws + WS_W_CQ), NTOK / 256, 2, G, bx, 4096, 1 << 30, 0}; \
        pg8::EpiCQ E{(const float*)(ws + WS_SS1P), (bf16*)(ws + WS_CQ), l_slots}; \
        pg8::gemm_phase(lds, 2 * DM, S, E); } while (0)
#define PH6 do { int prev = -1;     \
        if (G == 256) { for (int i = 0; i < 2; ++i) { const int bh = vcu >> 2; \
            xattn::unit(lds, (const bf16*)(ws + WS_CQ), (const bf16*)(ws + WS_CK), (const bf16*)(ws + WS_CVT), (bf16*)(ws + WS_OX), bh >> 2, bh & 3, (vcu & 3) * 2 + i, i == 0); } } \
        else for (int U = vcu; U < BATCH * XH * 8; U += G) { const int bh = U >> 3; \
            xattn::unit(lds, (const bf16*)(ws + WS_CQ), (const bf16*)(ws + WS_CK), (const bf16*)(ws + WS_CVT), (bf16*)(ws + WS_OX), bh >> 2, bh & 3, U & 7, bh != prev); prev = bh; } } while (0)
#define PH7 do { \
        pg8::SchedReg S{(const char*)(ws + WS_OX), (const char*)(ws + WS_W_CO), NTOK / 256, 8, G, bx, 1024, 1 << 30, 0}; \
        pg8::EpiX2 E{(const bf16*)(ws + WS_X1B), (bf16*)(ws + WS_X2H), (unsigned char*)(ws + WS_X2B)}; \
        pg8::gemm_phase(lds, 2 * XW, S, E, STAG7); } while (0)
#define PH8 p8_router(p, lds, vcu, G, tid, lane, wave)
#define PH9 do { \
        pg8::SchedMoE<true> S{l_utab9, l_cnt, (const int*)(ws + WS_LIST), (const char*)(ws + WS_X2B), (const char*)(ws + WS_W_GU), 4096}; \
        pg8::EpiAct E{l_cnt, (const int*)(ws + WS_LIST), (const float*)(ws + WS_R2), p.b_gu, (unsigned char*)(ws + WS_ACT), l_slots}; \
        pg8::gemm_phase(lds, DM, S, E, STAG9); } while (0)
#define PH10 do { \
        pg8::SchedMoE<false> S{l_utab10, l_cnt, nullptr, (const char*)(ws + WS_ACT), (const char*)(ws + WS_W_DN), 2048}; \
        pg8::EpiY E{p.b_dn, (unsigned char*)(ws + WS_Y), l_slots}; \
        pg8::gemm_phase(lds, DFF, S, E, STAG10); } while (0)
#define PH11 p11_combine(p, gw, NGW, lane, PROBE_PH >= 0 ? 1.0f + sqrtf(exp2f((floorf(log2f((float)__hip_atomic_load(ctl + 32, __ATOMIC_RELAXED, __HIP_MEMORY_SCOPE_AGENT) * 0.01f) * PROBE_STEPS + PROBE_OFF) + 0.5f - PROBE_OFF) * (1.0f / PROBE_STEPS)) * (1.0f / PROBE_US)) : 1.0f)
    volatile LAS unsigned* CLK = (volatile LAS unsigned*)(lds + LDSCTL_OFF + 1024);
    if (PROBE_PH >= 0 && bx == 0 && tid == 0) { const unsigned long long t_ = __builtin_amdgcn_s_memrealtime(), c_ = __builtin_amdgcn_s_memtime(); MISC[16 + 2 * lo] = (unsigned)t_; MISC[17 + 2 * lo] = (unsigned)(t_ >> 32); CLK[0] = (unsigned)c_; CLK[1] = (unsigned)(c_ >> 32); }
    RUN(0, PH0); SEAM(0);
    RUN(1, PH1); SEAM(1);
    RUN(2, PH2); SEAM(2);
    RUN(3, PH3);
    if (PROBE_MB && IN(3)) {
        pg8::v8i a8, b8; bf16x8 a4, b4; f32x4 ac[8];
        for (int i = 0; i < 8; ++i) { a8[i] = 0x38383838 + lane; b8[i] = 0x3c3c3c3c ^ (lane << 3); }
        for (int i = 0; i < 8; ++i) { a4[i] = (short)(0x3f80 + lane); b4[i] = (short)(0x3f00 + 3 * lane); ac[i] = (f32x4){0.f, 0.f, 0.f, 0.f}; }
        asm volatile("" : "+v"(a8), "+v"(b8), "+v"(a4), "+v"(b4));
        __syncthreads();
        const unsigned long long c0 = __builtin_amdgcn_s_memtime();
#pragma unroll 1
        for (int it = 0; it < 2048; ++it) {
#pragma unroll
            for (int i = 0; i < 8; ++i) { if (PROBE_MB == 1) ac[i] = __builtin_amdgcn_mfma_f32_16x16x32_bf16(a4, b4, ac[i], 0, 0, 0);
                else ac[i] = __builtin_amdgcn_mfma_scale_f32_16x16x128_f8f6f4(a8, b8, ac[i], 0, 0, 0, 0x7C7C7C7C, 0, 0x7C7C7C7C); } }
        const unsigned long long c1 = __builtin_amdgcn_s_memtime();
#pragma unroll
        for (int i = 0; i < 8; ++i) asm volatile("" :: "v"(ac[i]));
        if (bx == 0 && tid == 0) __hip_atomic_store(ctl + 32, (unsigned)((c1 - c0) * 100ull / (2048ull * 8ull)) * 100u, __ATOMIC_RELAXED, __HIP_MEMORY_SCOPE_AGENT);
    }
    SEAM(3);
    RUN(4, PH4); SEAM(4);
    RUN(5, PH5); SEAM(5);
    RUN(6, PH6); SEAM(6);
    if (IN(7)) { PH7; } SEAM(7);
    if (IN(8)) { PH8; } SEAM(8);
    if (IN(9) || IN(10)) {
        if (tid < NE) l_cnt[tid] = ((const int*)ctl)[CW_CNT + tid];
        __syncthreads();
        if (tid == 0) { int a = 0; for (int e = 0; e < NE; ++e) { l_toff[e] = a; a += (l_cnt[e] + 255) >> 8; } l_toff[NE] = a; }
        __syncthreads();
        pg8::moe_unit_table(l_toff, l_utab9, 16, G, bx, tid); pg8::moe_unit_table(l_toff, l_utab10, 8, G, bx, tid);
        __syncthreads();
    }
    RUN(9, PH9); SEAM(9);
    RUN(10, PH10); SEAM(10);
    if (IN(11)) { PH11; }
#undef IN
#undef SEAM
}

extern "C" void kernel_launch(void* const* d_in, const int* in_sizes, int n_in, void* d_out, int out_size, void* d_ws, size_t ws_size, hipStream_t stream) {
    static int grid = 0;
    if (grid == 0) {
        if (n_in != 28 || in_sizes[0] != NTOK * DM || out_size != NTOK * DM || ws_size < WS_END) { fprintf(stderr, "kernel_launch: unexpected shapes (n_in %d, ws %zu)\n", n_in, ws_size); grid = -1; return; }
        int dev = 0, cus = 0;
        if (hipGetDevice(&dev) != hipSuccess || hipDeviceGetAttribute(&cus, hipDeviceAttributeMultiprocessorCount, dev) != hipSuccess) { grid = -1; return; }
        if (hipFuncSetAttribute((const void*)fwd, hipFuncAttributeMaxDynamicSharedMemorySize, LDS_BYTES) != hipSuccess) { fprintf(stderr, "kernel_launch: hipFuncSetAttribute failed\n"); grid = -1; return; }
        int per_cu = 0; (void)hipOccupancyMaxActiveBlocksPerMultiprocessor(&per_cu, (const void*)fwd, NWAVES * 64, LDS_BYTES); (void)hipGetLastError();
        grid = cus;
    }
    if (grid < 0) return;
    (void)hipMemsetAsync((char*)d_ws + WS_CTL, 0, (FAST_MASK == 0xFFFu) ? (size_t)32768 : CTL_ZERO_BYTES, stream);
    P p{};
    const float** pp = (const float**)&p;
    for (int i = 0; i < 28; ++i) pp[i] = (const float*)d_in[i];
    p.out = (float*)d_out; p.ws = (unsigned char*)d_ws;
    unsigned char* ws = (unsigned char*)d_ws;
    bf16* QKXY = (bf16*)(ws + WS_QKXY); int* ctl = (int*)(ws + WS_CTL);
    int li = 0;
    auto isfast = [](int ph) { return ph == 2 ? (SUB2_MASK != 0u) : (((FAST_MASK >> ph) & 1u) != 0u); };
    for (int ph = 0; ph < NPHASE;) {
        if (ph == 2) {
            if (!(SUB2_MASK & 1u)) { F1b f{}; f.A = (bf16*)(ws + WS_MEMB); f.Bt = (bf16*)(ws + WS_W_CKV); f.ssm = (float*)(ws + WS_SSM); f.ck = (bf16*)(ws + WS_CK); f.cvt = (bf16*)(ws + WS_CVT);
                  hipLaunchKernelGGL(ngemm<F1b>, dim3(1024 / 64, NMEM / 64), dim3(256), 0, stream, f); }
            if (!(SUB2_MASK & 2u)) hipLaunchKernelGGL(n_attn, dim3(BATCH * AH * 8), dim3(256), 0, stream, QKXY, (const bf16*)(ws + WS_VT), p.rel, (bf16*)(ws + WS_MIX), (float*)(ws + WS_SSA));
            if (!(SUB2_MASK & 4u)) {
                  hipLaunchKernelGGL(n_lru_a, dim3(NTOK * 4), dim3(256), 0, stream, QKXY + (size_t)2 * NTOK * 1024, p.conv_w, p.conv_b, (const bf16*)(ws + WS_W_GA), p.b_ga, (const bf16*)(ws + WS_W_GX), p.b_gx, p.lam, (float*)(ws + WS_NA), (float*)(ws + WS_NB));
                  hipLaunchKernelGGL(n_lru_b, dim3(256), dim3(64), 0, stream, (const float*)(ws + WS_NA), (const float*)(ws + WS_NB), QKXY + (size_t)3 * NTOK * 1024, (bf16*)(ws + WS_MIX), (float*)(ws + WS_SSL)); }
        }
        if (isfast(ph)) { int hi = ph + 1; while (hi < NPHASE && isfast(hi) && !(hi == 2 && SUB2_MASK != 7u)) ++hi;
            p.ph_lo = ph; p.ph_hi = hi; p.li = li++; hipLaunchKernelGGL(fwd, dim3(grid), dim3(NWAVES * 64), LDS_BYTES, stream, p); ph = hi; continue; }
        switch (ph) {
        case 1: { F1 f{}; f.A = (bf16*)(ws + WS_XB); f.Bt = (bf16*)(ws + WS_W_IN); f.ss0 = (float*)(ws + WS_SS0); f.qkxy = QKXY; f.vt = (bf16*)(ws + WS_VT);
                  hipLaunchKernelGGL(ngemm<F1>, dim3(5120 / 64, NTOK / 64), dim3(256), 0, stream, f); } break;
        case 4: { F4 f{}; f.A = (bf16*)(ws + WS_MIX); f.Bt = (bf16*)(ws + WS_W_OUT); f.scl = (float*)(ws + WS_SCL); f.x = p.x; f.x1 = p.out; f.x1b = (bf16*)(ws + WS_X1B); f.ss1p = (float*)(ws + WS_SS1P);
                  hipLaunchKernelGGL(ngemm<F4>, dim3(DM / 64, NTOK / 64), dim3(256), 0, stream, f); } break;
        case 5: { F5 f{}; f.A = (bf16*)(ws + WS_X1B); f.Bt = (bf16*)(ws + WS_W_CQ); f.ss1p = (float*)(ws + WS_SS1P); f.cq = (bf16*)(ws + WS_CQ);
                  hipLaunchKernelGGL(ngemm<F5>, dim3(XW / 64, NTOK / 64), dim3(256), 0, stream, f); } break;
        case 6: hipLaunchKernelGGL(n_xattn, dim3(BATCH * XH * 8 * 2), dim3(256), 0, stream, (const bf16*)(ws + WS_CQ), (const bf16*)(ws + WS_CK), (const bf16*)(ws + WS_CVT), (bf16*)(ws + WS_OX)); break;
        case 7: { F7 f{}; f.A = (bf16*)(ws + WS_OX); f.Bt = (bf16*)(ws + WS_W_CO); f.x12 = p.out; f.x2b = (unsigned char*)(ws + WS_X2B);
                  hipLaunchKernelGGL(ngemm<F7>, dim3(DM / 64, NTOK / 64), dim3(256), 0, stream, f); } break;
        case 9: { hipLaunchKernelGGL(n_toff, dim3(1), dim3(64), 0, stream, (const int*)(ctl + CW_CNT), ctl + CW_TOFF);
                  F9 f{}; f.x2b = (unsigned char*)(ws + WS_X2B); f.wgu = (unsigned char*)(ws + WS_W_GU); f.toff = ctl + CW_TOFF; f.cnt = ctl + CW_CNT; f.list = (int*)(ws + WS_LIST); f.r2 = (float*)(ws + WS_R2); f.b_gu = p.b_gu; f.act = (unsigned char*)(ws + WS_ACT);
                  hipLaunchKernelGGL(ngemm<F9>, dim3(DFF / 32, NSLOT / 64), dim3(256), 0, stream, f); } break;
        case 10: { hipLaunchKernelGGL(n_toff, dim3(1), dim3(64), 0, stream, (const int*)(ctl + CW_CNT), ctl + CW_TOFF);
                  F10 f{}; f.act = (unsigned char*)(ws + WS_ACT); f.wdn = (unsigned char*)(ws + WS_W_DN); f.toff = ctl + CW_TOFF; f.b_dn = p.b_dn; f.y = (unsigned char*)(ws + WS_Y);
                  hipLaunchKernelGGL(ngemm<F10>, dim3(DM / 64, NSLOT / 64), dim3(256), 0, stream, f); } break;
        default: break;
        }
        ++ph;
    }
}
```

```cpp
#include <hip/hip_runtime.h>
#include <cstdio>
#include <cstdint>
#include <cmath>

#define GAS __attribute__((address_space(1)))
#define LAS __attribute__((address_space(3)))
typedef unsigned short bf16;
typedef unsigned v4u __attribute__((ext_vector_type(4)));
typedef unsigned v2u __attribute__((ext_vector_type(2)));
typedef float f32x4 __attribute__((ext_vector_type(4)));
typedef float f32x2 __attribute__((ext_vector_type(2)));
typedef float f32x16 __attribute__((ext_vector_type(16)));
typedef short bf16x8 __attribute__((ext_vector_type(8)));

constexpr int BATCH = 16, SEQ = 2048, DM = 2048, NTOK = BATCH * SEQ;
constexpr int CHUNK = 64, LEFTC = 8, AW = 1024, AH = 16, AHD = 64, MAXREL = 128, RELW = 2 * MAXREL + 1;
constexpr int LW = 1024, LB = 8, LBW = 128;
constexpr int MEML = 256, NMEM = BATCH * MEML, XH = 4, XHD = 128, XW = 512;
constexpr int NE = 32, TOPK = 4, DFF = 2048;
constexpr int NSLOT = NTOK * TOPK + NE * 256;
constexpr float EPS = 1e-6f, LOG2E = 1.4426950408889634f;
constexpr float QSCALE = 0.125f * LOG2E;
constexpr float CQSCALE = 0.08838834764831845f * LOG2E;
constexpr float SW_ALPHA = 1.702f, SW_LIMIT = 7.0f;

constexpr size_t MiB = 1u << 20;
constexpr size_t WS_CTL = 0, CTL_ZERO_BYTES = 1 * MiB;
constexpr size_t WS_W_IN = 2 * MiB, WS_W_OUT = 22 * MiB, WS_W_CQ = 30 * MiB, WS_W_CKV = 32 * MiB, WS_W_CO = 36 * MiB;
constexpr size_t WS_W_GA = 38 * MiB, WS_W_GX = WS_W_GA + 256 * 1024, WS_W_R = WS_W_GX + 256 * 1024;
constexpr size_t WS_SS0 = 39 * MiB, WS_SSM = WS_SS0 + 128 * 1024, WS_R2 = WS_SS0 + 256 * 1024;
constexpr size_t WS_SSA = 40 * MiB, WS_SSL = 42 * MiB, WS_SCL = 44 * MiB, WS_SS1P = 45 * MiB;
constexpr size_t WS_TOPE = 49 * MiB, WS_TOPG = WS_TOPE + 512 * 1024, WS_TPOS = 50 * MiB;
constexpr size_t WS_LIST = 3008 * MiB  , WS_CK = 55 * MiB, WS_CVT = 59 * MiB, WS_MEMB = 64 * MiB;
constexpr size_t WS_W_GU = 128 * MiB, WS_W_DN = 640 * MiB;
constexpr size_t WS_XB = 896 * MiB, WS_MIX = 2496 * MiB;
constexpr size_t WS_QKXY = 1024 * MiB, WS_VT = 1280 * MiB, WS_X1B = 1344 * MiB, WS_CQ = 1472 * MiB, WS_OX = 1504 * MiB, WS_X2B = 1536 * MiB;
constexpr size_t WS_X2H = 2752 * MiB;
constexpr size_t WS_ACT = 1664 * MiB, WS_Y = 2208 * MiB, WS_NA = 2752 * MiB, WS_NB = 2880 * MiB, WS_END = 3016 * MiB;
constexpr int CW_CNT = 64;
constexpr int CW_TOFF = 128;
constexpr int CW_BAR = 4096;

struct P {
    const float *x, *mem, *g_mix, *w_in, *rel, *conv_w, *conv_b, *w_ga, *b_ga, *w_gx, *b_gx, *lam, *g_att, *g_lru, *w_out, *g_cross, *g_mem,
        *w_cq, *w_ckv, *w_co, *g_ffn, *w_r, *b_r, *w_gu, *b_gu, *w_dn, *b_dn, *g_fin;
    float* out; unsigned char* ws;
    int ph_lo, ph_hi, li, pad;
};

__device__ __forceinline__ float bf2f(bf16 b) { return __uint_as_float(((unsigned)b) << 16); }
__device__ __forceinline__ unsigned f2bf(float f) { unsigned u = __float_as_uint(f); return (u + 0x7fffu + ((u >> 16) & 1u)) >> 16; }
__device__ __forceinline__ unsigned pk2(float lo, float hi) { return f2bf(lo) | (f2bf(hi) << 16); }
constexpr float W8_SCALE = 64.0f, W8_INV = 1.0f / 64.0f;
__device__ __forceinline__ unsigned pk4_fp8(float a, float b, float c, float d) { int w = 0; w = __builtin_amdgcn_cvt_pk_fp8_f32(a, b, w, false); w = __builtin_amdgcn_cvt_pk_fp8_f32(c, d, w, true); return (unsigned)w; }
__device__ __forceinline__ float fp8_to_f(unsigned b) { const unsigned s = (b >> 7) & 1u, e = (b >> 3) & 15u, m = b & 7u; const float v = e ? ldexpf(1.0f + (float)m * 0.125f, (int)e - 7) : ldexpf((float)m * 0.125f, -6); return s ? -v : v; }
__device__ __forceinline__ float wave_sum(float v) {
#pragma unroll
    for (int o = 1; o < 64; o <<= 1) v += __shfl_xor(v, o);
    return v;
}
__device__ __forceinline__ float sigmoidf_(float x) { return 1.0f / (1.0f + __expf(-x)); }
__device__ __forceinline__ float gelu_tanh(float x) { const float u = 0.7978845608028654f * (x + 0.044715f * x * x * x); return 0.5f * x * (1.0f + tanhf(u)); }
__device__ __forceinline__ int find_expert(const int* toff, int tile) { int e = 0;
#pragma unroll 1
    for (int i = 1; i < NE; ++i) e += (tile >= toff[i]) ? 1 : 0;
    return e; }

template <class F>
__global__ void __launch_bounds__(256) ngemm(F f) {
    __shared__ float As[16][68], Bs[16][68];
    const int tx = threadIdx.x & 15, ty = threadIdx.x >> 4, bm = blockIdx.y, bn = blockIdx.x;
    if (!f.valid(bm)) return;
    const int lr = threadIdx.x >> 2, lk = (threadIdx.x & 3) * 4;
    const unsigned char* ap = (const unsigned char*)f.aptr(bm * 64 + lr);
    const unsigned char* bp = (const unsigned char*)f.bptr(bm, bn, lr);
    float acc[4][4];
#pragma unroll
    for (int i = 0; i < 4; ++i)
#pragma unroll
        for (int j = 0; j < 4; ++j) acc[i][j] = 0.f;
    for (int k0 = 0; k0 < F::K; k0 += 16) {
        f.mid(k0, bm, ty, acc);
        if constexpr (F::FP8) { const unsigned av = *(const unsigned*)(ap + k0 + lk), bv = *(const unsigned*)(bp + k0 + lk);
#pragma unroll
            for (int q = 0; q < 4; ++q) { As[lk + q][lr] = fp8_to_f((av >> (8 * q)) & 255u); Bs[lk + q][lr] = fp8_to_f((bv >> (8 * q)) & 255u) * W8_INV; } }
        else { const v2u av = *(const v2u*)(ap + 2 * (k0 + lk)), bv = *(const v2u*)(bp + 2 * (k0 + lk));
        As[lk + 0][lr] = __uint_as_float(av.x << 16); As[lk + 1][lr] = __uint_as_float(av.x & 0xffff0000u);
        As[lk + 2][lr] = __uint_as_float(av.y << 16); As[lk + 3][lr] = __uint_as_float(av.y & 0xffff0000u);
        Bs[lk + 0][lr] = __uint_as_float(bv.x << 16); Bs[lk + 1][lr] = __uint_as_float(bv.x & 0xffff0000u);
        Bs[lk + 2][lr] = __uint_as_float(bv.y << 16); Bs[lk + 3][lr] = __uint_as_float(bv.y & 0xffff0000u); }
        __syncthreads();
#pragma unroll
        for (int kk = 0; kk < 16; ++kk) {
            const f32x4 a = *(const f32x4*)&As[kk][ty * 4], b = *(const f32x4*)&Bs[kk][tx * 4];
#pragma unroll
            for (int i = 0; i < 4; ++i)
#pragma unroll
                for (int j = 0; j < 4; ++j) acc[i][j] += a[i] * b[j];
        }
        __syncthreads();
    }
    f.out(bm, bn, ty, tx, acc);
}
struct FBase { static constexpr bool FP8 = false;
    __device__ bool valid(int) const { return true; }
    __device__ void mid(int, int, int, float (&)[4][4]) const {}
};
struct F1 : FBase { static constexpr int K = 2048; const bf16* A; const bf16* Bt; const float* ss0; bf16* qkxy; bf16* vt;
    __device__ const bf16* aptr(int row) const { return A + (size_t)row * K; }
    __device__ const bf16* bptr(int, int bn, int j) const { return Bt + (size_t)(bn * 64 + j) * K; }
    __device__ void out(int bm, int bn, int ty, int tx, float (&acc)[4][4]) const {
        for (int i = 0; i < 4; ++i) { const int m = bm * 64 + ty * 4 + i; const float r0 = rsqrtf(ss0[m] * (1.0f / DM) + EPS);
            for (int j = 0; j < 4; ++j) { const int n = bn * 64 + tx * 4 + j, t = n >> 10, c = n & 1023; float v = acc[i][j] * r0;
                if (t == 2) vt[(size_t)c * NTOK + m] = (bf16)f2bf(v);
                else { const int slot = t < 2 ? t : t - 1; if (t == 0) v *= QSCALE; qkxy[(size_t)slot * NTOK * 1024 + (size_t)m * 1024 + c] = (bf16)f2bf(v); } } }
    }
};
struct F1b : FBase { static constexpr int K = 2048; const bf16* A; const bf16* Bt; const float* ssm; bf16* ck; bf16* cvt;
    __device__ const bf16* aptr(int row) const { return A + (size_t)row * K; }
    __device__ const bf16* bptr(int, int bn, int j) const { return Bt + (size_t)(bn * 64 + j) * K; }
    __device__ void out(int bm, int bn, int ty, int tx, float (&acc)[4][4]) const {
        for (int i = 0; i < 4; ++i) { const int m = bm * 64 + ty * 4 + i; const float r = rsqrtf(ssm[m] * (1.0f / DM) + EPS);
            for (int j = 0; j < 4; ++j) { const int n = bn * 64 + tx * 4 + j; const float v = acc[i][j] * r;
                if (n < XW) ck[(size_t)m * XW + n] = (bf16)f2bf(v); else cvt[(size_t)(n - XW) * NMEM + m] = (bf16)f2bf(v); } }
    }
};
struct F4 : FBase { static constexpr int K = 2048; const bf16* A; const bf16* Bt; const float* scl; const float* x; float* x1; bf16* x1b; float* ss1p;
    __device__ const bf16* aptr(int row) const { return A + (size_t)row * K; }
    __device__ const bf16* bptr(int, int bn, int j) const { return Bt + (size_t)(bn * 64 + j) * K; }
    __device__ void mid(int k0, int bm, int ty, float (&acc)[4][4]) const { if (k0 == 1024) { for (int i = 0; i < 4; ++i) { const float s = scl[2 * (bm * 64 + ty * 4 + i)]; for (int j = 0; j < 4; ++j) acc[i][j] *= s; } } }
    __device__ void out(int bm, int bn, int ty, int tx, float (&acc)[4][4]) const {
        for (int i = 0; i < 4; ++i) { const int m = bm * 64 + ty * 4 + i; const float s = scl[2 * m + 1]; float q = 0.f;
            for (int j = 0; j < 4; ++j) { const int n = bn * 64 + tx * 4 + j; const float v = x[(size_t)m * DM + n] + acc[i][j] * s; x1[(size_t)m * DM + n] = v; x1b[(size_t)m * DM + n] = (bf16)f2bf(v); q += v * v; }
            q += __shfl_xor(q, 1); q += __shfl_xor(q, 2); q += __shfl_xor(q, 4); q += __shfl_xor(q, 8);
            if (tx == 0) ss1p[(size_t)m * 32 + bn] = q; }
    }
};
struct F5 : FBase { static constexpr int K = 2048; const bf16* A; const bf16* Bt; const float* ss1p; bf16* cq;
    __device__ const bf16* aptr(int row) const { return A + (size_t)row * K; }
    __device__ const bf16* bptr(int, int bn, int j) const { return Bt + (size_t)(bn * 64 + j) * K; }
    __device__ void out(int bm, int bn, int ty, int tx, float (&acc)[4][4]) const {
        for (int i = 0; i < 4; ++i) { const int m = bm * 64 + ty * 4 + i; float q = 0.f; for (int p = 0; p < 32; ++p) q += ss1p[(size_t)m * 32 + p];
            const float r1 = rsqrtf(q * (1.0f / DM) + EPS) * CQSCALE;
            for (int j = 0; j < 4; ++j) { const int n = bn * 64 + tx * 4 + j; cq[(size_t)m * XW + n] = (bf16)f2bf(acc[i][j] * r1); } }
    }
};
struct F7 : FBase { static constexpr int K = 512; const bf16* A; const bf16* Bt; float* x12; unsigned char* x2b;
    __device__ const bf16* aptr(int row) const { return A + (size_t)row * K; }
    __device__ const bf16* bptr(int, int bn, int j) const { return Bt + (size_t)(bn * 64 + j) * K; }
    __device__ void out(int bm, int bn, int ty, int tx, float (&acc)[4][4]) const {
        for (int i = 0; i < 4; ++i) { const int m = bm * 64 + ty * 4 + i;
            for (int j = 0; j < 4; ++j) { const int n = bn * 64 + tx * 4 + j; const float v = x12[(size_t)m * DM + n] + acc[i][j]; x12[(size_t)m * DM + n] = v; x2b[(size_t)m * DM + n] = (unsigned char)(pk4_fp8(v, 0.f, 0.f, 0.f) & 255u); } }
    }
};
struct F9 { static constexpr int K = 2048; static constexpr bool FP8 = true; const unsigned char* x2b; const unsigned char* wgu; const int* toff; const int* cnt; const int* list; const float* r2; const float* b_gu; unsigned char* act;
    __device__ bool valid(int bm) const { return (bm >> 2) < toff[NE]; }
    __device__ void mid(int, int, int, float (&)[4][4]) const {}
    __device__ int tok_of(int slot, int& e) const { const int tile = slot >> 8; e = find_expert(toff, tile); const int pos = slot - 256 * toff[e]; return pos < cnt[e] ? list[2 * (e * NTOK + pos)] : 0; }
    __device__ const unsigned char* aptr(int slot) const { int e; const int tok = tok_of(slot, e); return x2b + (size_t)tok * K; }
    __device__ const unsigned char* bptr(int bm, int bn, int j) const { const int e = find_expert(toff, bm >> 2); const int a = bn * 32 + (j >> 2) * 2 + (j & 1), up = (j >> 1) & 1;
        const int row = 256 * (a >> 7) + (a & 127) + 128 * up; return wgu + ((size_t)e * 4096 + row) * K; }
    __device__ void out(int bm, int bn, int ty, int tx, float (&acc)[4][4]) const {
        for (int i = 0; i < 4; ++i) { const int slot = bm * 64 + ty * 4 + i; int e; const int tok = tok_of(slot, e); const float r = r2[tok];
            for (int j = 0; j < 2; ++j) { const int a = bn * 32 + tx * 2 + j;
                float g = acc[i][j] * r + b_gu[e * 4096 + a], u = acc[i][2 + j] * r + b_gu[e * 4096 + 2048 + a];
                g = fminf(g, SW_LIMIT); u = fminf(fmaxf(u, -SW_LIMIT), SW_LIMIT);
                act[(size_t)slot * DFF + a] = (unsigned char)(pk4_fp8((u + 1.0f) * g * sigmoidf_(SW_ALPHA * g), 0.f, 0.f, 0.f) & 255u); } }
    }
};
struct F10 { static constexpr int K = 2048; static constexpr bool FP8 = true; const unsigned char* act; const unsigned char* wdn; const int* toff; const float* b_dn; unsigned char* y;
    __device__ bool valid(int bm) const { return (bm >> 2) < toff[NE]; }
    __device__ void mid(int, int, int, float (&)[4][4]) const {}
    __device__ const unsigned char* aptr(int slot) const { return act + (size_t)slot * K; }
    __device__ const unsigned char* bptr(int bm, int bn, int j) const { const int e = find_expert(toff, bm >> 2); return wdn + ((size_t)e * DM + bn * 64 + j) * K; }
    __device__ void out(int bm, int bn, int ty, int tx, float (&acc)[4][4]) const { const int e = find_expert(toff, bm >> 2);
        for (int i = 0; i < 4; ++i) { const int slot = bm * 64 + ty * 4 + i;
            for (int j = 0; j < 4; ++j) { const int n = bn * 64 + tx * 4 + j; y[(size_t)slot * DM + n] = (unsigned char)(pk4_fp8(acc[i][j] + b_dn[e * DM + n], 0.f, 0.f, 0.f) & 255u); } }
    }
};

__global__ void __launch_bounds__(256) n_attn(const bf16* __restrict__ qkxy, const bf16* __restrict__ vt, const float* __restrict__ rel, bf16* mix, float* ssa) {
    const int blk = blockIdx.x, tq = (blk & 7) * 256 + threadIdx.x, bh = blk >> 3, h = bh & 15, b = bh >> 4;
    const size_t m = (size_t)b * SEQ + tq;
    const bf16* Q = qkxy; const bf16* Kp = qkxy + (size_t)NTOK * 1024;
    float q[64], o[64];
#pragma unroll
    for (int d = 0; d < 64; ++d) { q[d] = bf2f(Q[m * 1024 + h * 64 + d]); o[d] = 0.f; }
    float mx = -INFINITY, l = 0.f;
    const int c = tq >> 6, k0 = (c > LEFTC ? c - LEFTC : 0) * 64, k1 = (c + 1) * 64;
    const float* tab = rel + h * RELW;
    for (int key = k0; key < k1; ++key) {
        const bf16* kr = Kp + ((size_t)b * SEQ + key) * 1024 + h * 64;
        float s = 0.f;
#pragma unroll
        for (int d = 0; d < 64; ++d) s += q[d] * bf2f(kr[d]);
        int r = tq - key; r = (r < -MAXREL ? -MAXREL : (r > MAXREL ? MAXREL : r)) + MAXREL;
        s += tab[r] * LOG2E;
        const float mn = fmaxf(mx, s), corr = exp2f(mx - mn), pe = exp2f(s - mn);
        l = l * corr + pe;
        const bf16* vp = vt + (size_t)(h * 64) * NTOK + (size_t)b * SEQ + key;
#pragma unroll
        for (int d = 0; d < 64; ++d) o[d] = o[d] * corr + pe * bf2f(vp[(size_t)d * NTOK]);
        mx = mn;
    }
    const float il = 1.0f / l; float ss = 0.f;
#pragma unroll
    for (int d = 0; d < 64; ++d) { const float v = o[d] * il; ss += v * v; mix[m * DM + h * 64 + d] = (bf16)f2bf(v); }
    ssa[m * 16 + h] = ss;
}
__global__ void __launch_bounds__(256) n_xattn(const bf16* __restrict__ cq, const bf16* __restrict__ ck, const bf16* __restrict__ cvt, bf16* ox) {
    const int blk = blockIdx.x, dh = blk & 1, tq = ((blk >> 1) & 7) * 256 + threadIdx.x, bh = blk >> 4, h = bh & 3, b = bh >> 2;
    const size_t m = (size_t)b * SEQ + tq;
    float q[128], o[64];
#pragma unroll
    for (int d = 0; d < 128; ++d) q[d] = bf2f(cq[m * XW + h * XHD + d]);
#pragma unroll
    for (int d = 0; d < 64; ++d) o[d] = 0.f;
    float mx = -INFINITY, l = 0.f;
    for (int key = 0; key < MEML; ++key) {
        const bf16* kr = ck + ((size_t)b * MEML + key) * XW + h * XHD;
        float s = 0.f;
#pragma unroll
        for (int d = 0; d < 128; ++d) s += q[d] * bf2f(kr[d]);
        const float mn = fmaxf(mx, s), corr = exp2f(mx - mn), pe = exp2f(s - mn);
        l = l * corr + pe;
        const bf16* vp = cvt + (size_t)(h * XHD + dh * 64) * NMEM + (size_t)b * MEML + key;
#pragma unroll
        for (int d = 0; d < 64; ++d) o[d] = o[d] * corr + pe * bf2f(vp[(size_t)d * NMEM]);
        mx = mn;
    }
    const float il = 1.0f / l;
#pragma unroll
    for (int d = 0; d < 64; ++d) ox[m * XW + h * XHD + dh * 64 + d] = (bf16)f2bf(o[d] * il);
}
__global__ void __launch_bounds__(256) n_lru_a(const bf16* __restrict__ xr, const float* __restrict__ conv_w, const float* __restrict__ conv_b, const bf16* __restrict__ wga_t, const float* __restrict__ b_ga,
                                              const bf16* __restrict__ wgx_t, const float* __restrict__ b_gx, const float* __restrict__ lam, float* na, float* nb) {
    const size_t idx = (size_t)blockIdx.x * 256 + threadIdx.x; const int c = (int)(idx & 1023); const size_t m = idx >> 10; const int t = (int)(m & (SEQ - 1)), n = c >> 7, d = c & 127;
    float rp = b_ga[c], ip = b_gx[c], xown = 0.f;
    const bf16* wa = wga_t + (size_t)(n * 128 + d) * 128; const bf16* wx = wgx_t + (size_t)(n * 128 + d) * 128;
    for (int cp = 0; cp < 128; ++cp) { const int cc = n * 128 + cp; float xc = conv_b[cc];
#pragma unroll
        for (int j = 0; j < 4; ++j) { const int tt = t - 3 + j; if (tt >= 0) xc += conv_w[j * LW + cc] * bf2f(xr[(m - 3 + j) * 1024 + cc]); }
        rp += xc * bf2f(wa[cp]); ip += xc * bf2f(wx[cp]); if (cp == d) xown = xc; }
    const float r = sigmoidf_(rp), ig = sigmoidf_(ip);
    const float la = -8.0f * r * log1pf(__expf(-lam[c]));
    na[idx] = __expf(la); nb[idx] = sqrtf(-expm1f(2.0f * la)) * (ig * xown);
}
__global__ void __launch_bounds__(64) n_lru_b(const float* __restrict__ na, const float* __restrict__ nb, const bf16* __restrict__ yg, bf16* mix, float* ssl) {
    const int b = blockIdx.x >> 4, g = blockIdx.x & 15, c = g * 64 + threadIdx.x; float h = 0.f;
    for (int t = 0; t < SEQ; ++t) { const size_t m = (size_t)b * SEQ + t; h = na[m * 1024 + c] * h + nb[m * 1024 + c];
        const float y = h * gelu_tanh(bf2f(yg[m * 1024 + c])); mix[m * DM + 1024 + c] = (bf16)f2bf(y);
        const float s = wave_sum(y * y); if (threadIdx.x == 0) ssl[m * 16 + g] = s; }
}
__global__ void n_toff(const int* cnt, int* toff) { if (threadIdx.x == 0 && blockIdx.x == 0) { int a = 0; for (int e = 0; e < NE; ++e) { toff[e] = a; a += (cnt[e] + 255) >> 8; } toff[NE] = a; } }

#define XB_TMO      128
#define XB_XCNT(j)  (256  + 64 * (j))
#define XB_XSUB(j)  (1280 + 64 * (j))
#define XB_XGEN(j)  (2304 + 64 * (j))
#define XB_TOP      3328
#define XB_TOPGEN   3392
#define XCD_BAR_WORDS 3456
#define XB_SPIN_CAP (1u << 18)
__device__ __forceinline__ unsigned xb_ld(unsigned* p)              { return __hip_atomic_load(p, __ATOMIC_RELAXED, __HIP_MEMORY_SCOPE_AGENT); }
__device__ __forceinline__ unsigned xb_add(unsigned* p, unsigned v) { return __hip_atomic_fetch_add(p, v, __ATOMIC_RELAXED, __HIP_MEMORY_SCOPE_AGENT); }
__device__ __forceinline__ unsigned xb_xcc_id() { return (unsigned)__builtin_amdgcn_s_getreg((3 << 11) | 20) & 0xFu; }
#define XB_SPIN(cond, bar) do { unsigned _sp = 0; while (cond) { __builtin_amdgcn_s_sleep(1); \
    if ((++_sp & 255u) == 0u) { if (xb_ld(&(bar)[XB_TMO])) break; if (_sp > XB_SPIN_CAP) { atomicAdd(&(bar)[XB_TMO], 1u); break; } } } } while (0)
struct XcdBarrier { unsigned* bar; unsigned x; volatile LAS unsigned* st; };
__device__ __forceinline__ XcdBarrier xcd_barrier_post(unsigned* bar, volatile LAS unsigned* st) {
    XcdBarrier b; b.bar = bar; b.x = xb_xcc_id(); b.st = st;
    if (threadIdx.x == 0) (void)xb_add(&bar[XB_XCNT(b.x)], 1u);
    return b;
}
__device__ __forceinline__ void xcd_barrier_complete(unsigned* bar, unsigned x, unsigned& nloc, unsigned& nx) {
    const unsigned G = gridDim.x * gridDim.y * gridDim.z;
    unsigned sum, cnt, mine, sp = 0u;
    for (;;) {
        sum = 0u; cnt = 0u; mine = 0u;
#pragma unroll
        for (unsigned j = 0; j < 16; ++j) { const unsigned c = xb_ld(&bar[XB_XCNT(j)]); sum += c; cnt += (c > 0u) ? 1u : 0u; mine = (j == x) ? c : mine; }
        if (sum == G) break;
        __builtin_amdgcn_s_sleep(1);
        if ((++sp & 255u) == 0u) { if (xb_ld(&bar[XB_TMO])) break; if (sp > XB_SPIN_CAP) { atomicAdd(&bar[XB_TMO], 1u); break; } }
    }
    nloc = mine > 0u ? mine : 1u; nx = cnt > 0u ? cnt : 1u;
}
__device__ __forceinline__ void xcd_barrier(const XcdBarrier& b) {
    asm volatile("s_waitcnt vmcnt(0)" ::: "memory");
    __syncthreads();
    if (threadIdx.x == 0) {
        unsigned* bar = b.bar;
        __builtin_amdgcn_s_waitcnt(0);
        unsigned nloc = b.st[0], nx = b.st[1];
        if (nloc == 0u) { xcd_barrier_complete(bar, b.x, nloc, nx); b.st[0] = nloc; b.st[1] = nx; }
        const unsigned old = xb_add(&bar[XB_XSUB(b.x)], 1u);
        const unsigned gen = old / nloc;
        if (old + 1u == (gen + 1u) * nloc) {
            __builtin_amdgcn_fence(__ATOMIC_RELEASE, "agent");
            asm volatile("s_waitcnt vmcnt(0)" ::: "memory");
            const unsigned og = xb_add(&bar[XB_TOP], 1u);
            const unsigned tg = og / nx;
            if (og + 1u == (tg + 1u) * nx) xb_add(&bar[XB_TOPGEN], 1u);
            else XB_SPIN(xb_ld(&bar[XB_TOPGEN]) == tg, bar);
            __builtin_amdgcn_fence(__ATOMIC_ACQUIRE, "agent");
            xb_add(&bar[XB_XGEN(b.x)], 1u);
            asm volatile("s_waitcnt vmcnt(0)" ::: "memory");
        } else {
            XB_SPIN(xb_ld(&bar[XB_XGEN(b.x)]) == gen, bar);
            __builtin_amdgcn_fence(__ATOMIC_ACQUIRE, "agent");
            asm volatile("s_waitcnt vmcnt(0)" ::: "memory");
        }
    }
    __syncthreads();
}

#ifndef EPI_TWICE
#define EPI_TWICE 0
#endif
namespace pg8 {
constexpr int BM = 256, BK = 64, HALF = 128, HTB = HALF * BK * 2, STAGE_BYTES = 8 * HTB;
__host__ __device__ __forceinline__ int lds_byte(int r, int c) { const int st = (r >> 4) * 2 + (c >> 5), rr = r & 15, cc = c & 31, ob = rr * 64 + cc * 2; return st * 1024 + (ob ^ (((ob >> 9) & 1) << 5)); }
__host__ __device__ __forceinline__ void stage_rc(int b, int& R, int& C) { const int st = b / 1024, sb = b % 1024, swz = sb ^ (((sb >> 9) & 1) << 5); R = (st >> 1) * 16 + swz / 64; C = (st & 1) * 32 + (swz % 64) / 2; }
__host__ __device__ __forceinline__ int perm32(int rho) { const int n = rho >> 4, i = rho & 15; return 8 * (i >> 2) + 4 * n + (i & 3); }
__device__ __forceinline__ unsigned cvt_pk_bf16(float lo, float hi) { unsigned r; asm volatile("v_cvt_pk_bf16_f32 %0, %1, %2" : "=v"(r) : "v"(lo), "v"(hi)); return r; }
struct Unit { const char* a; const char* b; int pm, pn, e, tl, idx; };
typedef f32x4 Acc[2][2][4][2];
typedef int v8i __attribute__((ext_vector_type(8)));
__device__ __forceinline__ v8i cat8(const bf16x8 lo, const bf16x8 hi) { const v4u a = __builtin_bit_cast(v4u, lo), b = __builtin_bit_cast(v4u, hi); return (v8i){(int)a.x, (int)a.y, (int)a.z, (int)a.w, (int)b.x, (int)b.y, (int)b.z, (int)b.w}; }
template <class Epi, class Sched>
__device__ __forceinline__ void gemm_phase(LAS unsigned char* lds, const int KB  , const Sched& S, const Epi& E, const int stagger = 0) {
    if (stagger) { const unsigned long long t0 = __builtin_amdgcn_s_memrealtime(), d = (unsigned long long)(((blockIdx.x >> 3) & 3u) * (unsigned)stagger);
        while (__builtin_amdgcn_s_memrealtime() - t0 < d) __builtin_amdgcn_s_sleep(8); }
    const int tid = threadIdx.x, wid = __builtin_amdgcn_readfirstlane(tid >> 6), lane = tid & 63, wr = wid >> 2, wc = wid & 3, fr = lane & 15, fq = lane >> 4;
    const int nt = KB / 128;
    unsigned voffA[2], voffB[2];
#pragma unroll
    for (int i = 0; i < 2; ++i) { int R, C; stage_rc(tid * 16 + i * 8192, R, C); const int Rb = Epi::PERM ? ((R & ~31) + perm32(R & 31)) : R;
        voffA[i] = Sched::GATHER ? (unsigned)(C * 2) : (unsigned)(R * KB + C * 2); voffB[i] = (unsigned)(Rb * KB + C * 2); }
    const size_t kstep = (size_t)(BK * 2);
    const size_t hstep = (size_t)HALF * KB;
    const unsigned ldsw = (unsigned)wid * 1024u;
    const int aoff = lds_byte(wr * 64 + fr, fq * 8), boff = lds_byte(wc * 32 + fr, fq * 8);
#define PG8_SA(b, h) (((b) * 2 + (h)) * HTB)
#define PG8_SB(b, h) ((4 + (b) * 2 + (h)) * HTB)
#define PG8_STAGE(bufoff, gbase, voff) do { _Pragma("unroll") for (int _i = 0; _i < 2; ++_i) { unsigned _vo = (voff)[_i]; asm volatile("" : "+v"(_vo)); \
        __builtin_amdgcn_global_load_lds((const unsigned*)((const char*)(gbase) + _vo), (LAS unsigned*)(lds + (bufoff) + ldsw + _i * 8192), 16, 0, 0); } } while (0)
#define PG8_STAGE_A(bufoff, gbase, h, go) do { if constexpr (Sched::GATHER) { PG8_STAGE(bufoff, gbase, go[h]); } else { PG8_STAGE(bufoff, (gbase) + (h) * hstep, voffA); } } while (0)
#define PG8_LDA(dst, b, h) do { _Pragma("unroll") for (int m = 0; m < 4; ++m) _Pragma("unroll") for (int k = 0; k < 2; ++k) dst[m][k] = *(const LAS bf16x8*)(lds + PG8_SA(b, h) + aoff + m * 2048 + k * 1024); } while (0)
#define PG8_LDB(dst, b, h) do { _Pragma("unroll") for (int n = 0; n < 2; ++n) _Pragma("unroll") for (int k = 0; k < 2; ++k) dst[n][k] = *(const LAS bf16x8*)(lds + PG8_SB(b, h) + boff + n * 2048 + k * 1024); } while (0)
#define PG8_MMA(ai, bj, At, Bt) do { __builtin_amdgcn_s_setprio(1); _Pragma("unroll") for (int m = 0; m < 4; ++m) _Pragma("unroll") for (int n = 0; n < 2; ++n) { \
        if constexpr (Sched::FP8) acc[ai][bj][m][n] = __builtin_amdgcn_mfma_scale_f32_16x16x128_f8f6f4(cat8(Bt[n][0], Bt[n][1]), cat8(At[m][0], At[m][1]), acc[ai][bj][m][n], 0, 0, 0, 0x7C7C7C7C, 0, 0x7C7C7C7C);     \
        else { _Pragma("unroll") for (int k = 0; k < 2; ++k) acc[ai][bj][m][n] = __builtin_amdgcn_mfma_f32_16x16x32_bf16(Bt[n][k], At[m][k], acc[ai][bj][m][n], 0, 0, 0); } } __builtin_amdgcn_s_setprio(0); } while (0)
#define PG8_WAIT_V(n) asm volatile("s_waitcnt vmcnt(" #n ")" ::: "memory")
#define PG8_WAIT_L(n) asm volatile("s_waitcnt lgkmcnt(" #n ")" ::: "memory")
#define PG8_BAR __builtin_amdgcn_s_barrier()
#define PG8_SCHED __builtin_amdgcn_sched_barrier(0)
    Unit cur, nxt; int ui = 0;
    if (!S.next(0, cur)) return;
    Acc acc;
#pragma unroll
    for (int a = 0; a < 2; ++a)
#pragma unroll
        for (int b = 0; b < 2; ++b)
#pragma unroll
            for (int m = 0; m < 4; ++m)
#pragma unroll
                for (int n = 0; n < 2; ++n) acc[a][b][m][n] = (f32x4){0.f, 0.f, 0.f, 0.f};
    bf16x8 At[4][2], B0[2][2], B1[2][2];
    const char* cA = cur.a; const char* cB = cur.b;
    unsigned gc[2][2], gn[2][2];
    if constexpr (Sched::GATHER) { S.gather(cur, voffA, gc); }
    if constexpr (Epi::PREF) E.prefetch(cur);
    PG8_STAGE(PG8_SB(0, 0), cB, voffB); PG8_STAGE(PG8_SB(0, 1), cB + hstep, voffB); PG8_STAGE_A(PG8_SA(0, 0), cA, 0, gc); PG8_STAGE_A(PG8_SA(0, 1), cA, 1, gc);
    if (wr == 1) PG8_BAR;
    PG8_WAIT_V(2); PG8_BAR;
    PG8_STAGE(PG8_SB(1, 0), cB + kstep, voffB); PG8_STAGE_A(PG8_SA(1, 0), cA + kstep, 0, gc); PG8_STAGE(PG8_SB(1, 1), cB + hstep + kstep, voffB);
    PG8_WAIT_V(6); PG8_BAR;
    for (;;) {
        const bool has_next = S.next(ui + 1, nxt);
        const char* nA = has_next ? nxt.a : cA; const char* nB = has_next ? nxt.b : cB;
        if constexpr (Sched::GATHER) { if (has_next) S.gather(nxt, voffA, gn); else {
#pragma unroll
            for (int h = 0; h < 2; ++h)
#pragma unroll
                for (int i = 0; i < 2; ++i) gn[h][i] = gc[h][i]; } }
        for (int t = 0; t < nt; t += 2) {
            const bool last = (t == nt - 2);
            if constexpr (Epi::MIDK) { if (t == nt / 2) { int fr_e = fr; asm volatile("" : "+v"(fr_e)); E.midk(acc, cur, wr, fr_e); } }
            const char* a1 = cA + (size_t)(t + 1) * kstep;
            const char* a2 = last ? nA : cA + (size_t)(t + 2) * kstep; const char* b2 = last ? nB : cB + (size_t)(t + 2) * kstep;
            const char* a3 = a2 + kstep; const char* b3 = b2 + kstep;
            PG8_LDB(B0, 0, 0); PG8_LDB(B1, 0, 1); PG8_SCHED; PG8_LDA(At, 0, 0); PG8_STAGE_A(PG8_SA(1, 1), a1, 1, gc);
            if constexpr (Sched::GATHER) { if (last) {
#pragma unroll
                for (int h = 0; h < 2; ++h)
#pragma unroll
                    for (int i = 0; i < 2; ++i) gc[h][i] = gn[h][i]; } }
            PG8_WAIT_V(8); PG8_WAIT_L(0); PG8_BAR; PG8_MMA(0, 0, At, B0); PG8_MMA(0, 1, At, B1); PG8_BAR; PG8_SCHED;
            PG8_LDA(At, 0, 1); PG8_STAGE(PG8_SB(0, 0), b2, voffB); PG8_STAGE(PG8_SB(0, 1), b2 + hstep, voffB); PG8_STAGE_A(PG8_SA(0, 0), a2, 0, gc);
            PG8_WAIT_V(8); PG8_WAIT_L(0); PG8_BAR; PG8_MMA(1, 0, At, B0); PG8_MMA(1, 1, At, B1); PG8_BAR; PG8_SCHED;
            PG8_LDB(B0, 1, 0); PG8_LDB(B1, 1, 1); PG8_SCHED; PG8_LDA(At, 1, 0); PG8_STAGE_A(PG8_SA(0, 1), a2, 1, gc);
            PG8_WAIT_V(8); PG8_WAIT_L(0); PG8_BAR; PG8_MMA(0, 0, At, B0); PG8_MMA(0, 1, At, B1); PG8_BAR; PG8_SCHED;
            PG8_LDA(At, 1, 1); PG8_STAGE(PG8_SB(1, 0), b3, voffB); PG8_STAGE(PG8_SB(1, 1), b3 + hstep, voffB); PG8_STAGE_A(PG8_SA(1, 0), a3, 0, gc);
            PG8_WAIT_V(8); PG8_WAIT_L(0); PG8_BAR; PG8_MMA(1, 0, At, B0); PG8_MMA(1, 1, At, B1); PG8_BAR; PG8_SCHED;
        }
        if (wr == 0) PG8_BAR;
        { int fr_e = fr, fq_e = fq; asm volatile("" : "+v"(fr_e), "+v"(fq_e));
          E(acc, cur, wr, wc, fr_e, fq_e);
          if constexpr (EPI_TWICE != 0 && !Epi::INPLACE) { asm volatile("" : "+v"(fr_e), "+v"(fq_e)); E(acc, cur, wr, wc, fr_e, fq_e); } }
        if (!has_next) break;
#pragma unroll
        for (int a = 0; a < 2; ++a)
#pragma unroll
            for (int b = 0; b < 2; ++b)
#pragma unroll
                for (int m = 0; m < 4; ++m)
#pragma unroll
                    for (int n = 0; n < 2; ++n) acc[a][b][m][n] = (f32x4){0.f, 0.f, 0.f, 0.f};
        cur = nxt; cA = nA; cB = nB; ++ui;
        if constexpr (Epi::PREF) E.prefetch(cur);
        if (wr == 1) PG8_BAR;
    }
    PG8_WAIT_V(0);
    PG8_BAR;
#undef PG8_SA
#undef PG8_SB
#undef PG8_STAGE
#undef PG8_STAGE_A
#undef PG8_LDA
#undef PG8_LDB
#undef PG8_MMA
#undef PG8_WAIT_V
#undef PG8_WAIT_L
#undef PG8_BAR
#undef PG8_SCHED
}
}

namespace pg8 {
__device__ __forceinline__ void tile_of(int L, int nM, int nN, int& pm, int& pn) {
    const int nwg = nM * nN; int wgid = L; { const int q = nwg / 8, r = nwg % 8, xcd = wgid % 8, off = wgid / 8; wgid = (xcd < r ? xcd * (q + 1) : r * (q + 1) + (xcd - r) * q) + off; }
    const int nig = 8 * nN, gid = wgid / nig, fm = gid * 8, gsz = (nM - fm) < 8 ? (nM - fm) : 8;
    pm = fm + ((wgid % nig) % gsz); pn = (wgid % nig) / gsz;
}
struct SchedReg { static constexpr bool GATHER = false, FP8 = false;
    const char* A; const char* Bt; int nM, nN, G, c, rowbytes, bskip_from, bskip_rows;
    __device__ __forceinline__ bool next(int i, Unit& u) const { const int L = i * G + c; if (L >= nM * nN) return false; tile_of(L, nM, nN, u.pm, u.pn); u.e = 0; u.tl = 0; u.idx = i;
        u.a = A + (size_t)u.pm * 256 * rowbytes; const int brow = u.pn * 256 + (u.pn >= bskip_from ? bskip_rows : 0); u.b = Bt + (size_t)brow * rowbytes; return true; }
    __device__ __forceinline__ void gather(const Unit&, const unsigned (&)[2], unsigned (&)[2][2]) const {}
};
__device__ __forceinline__ void moe_unit_table(const LAS int* toff, LAS int* utab, int npn, int G, int c, int tid) {
    if (tid < 64) { int v = -1; const int ttot = toff[NE];
        int tile = -1, pn = 0;
        if (G == 256) { const int x = c & 7, j = c >> 3;
            if (npn == 16) { tile = 16 * tid + (j & 15); pn = 2 * x + (j >> 4); } else { tile = 32 * tid + x + 8 * (j >> 3); pn = j & 7; }
            if (tile >= ttot) tile = -1; }
        else { const int L = tid * G + c; if (L < ttot * npn) { int e = 0;
#pragma unroll 1
                for (int jj = 1; jj < NE; ++jj) e += (L >= toff[jj] * npn) ? 1 : 0;
                const int t0 = toff[e], ne = toff[e + 1] - t0, Ll = L - t0 * npn; pn = Ll / ne; tile = t0 + (Ll - pn * ne); } }
        if (tile >= 0) { int e = 0;
#pragma unroll 1
            for (int jj = 1; jj < NE; ++jj) e += (tile >= toff[jj]) ? 1 : 0;
            v = e | ((tile - toff[e]) << 8) | (pn << 16) | (tile << 21); }
        utab[tid] = v; }
}
template <bool G_> struct SchedMoE { static constexpr bool GATHER = G_, FP8 = true;
    const LAS int* utab; const LAS int* cnt; const int* list; const char* A; const char* Bt; int brows;
    __device__ __forceinline__ bool next(int i, Unit& u) const { if (i >= 64) return false; const int v = utab[i]; if (v < 0) return false; u.idx = i;
        u.e = v & 255; u.tl = (v >> 8) & 255; u.pn = (v >> 16) & 31; u.pm = (int)((unsigned)v >> 21);
        u.a = GATHER ? A : A + (size_t)u.pm * 256 * 2048; u.b = Bt + ((size_t)u.e * brows + u.pn * 256) * 2048; return true; }
    __device__ __forceinline__ void gather(const Unit& u, const unsigned (&voffA)[2], unsigned (&g)[2][2]) const {
        const int ce = cnt[u.e];
#pragma unroll
        for (int i = 0; i < 2; ++i) { int R, C; stage_rc((int)threadIdx.x * 16 + i * 8192, R, C);
#pragma unroll
            for (int h = 0; h < 2; ++h) { const int pos = u.tl * 256 + h * 128 + R; const int pc = pos < ce ? pos : ce - 1; const int tok = list[2 * ((size_t)u.e * NTOK + pc)]; g[h][i] = (unsigned)tok * 2048u + voffA[i]; } }
    }
};
struct SchedP1 { static constexpr bool GATHER = false, FP8 = false;
    const char* XB; const char* WIN; int G, c;
    __device__ __forceinline__ bool next(int i, Unit& u) const { const int L = i * G + c; if (L >= 2560) return false; u.tl = 0; u.idx = i;
        if (L < 2048) { tile_of(L, NTOK / 256, 16, u.pm, u.pn); u.e = 0; u.a = XB + (size_t)u.pm * 256 * 4096; u.b = WIN + (size_t)(u.pn * 256 + (u.pn >= 8 ? 1024 : 0)) * 4096; }
        else { tile_of(L - 2048, 4, NTOK / 256, u.pm, u.pn); u.e = 1; u.a = WIN + (size_t)(2048 + u.pm * 256) * 4096; u.b = XB + (size_t)u.pn * 256 * 4096; }
        return true; }
    __device__ __forceinline__ void gather(const Unit&, const unsigned (&)[2], unsigned (&)[2][2]) const {}
};
#define EPI_ROWS(ai, m) (u.pm * 256 + (ai) * 128 + wr * 64 + (m) * 16 + fr)
__device__ __forceinline__ v4u pack8(const f32x4 a, const f32x4 b) { v4u w; w.x = cvt_pk_bf16(a[0], a[1]); w.y = cvt_pk_bf16(a[2], a[3]); w.z = cvt_pk_bf16(b[0], b[1]); w.w = cvt_pk_bf16(b[2], b[3]); return w; }
struct EpiRowScale { static constexpr bool PERM = true, MIDK = false, INPLACE = false, PREF = true; const float* ss; bf16* out; int ld, split_cols; size_t split_stride; float mul0; LAS float* slots;
    __device__ __forceinline__ void prefetch(const Unit& u) const { const int tid = threadIdx.x, w = __builtin_amdgcn_readfirstlane(tid >> 6);
        if (w < 4) __builtin_amdgcn_global_load_lds((const unsigned*)(ss + u.pm * 256 + tid), (LAS unsigned*)(slots + (u.idx & 1) * 512 + w * 64), 4, 0, 0); }
    __device__ __forceinline__ void operator()(const Acc& acc, const Unit& u, int wr, int wc, int fr, int fq) const {
        int colt = u.pn * 256; bf16* base = out; float mul = mul0;
        if (split_cols) { const int t = colt / split_cols; base += (size_t)t * split_stride; colt -= t * split_cols; mul = t == 0 ? mul0 : 1.0f; }
        const int col0 = colt + wc * 32 + 8 * fq;
        float rs[2][4]; const LAS float* sl = slots + (u.idx & 1) * 512 + wr * 64 + fr;
#pragma unroll
        for (int ai = 0; ai < 2; ++ai)
#pragma unroll
            for (int m = 0; m < 4; ++m) rs[ai][m] = sl[ai * 128 + m * 16];
#pragma unroll
        for (int ai = 0; ai < 2; ++ai)
#pragma unroll
            for (int m = 0; m < 4; ++m) { const int row = EPI_ROWS(ai, m); const float r = rsqrtf(rs[ai][m] * (1.0f / DM) + EPS) * mul; bf16* rowp = base + (size_t)row * ld + col0;
#pragma unroll
                for (int bj = 0; bj < 2; ++bj) *(v4u*)(rowp + bj * 128) = pack8(acc[ai][bj][m][0] * r, acc[ai][bj][m][1] * r); }
    }
};
struct EpiColScale { static constexpr bool PERM = true, MIDK = false, INPLACE = false, PREF = true; const float* ss; bf16* out; size_t ld; LAS float* slots;
    __device__ __forceinline__ void prefetch(const Unit& u) const { const int tid = threadIdx.x, w = __builtin_amdgcn_readfirstlane(tid >> 6);
        if (w < 4) __builtin_amdgcn_global_load_lds((const unsigned*)(ss + u.pn * 256 + tid), (LAS unsigned*)(slots + (u.idx & 1) * 512 + w * 64), 4, 0, 0); }
    __device__ __forceinline__ void operator()(const Acc& acc, const Unit& u, int wr, int wc, int fr, int fq) const {
        f32x4 sc[2][2];
#pragma unroll
        for (int bj = 0; bj < 2; ++bj) { const LAS float* sl = slots + (u.idx & 1) * 512 + bj * 128 + wc * 32 + 8 * fq; sc[bj][0] = *(const LAS f32x4*)sl; sc[bj][1] = *(const LAS f32x4*)(sl + 4); }
#pragma unroll
        for (int bj = 0; bj < 2; ++bj) { const int c0 = u.pn * 256 + bj * 128 + wc * 32 + 8 * fq; f32x4 s0 = sc[bj][0], s1 = sc[bj][1];
#pragma unroll
            for (int j = 0; j < 4; ++j) { s0[j] = rsqrtf(s0[j] * (1.0f / DM) + EPS); s1[j] = rsqrtf(s1[j] * (1.0f / DM) + EPS); }
#pragma unroll
            for (int ai = 0; ai < 2; ++ai)
#pragma unroll
                for (int m = 0; m < 4; ++m) { const int row = EPI_ROWS(ai, m); *(v4u*)(out + (size_t)row * ld + c0) = pack8(acc[ai][bj][m][0] * s0, acc[ai][bj][m][1] * s1); } }
    }
};
struct EpiP1 { static constexpr bool PERM = true, MIDK = false, INPLACE = false, PREF = true; EpiRowScale rs; EpiColScale cs;
    __device__ __forceinline__ void prefetch(const Unit& u) const { if (u.e == 0) rs.prefetch(u); else cs.prefetch(u); }
    __device__ __forceinline__ void operator()(const Acc& acc, const Unit& u, int wr, int wc, int fr, int fq) const { if (u.e == 0) rs(acc, u, wr, wc, fr, fq); else cs(acc, u, wr, wc, fr, fq); }
};
struct EpiX1 { static constexpr bool PERM = true, MIDK = true, INPLACE = false, PREF = true; const float* scl; const bf16* x; float* x1; bf16* x1b; float* ss1p; LAS float* slots;
    __device__ __forceinline__ void prefetch(const Unit& u) const { const int tid = threadIdx.x, w = __builtin_amdgcn_readfirstlane(tid >> 6);
        __builtin_amdgcn_global_load_lds((const unsigned*)(scl + 2 * (size_t)(u.pm * 256 + (tid & 255)) + (tid >> 8)), (LAS unsigned*)(slots + (u.idx & 1) * 512 + w * 64), 4, 0, 0); }
    __device__ __forceinline__ void midk(Acc& acc, const Unit& u, int wr, int fr) const { const LAS float* sl = slots + (u.idx & 1) * 512 + wr * 64 + fr;
#pragma unroll
        for (int ai = 0; ai < 2; ++ai)
#pragma unroll
            for (int m = 0; m < 4; ++m) { const float s = sl[ai * 128 + m * 16];
#pragma unroll
                for (int bj = 0; bj < 2; ++bj) { acc[ai][bj][m][0] *= s; acc[ai][bj][m][1] *= s; } }
    }
    __device__ __forceinline__ void operator()(const Acc& acc, const Unit& u, int wr, int wc, int fr, int fq) const {
        const int col0 = u.pn * 256 + wc * 32 + 8 * fq; const LAS float* sl = slots + (u.idx & 1) * 512 + 256 + wr * 64 + fr;
#pragma unroll
        for (int ai = 0; ai < 2; ++ai) {
            v4u xw[4][2]; float sv[4];
#pragma unroll
            for (int m = 0; m < 4; ++m) { const int row = EPI_ROWS(ai, m); const size_t off = (size_t)row * DM + col0; sv[m] = sl[ai * 128 + m * 16];
#pragma unroll
                for (int bj = 0; bj < 2; ++bj) xw[m][bj] = *(const v4u*)(x + off + bj * 128); }
#pragma unroll
            for (int m = 0; m < 4; ++m) { const int row = EPI_ROWS(ai, m); const float s = sv[m]; const size_t off = (size_t)row * DM + col0; float q = 0.f;
#pragma unroll
                for (int bj = 0; bj < 2; ++bj) { const v4u w = xw[m][bj];
                    const f32x4 v0 = (f32x4){__uint_as_float(w.x << 16), __uint_as_float(w.x & 0xffff0000u), __uint_as_float(w.y << 16), __uint_as_float(w.y & 0xffff0000u)} + acc[ai][bj][m][0] * s,
                                v1 = (f32x4){__uint_as_float(w.z << 16), __uint_as_float(w.z & 0xffff0000u), __uint_as_float(w.w << 16), __uint_as_float(w.w & 0xffff0000u)} + acc[ai][bj][m][1] * s;
                    *(v4u*)(x1b + off + bj * 128) = pack8(v0, v1);
                    q += (v0[0] * v0[0] + v0[1] * v0[1]) + (v0[2] * v0[2] + v0[3] * v0[3]) + (v1[0] * v1[0] + v1[1] * v1[1]) + (v1[2] * v1[2] + v1[3] * v1[3]); }
                q += __shfl_xor(q, 16); q += __shfl_xor(q, 32);
                if (fq == 0) ss1p[(size_t)row * 32 + u.pn * 4 + wc] = q; } }
    }
};
struct EpiCQ { static constexpr bool PERM = true, MIDK = false, INPLACE = false, PREF = true; const float* ss1p; bf16* cq; LAS float* slots;
    __device__ __forceinline__ void prefetch(const Unit& u) const { const int tid = threadIdx.x;
        if (tid < 256) { const f32x4* sp = (const f32x4*)(ss1p + (size_t)(u.pm * 256 + tid) * 32); f32x4 t = sp[0];
#pragma unroll
            for (int j = 1; j < 8; ++j) t += sp[j];
            slots[(u.idx & 1) * 512 + tid] = rsqrtf(((t[0] + t[1]) + (t[2] + t[3])) * (1.0f / DM) + EPS) * CQSCALE; } }
    __device__ __forceinline__ void operator()(const Acc& acc, const Unit& u, int wr, int wc, int fr, int fq) const {
        const int col0 = u.pn * 256 + wc * 32 + 8 * fq; const LAS float* sl = slots + (u.idx & 1) * 512 + wr * 64 + fr;
        float rr[2][4];
#pragma unroll
        for (int ai = 0; ai < 2; ++ai)
#pragma unroll
            for (int m = 0; m < 4; ++m) rr[ai][m] = sl[ai * 128 + m * 16];
#pragma unroll
        for (int ai = 0; ai < 2; ++ai)
#pragma unroll
            for (int m = 0; m < 4; ++m) { const int row = EPI_ROWS(ai, m); const float r = rr[ai][m];
#pragma unroll
                for (int bj = 0; bj < 2; ++bj) *(v4u*)(cq + (size_t)row * XW + col0 + bj * 128) = pack8(acc[ai][bj][m][0] * r, acc[ai][bj][m][1] * r); }
    }
};
struct EpiX2 { static constexpr bool PERM = true, MIDK = false, INPLACE = false, PREF = false; const bf16* x1b; bf16* x2; unsigned char* x2b;
    __device__ __forceinline__ void operator()(const Acc& acc, const Unit& u, int wr, int wc, int fr, int fq) const {
        const int col0 = u.pn * 256 + wc * 32 + 8 * fq;
#pragma unroll
        for (int ai = 0; ai < 2; ++ai) { v4u xv[4][2];
#pragma unroll
            for (int m = 0; m < 4; ++m) { const size_t off = (size_t)EPI_ROWS(ai, m) * DM + col0;
#pragma unroll
                for (int bj = 0; bj < 2; ++bj) xv[m][bj] = *(const v4u*)(x1b + off + bj * 128); }
#pragma unroll
            for (int m = 0; m < 4; ++m) { const size_t off = (size_t)EPI_ROWS(ai, m) * DM + col0;
#pragma unroll
                for (int bj = 0; bj < 2; ++bj) { const v4u w = xv[m][bj];
                    const f32x4 v0 = (f32x4){__uint_as_float(w.x << 16), __uint_as_float(w.x & 0xffff0000u), __uint_as_float(w.y << 16), __uint_as_float(w.y & 0xffff0000u)} + acc[ai][bj][m][0],
                                v1 = (f32x4){__uint_as_float(w.z << 16), __uint_as_float(w.z & 0xffff0000u), __uint_as_float(w.w << 16), __uint_as_float(w.w & 0xffff0000u)} + acc[ai][bj][m][1];
                    *(v4u*)(x2 + off + bj * 128) = pack8(v0, v1); v2u o; o.x = pk4_fp8(v0[0], v0[1], v0[2], v0[3]); o.y = pk4_fp8(v1[0], v1[1], v1[2], v1[3]); *(v2u*)(x2b + off + bj * 128) = o; } } }
    }
};
struct EpiAct { static constexpr bool PERM = true, MIDK = false, INPLACE = false, PREF = true; const LAS int* cnt; const int* list; const float* r2; const float* b_gu; unsigned char* act; LAS float* slots;
    __device__ __forceinline__ void prefetch(const Unit& u) const { const int tid = threadIdx.x, w = __builtin_amdgcn_readfirstlane(tid >> 6); LAS float* s = slots + (u.idx & 1) * 512 + w * 64; const float* g;
        if (w < 4) { const int ce = cnt[u.e], pos = u.tl * 256 + tid, pc = pos < ce ? pos : ce - 1; g = (const float*)(list + 2 * ((size_t)u.e * NTOK + pc) + 1); }
        else { const int c = tid - 256; g = b_gu + (size_t)u.e * 4096 + (c >> 7) * 2048 + u.pn * 128 + (c & 127); }
        __builtin_amdgcn_global_load_lds((const unsigned*)g, (LAS unsigned*)s, 4, 0, 0); }
    __device__ __forceinline__ void operator()(const Acc& acc, const Unit& u, int wr, int wc, int fr, int fq) const {
        const int cb = u.pn * 128 + wc * 32 + 8 * fq; const LAS float* sl = slots + (u.idx & 1) * 512; const LAS float* bl = sl + 256 + wc * 32 + 8 * fq;
        const f32x4 bg0 = *(const LAS f32x4*)bl, bg1 = *(const LAS f32x4*)(bl + 4), bu0 = *(const LAS f32x4*)(bl + 128) + 1.0f, bu1 = *(const LAS f32x4*)(bl + 132) + 1.0f;
        float sv[2][4];
#pragma unroll
        for (int ai = 0; ai < 2; ++ai)
#pragma unroll
            for (int m = 0; m < 4; ++m) sv[ai][m] = sl[ai * 128 + wr * 64 + m * 16 + fr];
#pragma unroll
        for (int ai = 0; ai < 2; ++ai)
#pragma unroll
            for (int m = 0; m < 4; ++m) { const int r = ai * 128 + wr * 64 + m * 16 + fr; const float s = sv[ai][m];
                f32x4 g0 = acc[ai][0][m][0] * s + bg0, g1 = acc[ai][0][m][1] * s + bg1, u0 = acc[ai][1][m][0] * s + bu0, u1 = acc[ai][1][m][1] * s + bu1;
#pragma unroll
                for (int j = 0; j < 4; ++j) { g0[j] = fminf(g0[j], SW_LIMIT); g1[j] = fminf(g1[j], SW_LIMIT); u0[j] = __builtin_amdgcn_fmed3f(u0[j], 1.0f - SW_LIMIT, 1.0f + SW_LIMIT); u1[j] = __builtin_amdgcn_fmed3f(u1[j], 1.0f - SW_LIMIT, 1.0f + SW_LIMIT); }
                f32x4 z0 = g0 * (-SW_ALPHA * LOG2E), z1 = g1 * (-SW_ALPHA * LOG2E);
#pragma unroll
                for (int j = 0; j < 4; ++j) { z0[j] = __builtin_amdgcn_exp2f(z0[j]); z1[j] = __builtin_amdgcn_exp2f(z1[j]); }
                z0 = z0 + 1.0f; z1 = z1 + 1.0f;
#pragma unroll
                for (int j = 0; j < 4; ++j) { z0[j] = __builtin_amdgcn_rcpf(z0[j]); z1[j] = __builtin_amdgcn_rcpf(z1[j]); }
                g0 = u0 * (g0 * z0); g1 = u1 * (g1 * z1);
                v2u w; w.x = pk4_fp8(g0[0], g0[1], g0[2], g0[3]); w.y = pk4_fp8(g1[0], g1[1], g1[2], g1[3]); *(v2u*)(act + (size_t)(u.pm * 256 + r) * DFF + cb) = w; }
    }
};
struct EpiY { static constexpr bool PERM = true, MIDK = false, INPLACE = false, PREF = true; const float* b_dn; unsigned char* y; LAS float* slots;
    __device__ __forceinline__ void prefetch(const Unit& u) const { const int tid = threadIdx.x, w = __builtin_amdgcn_readfirstlane(tid >> 6);
        if (w < 4) __builtin_amdgcn_global_load_lds((const unsigned*)(b_dn + (size_t)u.e * DM + u.pn * 256 + tid), (LAS unsigned*)(slots + (u.idx & 1) * 512 + 256 + w * 64), 4, 0, 0); }
    __device__ __forceinline__ void operator()(const Acc& acc, const Unit& u, int wr, int wc, int fr, int fq) const {
        const int col0 = u.pn * 256 + wc * 32 + 8 * fq; const LAS float* bl = slots + (u.idx & 1) * 512 + 256 + wc * 32 + 8 * fq;
        f32x4 bb[2][2];
#pragma unroll
        for (int bj = 0; bj < 2; ++bj) { bb[bj][0] = *(const LAS f32x4*)(bl + bj * 128); bb[bj][1] = *(const LAS f32x4*)(bl + bj * 128 + 4); }
#pragma unroll
        for (int bj = 0; bj < 2; ++bj) { const f32x4 b0 = bb[bj][0], b1 = bb[bj][1];
#pragma unroll
            for (int ai = 0; ai < 2; ++ai)
#pragma unroll
                for (int m = 0; m < 4; ++m) { const f32x4 v0 = acc[ai][bj][m][0] + b0, v1 = acc[ai][bj][m][1] + b1; v2u w; w.x = pk4_fp8(v0[0], v0[1], v0[2], v0[3]); w.y = pk4_fp8(v1[0], v1[1], v1[2], v1[3]);
                    *(v2u*)(y + (size_t)EPI_ROWS(ai, m) * DM + col0 + bj * 128) = w; } }
    }
};
#undef EPI_ROWS
}

#define GLDS16(gp, lp) __builtin_amdgcn_global_load_lds((const unsigned*)(gp), (LAS unsigned*)(lp), 16, 0, 0)
#define MFMA32(a, b, c) __builtin_amdgcn_mfma_f32_32x32x16_bf16((a), (b), (c), 0, 0, 0)
#define MFMA16(a, b, c) __builtin_amdgcn_mfma_f32_16x16x32_bf16((a), (b), (c), 0, 0, 0)
typedef __bf16 bf16x2_t __attribute__((ext_vector_type(2)));
__device__ __forceinline__ unsigned cvtpk(float lo, float hi) { const f32x2 v = {lo, hi}; return __builtin_bit_cast(unsigned, __builtin_convertvector(v, bf16x2_t)); }
__device__ __forceinline__ bf16x8 pack_p(const f32x16& p, int s) {
    v4u w; w.x = cvtpk(p[8 * s + 0], p[8 * s + 1]); w.y = cvtpk(p[8 * s + 2], p[8 * s + 3]); w.z = cvtpk(p[8 * s + 4], p[8 * s + 5]); w.w = cvtpk(p[8 * s + 6], p[8 * s + 7]);
    return __builtin_bit_cast(bf16x8, w);
}
__device__ __forceinline__ int pi32(int r) { return (r & 0x13) | ((r & 4) << 1) | ((r & 8) >> 1); }
__device__ __forceinline__ float max3f(float a, float b, float c) { float r; asm("v_max3_f32 %0, %1, %2, %3" : "=v"(r) : "v"(a), "v"(b), "v"(c)); return r; }
__device__ __forceinline__ float max32(const f32x16& p, const f32x16& q) {
    float a = max3f(p[0], p[1], p[2]), b = max3f(p[3], p[4], p[5]), c = max3f(p[6], p[7], p[8]), d = max3f(p[9], p[10], p[11]);
    a = max3f(a, p[12], p[13]); b = max3f(b, p[14], p[15]); c = max3f(c, q[0], q[1]); d = max3f(d, q[2], q[3]);
    a = max3f(a, q[4], q[5]); b = max3f(b, q[6], q[7]); c = max3f(c, q[8], q[9]); d = max3f(d, q[10], q[11]);
    a = max3f(a, q[12], q[13]); b = max3f(b, q[14], q[15]); return max3f(max3f(a, b, c), d, d); }
__device__ __forceinline__ float max16(const f32x16& p) { float a = fmaxf(fmaxf(p[0], p[1]), fmaxf(p[2], p[3])), b = fmaxf(fmaxf(p[4], p[5]), fmaxf(p[6], p[7])), c = fmaxf(fmaxf(p[8], p[9]), fmaxf(p[10], p[11])), d = fmaxf(fmaxf(p[12], p[13]), fmaxf(p[14], p[15])); return fmaxf(fmaxf(a, b), fmaxf(c, d)); }
__device__ __forceinline__ float sum16(const f32x16& p) { return ((p[0] + p[1]) + (p[2] + p[3])) + ((p[4] + p[5]) + (p[6] + p[7])) + ((p[8] + p[9]) + (p[10] + p[11])) + ((p[12] + p[13]) + (p[14] + p[15])); }

namespace battn {
constexpr int NS = 6, SLOT = 16384, TAB_OFF = NS * SLOT;
__device__ __forceinline__ void unit(LAS unsigned char* lds, const bf16* __restrict__ Q, const bf16* __restrict__ Kp, const bf16* __restrict__ VT, const float* __restrict__ rel, bf16* mix, float* ssa, int b, int h, int u) {
    const int tid = threadIdx.x, lane = tid & 63, wave = __builtin_amdgcn_readfirstlane(tid >> 6), r32 = lane & 31, hh = lane >> 5, j = wave >> 1, qh = wave & 1, c0 = 4 * u;
    LAS float* tab = (LAS float*)(lds + TAB_OFF);
    const int tix = tid < RELW ? tid : RELW - 1; const float trel = rel[h * RELW + tix], tfar = rel[h * RELW + RELW - 1];
    const int lrow = tid >> 3, lchunk = (tid & 7) ^ ((lrow >> 1) & 7);
    const bf16* ksrc = Kp + ((size_t)b * SEQ + lrow) * 1024 + h * 64 + lchunk * 8;
    const bf16* vsrc = VT + (size_t)(h * 64 + lrow) * NTOK + (size_t)b * SEQ + lchunk * 8;
#define BA_LOAD(T) do { const int _sl = (((T) + 12) % NS) * SLOT + wave * 1024; const int _t = (T) < 0 ? 0 : (T); GLDS16(ksrc + (size_t)_t * 64 * 1024, lds + _sl); GLDS16(vsrc + (size_t)_t * 64, lds + _sl + 8192); } while (0)
    const size_t tok = (size_t)b * SEQ + (c0 + j) * 64 + 32 * qh + r32;
    bf16x8 qf[4];
#pragma unroll
    for (int d0 = 0; d0 < 4; ++d0) qf[d0] = *(const bf16x8*)(Q + tok * 1024 + h * 64 + 16 * d0 + 8 * hh);
#pragma unroll
    for (int T = c0 - 8; T < c0 - 3; ++T) BA_LOAD(T);
    if (tid < 320) tab[tid] = (trel - tfar) * LOG2E;
    asm volatile("s_waitcnt vmcnt(2) lgkmcnt(0)" ::: "memory"); __builtin_amdgcn_s_barrier(); asm volatile("" ::: "memory");
    float mrun = 0.f; f32x16 o0 = {}, o1 = {}, o2 = {}; bool first = true;
    f32x16 cfarv;
    const bf16x8 onesf = (r32 == 0) ? (bf16x8){0x3f80, 0x3f80, 0x3f80, 0x3f80, 0x3f80, 0x3f80, 0x3f80, 0x3f80} : (bf16x8){0, 0, 0, 0, 0, 0, 0, 0};
    constexpr float THR = 8.0f;
    const float cfar = rel[h * RELW + RELW - 1] * LOG2E;
#pragma unroll
    for (int r = 0; r < 16; ++r) cfarv[r] = cfar;
    const int k0r = pi32(r32), ks0 = (k0r >> 1) & 7, vs0 = (r32 >> 1) & 7;
    unsigned kof[4], vof[4];
#pragma unroll
    for (int d0 = 0; d0 < 4; ++d0) { kof[d0] = (unsigned)(k0r * 128 + (((2 * d0 + hh) ^ ks0) << 4)); vof[d0] = (unsigned)(8192 + r32 * 128 + (((2 * d0 + hh) ^ vs0) << 4)); asm volatile("" : "+v"(kof[d0]), "+v"(vof[d0])); }
#pragma unroll 1
    for (int s = 0; s < 9; ++s) {
        if (s < 7) BA_LOAD(c0 - 3 + s);
        const int T = c0 + j - 8 + s;
        if (T >= 0) {
            unsigned sbo = (unsigned)(((T + 12) % NS) * SLOT); asm volatile("" : "+s"(sbo));
            const int dj = 8 - s;
            bf16x8 kf0[4], kf1[4], vf0[4], vf1[4];
#pragma unroll
            for (int d0 = 0; d0 < 4; ++d0) { const LAS unsigned char* kp_ = lds + (kof[d0] + sbo); kf0[d0] = *(const LAS bf16x8*)kp_; kf1[d0] = *(const LAS bf16x8*)(kp_ + 4096); }
#pragma unroll
            for (int d0 = 0; d0 < 4; ++d0) { const LAS unsigned char* vp_ = lds + (vof[d0] + sbo); vf0[d0] = *(const LAS bf16x8*)vp_; vf1[d0] = *(const LAS bf16x8*)(vp_ + 4096); }
            f32x16 p0 = MFMA32(kf0[0], qf[0], cfarv), p1 = MFMA32(kf1[0], qf[0], cfarv);
#pragma unroll
            for (int d0 = 1; d0 < 4; ++d0) { p0 = MFMA32(kf0[d0], qf[d0], p0); p1 = MFMA32(kf1[d0], qf[d0], p1); }
            if (dj < 3) { const LAS float* tb = tab + (64 * dj + 32 * qh + r32 + 128 - 8 * hh - 55); asm volatile("" : "+v"(tb));
#pragma unroll
                for (int r = 0; r < 16; ++r) { p0[r] += tb[55 - (16 * (r >> 3) + (r & 7))]; p1[r] += tb[23 - (16 * (r >> 3) + (r & 7))]; } }
            asm volatile("s_nop 15\n\ts_nop 7" : "+v"(p0), "+v"(p1));
            float mx = max32(p0, p1); mx = fmaxf(mx, __shfl_xor(mx, 32));
            if (first || __any(mx > THR)) {
                const float dl = first ? mx : fmaxf(mx, 0.f); mrun += dl;
                const float corr = first ? 1.0f : __builtin_amdgcn_exp2f(-dl); first = false;
#pragma unroll
                for (int r = 0; r < 16; ++r) { p0[r] -= dl; p1[r] -= dl; o0[r] *= corr; o1[r] *= corr; cfarv[r] = cfar - mrun; }
                o2[0] *= corr; }
#pragma unroll
            for (int r = 0; r < 16; ++r) { p0[r] = __builtin_amdgcn_exp2f(p0[r]); p1[r] = __builtin_amdgcn_exp2f(p1[r]); }
            const bf16x8 pf00 = pack_p(p0, 0), pf01 = pack_p(p0, 1), pf10 = pack_p(p1, 0), pf11 = pack_p(p1, 1);
#define BA_V(c, hi) ((hi) ? vf1[c] : vf0[c])
            o0 = MFMA32(BA_V(0, 0), pf00, o0); o0 = MFMA32(BA_V(1, 0), pf01, o0); o0 = MFMA32(BA_V(2, 0), pf10, o0); o0 = MFMA32(BA_V(3, 0), pf11, o0);
            o1 = MFMA32(BA_V(0, 1), pf00, o1); o1 = MFMA32(BA_V(1, 1), pf01, o1); o1 = MFMA32(BA_V(2, 1), pf10, o1); o1 = MFMA32(BA_V(3, 1), pf11, o1);
            o2 = MFMA32(onesf, pf00, o2); o2 = MFMA32(onesf, pf01, o2); o2 = MFMA32(onesf, pf10, o2); o2 = MFMA32(onesf, pf11, o2);
#undef BA_V
        }
        if (s < 7) asm volatile("s_waitcnt vmcnt(2) lgkmcnt(0)" ::: "memory"); else asm volatile("s_waitcnt vmcnt(0) lgkmcnt(0)" ::: "memory");
        __builtin_amdgcn_s_barrier(); asm volatile("" ::: "memory");
    }
#undef BA_LOAD
    const float lden = hh == 0 ? o2[0] : 0.f;
    const float inv = 1.0f / (lden + __shfl_xor(lden, 32)); float ss = 0.f;
#pragma unroll
    for (int r = 0; r < 16; ++r) { o0[r] *= inv; o1[r] *= inv; ss += o0[r] * o0[r] + o1[r] * o1[r]; }
    ss += __shfl_xor(ss, 32); if (hh == 0) ssa[tok * 16 + h] = ss;
    bf16* op = mix + tok * DM + h * 64 + 4 * hh;
#pragma unroll
    for (int g = 0; g < 4; ++g) { v2u w; w.x = pg8::cvt_pk_bf16(o0[4 * g], o0[4 * g + 1]); w.y = pg8::cvt_pk_bf16(o0[4 * g + 2], o0[4 * g + 3]); *(v2u*)(op + 8 * g) = w;
        w.x = pg8::cvt_pk_bf16(o1[4 * g], o1[4 * g + 1]); w.y = pg8::cvt_pk_bf16(o1[4 * g + 2], o1[4 * g + 3]); *(v2u*)(op + 32 + 8 * g) = w; }
}
}

namespace xattn {
__device__ __forceinline__ void unit(LAS unsigned char* lds, const bf16* __restrict__ CQ, const bf16* __restrict__ CK, const bf16* __restrict__ CVT, bf16* ox, int b, int h, int qb, bool reload) {
    const int tid = threadIdx.x, lane = tid & 63, wave = __builtin_amdgcn_readfirstlane(tid >> 6), r32 = lane & 31, hh = lane >> 5;
    if (reload) {
#pragma unroll
        for (int i = 0; i < 8; ++i) { const int idx = i * 512 + tid;
            const int kr = idx >> 4, kc = (idx & 15) ^ (kr & 15); GLDS16(CK + ((size_t)b * MEML + kr) * XW + h * XHD + kc * 8, lds + i * 8192 + wave * 1024);
            const int vr = idx >> 5, vc = (idx & 31) ^ (vr & 15); GLDS16(CVT + (size_t)(h * XHD + vr) * NMEM + (size_t)b * MEML + vc * 8, lds + 65536 + i * 8192 + wave * 1024); }
    }
    const size_t tok = (size_t)b * SEQ + qb * 256 + wave * 32 + r32;
    bf16x8 qf[8];
#pragma unroll
    for (int d0 = 0; d0 < 8; ++d0) qf[d0] = *(const bf16x8*)(CQ + tok * XW + h * XHD + 16 * d0 + 8 * hh);
    asm volatile("s_waitcnt vmcnt(0)" ::: "memory"); __builtin_amdgcn_s_barrier(); asm volatile("" ::: "memory");
    float mrun = -1e30f, lsum = 0.f; f32x16 o[4] = {};
    const int kp = pi32(r32);
    unsigned xkof[8];
#pragma unroll
    for (int d0 = 0; d0 < 8; ++d0) { xkof[d0] = (unsigned)(kp * 256 + (((2 * d0 + hh) ^ (kp & 15)) << 4)); asm volatile("" : "+v"(xkof[d0])); }
#pragma unroll 1
    for (int s = 0; s < 4; ++s) {
        f32x16 p0 = {}, p1 = {};
        unsigned so = (unsigned)(s * 16384); asm volatile("" : "+s"(so));
        bf16x8 kf0[8], kf1[8];
#pragma unroll
        for (int d0 = 0; d0 < 8; ++d0) { const LAS unsigned char* kp_ = lds + (xkof[d0] + so); kf0[d0] = *(const LAS bf16x8*)kp_; kf1[d0] = *(const LAS bf16x8*)(kp_ + 8192); }
#pragma unroll
        for (int d0 = 0; d0 < 8; ++d0) { p0 = MFMA32(kf0[d0], qf[d0], p0); p1 = MFMA32(kf1[d0], qf[d0], p1); }
        asm volatile("s_nop 15\n\ts_nop 7" : "+v"(p0), "+v"(p1));
        float mx = max32(p0, p1); mx = fmaxf(mx, __shfl_xor(mx, 32));
        const float mnew = fmaxf(mrun, mx), corr = __builtin_amdgcn_exp2f(mrun - mnew); mrun = mnew;
#pragma unroll
        for (int r = 0; r < 16; ++r) { p0[r] = __builtin_amdgcn_exp2f(p0[r] - mnew); p1[r] = __builtin_amdgcn_exp2f(p1[r] - mnew); }
        lsum = lsum * corr + (sum16(p0) + sum16(p1));
        const bf16x8 pf00 = pack_p(p0, 0), pf01 = pack_p(p0, 1), pf10 = pack_p(p1, 0), pf11 = pack_p(p1, 1);
#pragma unroll
        for (int dh = 0; dh < 4; ++dh) { const int vr = 32 * dh + r32; const LAS unsigned char* vb = lds + 65536 + vr * 512;
#pragma unroll
            for (int r = 0; r < 16; ++r) o[dh][r] *= corr;
#define XA_V(c) (*(const LAS bf16x8*)(vb + ((((8 * s + (c) + hh)) ^ (vr & 15)) << 4)))
            o[dh] = MFMA32(XA_V(0), pf00, o[dh]); o[dh] = MFMA32(XA_V(2), pf01, o[dh]); o[dh] = MFMA32(XA_V(4), pf10, o[dh]); o[dh] = MFMA32(XA_V(6), pf11, o[dh]);
#undef XA_V
        }
    }
    const float inv = 1.0f / (lsum + __shfl_xor(lsum, 32));
    bf16* op = ox + tok * XW + h * XHD + 4 * hh;
#pragma unroll
    for (int dh = 0; dh < 4; ++dh)
#pragma unroll
        for (int g = 0; g < 4; ++g) { v2u w; w.x = pg8::cvt_pk_bf16(o[dh][4 * g] * inv, o[dh][4 * g + 1] * inv); w.y = pg8::cvt_pk_bf16(o[dh][4 * g + 2] * inv, o[dh][4 * g + 3] * inv); *(v2u*)(op + 32 * dh + 8 * g) = w; }
    asm volatile("s_waitcnt lgkmcnt(0)" ::: "memory"); __builtin_amdgcn_s_barrier(); asm volatile("" ::: "memory");
}
}

namespace lru {
constexpr int XA_P = 272, XA_OFF = 0, XF_OFF = 64 * XA_P, SA_OFF = XF_OFF + 64 * 64 * 4, SB_OFF = SA_OFF + 64 * 68 * 4, SC_OFF = SB_OFF + 64 * 68 * 4, HS_OFF = SC_OFF + 8 * 64 * 8, END_OFF = HS_OFF + 256;
__device__ __forceinline__ float fsig(float x) { return __builtin_amdgcn_rcpf(1.0f + __builtin_amdgcn_exp2f(-LOG2E * x)); }
__device__ __forceinline__ void unit(LAS unsigned char* lds, const bf16* __restrict__ xr, const bf16* __restrict__ yg, const float* __restrict__ conv_w, const float* __restrict__ conv_b, const bf16* __restrict__ wga_t, const bf16* __restrict__ wgx_t,
                                     const float* __restrict__ b_ga, const float* __restrict__ b_gx, const float* __restrict__ lam, bf16* mix, float* ssl, int b, int g) {
    const int tid = threadIdx.x, lane = tid & 63, wave = __builtin_amdgcn_readfirstlane(tid >> 6), n = g >> 1, hf = g & 1;
    LAS float* XF = (LAS float*)(lds + XF_OFF); LAS float* SA = (LAS float*)(lds + SA_OFF); LAS float* SB = (LAS float*)(lds + SB_OFF); LAS f32x2* SC = (LAS f32x2*)(lds + SC_OFF); LAS float* HS = (LAS float*)(lds + HS_OFF);
    if (tid < 64) HS[tid] = 0.f;
    const int tb = wave & 3, dq = wave >> 2, l15 = lane & 15, l4 = lane >> 4;
    bf16x8 wf[2][2][4];
#pragma unroll
    for (int dt = 0; dt < 2; ++dt)
#pragma unroll
        for (int ks = 0; ks < 4; ++ks) { const size_t off = (size_t)(n * 128 + hf * 64 + dq * 32 + 16 * dt + l15) * 128 + 32 * ks + 8 * l4;
            wf[0][dt][ks] = *(const bf16x8*)(wga_t + off); wf[1][dt][ks] = *(const bf16x8*)(wgx_t + off); }
    float cba[2][4], cbx[2][4], csp[2][4];
#pragma unroll
    for (int dt = 0; dt < 2; ++dt)
#pragma unroll
        for (int r = 0; r < 4; ++r) { const int c = n * 128 + hf * 64 + dq * 32 + 16 * dt + 4 * l4 + r; cba[dt][r] = -LOG2E * b_ga[c]; cbx[dt][r] = -LOG2E * b_gx[c]; csp[dt][r] = LOG2E * (-8.0f * log1pf(__expf(-lam[c]))); }
    float cw0[4], cw1[4];
#pragma unroll
    for (int jj = 0; jj < 4; ++jj) { cw0[jj] = conv_w[jj * LW + n * 128 + 2 * lane]; cw1[jj] = conv_w[jj * LW + n * 128 + 2 * lane + 1]; }
    const float cb0 = conv_b[n * 128 + 2 * lane], cb1 = conv_b[n * 128 + 2 * lane + 1];
#define LRU_UNI(p) ({ const unsigned long long _p = (unsigned long long)(p); (GAS char*)(((unsigned long long)(unsigned)__builtin_amdgcn_readfirstlane((int)(_p >> 32)) << 32) | (unsigned)__builtin_amdgcn_readfirstlane((int)_p)); })
#define LRU_VO(v) ({ unsigned _v = (v); asm volatile("" : "+v"(_v)); _v; })
#define LRU_SP(p) ({ GAS char* _q = (GAS char*)(p); asm volatile("" : "+s"(_q)); _q; })
    const GAS char* xru = LRU_UNI(xr + ((size_t)b * SEQ + 8 * wave) * 1024 + n * 128);
    const unsigned lo4 = 4u * (unsigned)lane, lo2 = 2u * (unsigned)lane;
    const int cc = lane, sg = wave;
    const GAS char* ygu = LRU_UNI(yg + ((size_t)b * SEQ + 8 * sg) * 1024 + n * 128 + hf * 64);
    GAS char* outu = LRU_UNI(mix + ((size_t)b * SEQ + 8 * sg) * DM + 1024 + n * 128 + hf * 64);
    unsigned xq[11]; bf16 yv[8];
#define LRU_LOADX(t0) do { _Pragma("unroll") for (int k = 0; k < 11; ++k) { const int trow = (t0) + 8 * wave - 3 + k; xq[k] = trow >= 0 ? *(const GAS unsigned*)(LRU_SP(xru + ((ptrdiff_t)((t0) - 3 + k)) * 2048) + LRU_VO(lo4)) : 0u; } \
        _Pragma("unroll") for (int i = 0; i < 8; ++i) yv[i] = *(const GAS bf16*)(LRU_SP(ygu + ((size_t)(t0) + i) * 2048) + LRU_VO(lo2)); } while (0)
    LRU_LOADX(0);
    asm volatile("s_waitcnt lgkmcnt(0)" ::: "memory"); __builtin_amdgcn_s_barrier(); asm volatile("" ::: "memory");
#pragma unroll 1
    for (int t0 = 0; t0 < SEQ; t0 += 64) {
        { f32x2 xe[11];
#pragma unroll
          for (int k = 0; k < 11; ++k) xe[k] = (f32x2){__uint_as_float(xq[k] << 16), __uint_as_float(xq[k] & 0xffff0000u)};
#pragma unroll
          for (int i = 0; i < 8; ++i) { f32x2 xc2 = (f32x2){cb0, cb1};
#pragma unroll
            for (int jj = 0; jj < 4; ++jj) xc2 += (f32x2){cw0[jj], cw1[jj]} * xe[i + jj];
            *(LAS unsigned*)(lds + XA_OFF + (8 * wave + i) * XA_P + 4 * lane) = cvtpk(xc2.x, xc2.y);
            if ((lane >> 5) == hf) *(LAS f32x2*)(XF + (8 * wave + i) * 64 + 2 * (lane & 31)) = xc2; } }
        bf16 ycur[8];
#pragma unroll
        for (int i = 0; i < 8; ++i) ycur[i] = yv[i];
        if (t0 + 64 < SEQ) LRU_LOADX(t0 + 64);
        asm volatile("s_waitcnt lgkmcnt(0)" ::: "memory"); __builtin_amdgcn_s_barrier(); asm volatile("" ::: "memory");
        {
            f32x4 ar[2] = {}, ai[2] = {};
#pragma unroll
            for (int ks = 0; ks < 4; ++ks) { const bf16x8 xfr = *(const LAS bf16x8*)(lds + XA_OFF + (16 * tb + l15) * XA_P + 64 * ks + 16 * l4);
#pragma unroll
                for (int dt = 0; dt < 2; ++dt) { ar[dt] = MFMA16(wf[0][dt][ks], xfr, ar[dt]); ai[dt] = MFMA16(wf[1][dt][ks], xfr, ai[dt]); } }
            const int tk = 16 * tb + l15;
#pragma unroll
            for (int dt = 0; dt < 2; ++dt) { const int dl = dq * 32 + 16 * dt + 4 * l4; const f32x4 xo = *(const LAS f32x4*)(XF + tk * 64 + dl); f32x4 av, bv;
#pragma unroll
                for (int r = 0; r < 4; ++r) { const float rg = __builtin_amdgcn_rcpf(1.0f + __builtin_amdgcn_exp2f(fmaf(ar[dt][r], -LOG2E, cba[dt][r]))), ig = __builtin_amdgcn_rcpf(1.0f + __builtin_amdgcn_exp2f(fmaf(ai[dt][r], -LOG2E, cbx[dt][r])));
                    const float a_ = __builtin_amdgcn_exp2f(rg * csp[dt][r]); av[r] = a_;
                    bv[r] = __builtin_amdgcn_sqrtf(fmaxf(1.0f - a_ * a_, 0.f)) * (ig * xo[r]); }
                *(LAS f32x4*)(SA + tk * 68 + dl) = av; *(LAS f32x4*)(SB + tk * 68 + dl) = bv; }
        }
        asm volatile("s_waitcnt lgkmcnt(0)" ::: "memory"); __builtin_amdgcn_s_barrier(); asm volatile("" ::: "memory");
        float a8[8], b8[8];
        { float A = 1.f, B = 0.f;
#pragma unroll
            for (int i = 0; i < 8; ++i) { a8[i] = SA[(8 * sg + i) * 68 + cc]; b8[i] = SB[(8 * sg + i) * 68 + cc]; B = a8[i] * B + b8[i]; A *= a8[i]; }
            SC[sg * 64 + cc] = (f32x2){A, B}; }
        asm volatile("s_waitcnt lgkmcnt(0)" ::: "memory"); __builtin_amdgcn_s_barrier(); asm volatile("" ::: "memory");
        {
            float hcur = HS[cc];
#pragma unroll
            for (int s2 = 0; s2 < 7; ++s2) { const f32x2 ab = SC[s2 * 64 + cc]; if (s2 < sg) hcur = ab.x * hcur + ab.y; }
            float ysq[8];
#pragma unroll
            for (int i = 0; i < 8; ++i) { hcur = a8[i] * hcur + b8[i]; const float x = bf2f(ycur[i]);
                const float zg = x * fmaf(x * x, -LOG2E * 1.5957691216f * 0.044715f, -LOG2E * 1.5957691216f);
                const float y = hcur * (x * __builtin_amdgcn_rcpf(1.0f + __builtin_amdgcn_exp2f(zg))); *(GAS bf16*)(LRU_SP(outu + ((size_t)t0 + i) * (DM * 2)) + LRU_VO(lo2)) = (bf16)(cvtpk(y, 0.f) & 0xffffu); ysq[i] = y * y; }
            float rs2[2];
            { float a4[4];
#pragma unroll
              for (int p2 = 0; p2 < 4; ++p2) { auto s_ = __builtin_amdgcn_permlane32_swap(__float_as_uint(ysq[2 * p2]), __float_as_uint(ysq[2 * p2 + 1]), false, false); a4[p2] = __uint_as_float(s_[0]) + __uint_as_float(s_[1]); }
#pragma unroll
              for (int q2 = 0; q2 < 2; ++q2) { auto s_ = __builtin_amdgcn_permlane16_swap(__float_as_uint(a4[2 * q2]), __float_as_uint(a4[2 * q2 + 1]), false, false); float v = __uint_as_float(s_[0]) + __uint_as_float(s_[1]);
                v += __builtin_bit_cast(float, __builtin_amdgcn_mov_dpp(__builtin_bit_cast(int, v), 0xB1, 0xf, 0xf, true));
                v += __builtin_bit_cast(float, __builtin_amdgcn_mov_dpp(__builtin_bit_cast(int, v), 0x4E, 0xf, 0xf, true));
                v += __builtin_bit_cast(float, __builtin_amdgcn_mov_dpp(__builtin_bit_cast(int, v), 0x141, 0xf, 0xf, true));
                v += __builtin_bit_cast(float, __builtin_amdgcn_mov_dpp(__builtin_bit_cast(int, v), 0x140, 0xf, 0xf, true));
                rs2[q2] = v; } }
            if ((lane & 15) == 15) { const int rho = lane >> 4, pv = ((rho & 1) << 1) | (rho >> 1); float* sp = ssl + ((size_t)b * SEQ + t0 + 8 * sg + pv) * 16 + g; sp[0] = rs2[0]; sp[64] = rs2[1]; }
            asm volatile("s_waitcnt lgkmcnt(0)" ::: "memory"); __builtin_amdgcn_s_barrier(); asm volatile("" ::: "memory");
            if (sg == 7) HS[cc] = hcur;
        }
    }
#undef LRU_LOADX
#undef LRU_VO
#undef LRU_SP
#undef LRU_UNI
    asm volatile("s_waitcnt vmcnt(0) lgkmcnt(0)" ::: "memory"); __builtin_amdgcn_s_barrier(); asm volatile("" ::: "memory");
}
}

constexpr int NWAVES = 8, NPHASE = 12;
constexpr int RING_BYTES = 131072, LDSCTL_OFF = RING_BYTES, MISC_OFF = LDSCTL_OFF + 320, LDS_BYTES = 147456;
#define LDS_WAIT() asm volatile("s_waitcnt lgkmcnt(0)" ::: "memory")
#define VM_WAIT() asm volatile("s_waitcnt vmcnt(0)" ::: "memory")

struct TrItem { const float* W; const float* gain; unsigned char* WT; int N, K, k0, n0, drow0, is8; };
__device__ __forceinline__ void tr_load(const TrItem& d, f32x4 (&v)[16], int lane) {
    const int g = lane & 7, r0 = lane >> 3;
#pragma unroll
    for (int i = 0; i < 8; ++i) v[i] = __builtin_nontemporal_load((const GAS f32x4*)(d.W + (size_t)(d.k0 + r0 + 8 * i) * d.N + d.n0 + 4 * g));
    if (d.is8) {
#pragma unroll
        for (int i = 8; i < 16; ++i) v[i] = __builtin_nontemporal_load((const GAS f32x4*)(d.W + (size_t)(d.k0 + r0 + 8 * i) * d.N + d.n0 + 4 * g)); }
}
__device__ __forceinline__ void tr_finish(const TrItem& d, const f32x4 (&v)[16], LAS float* scr, int lane_) {
    int lane = lane_; asm volatile("" : "+v"(lane));
    const int c = lane & 7;
    if (d.is8) {
        { const int g = lane & 7, r0 = lane >> 3;
#pragma unroll
          for (int i = 0; i < 16; ++i) { const float gs = (d.gain ? d.gain[d.k0 + r0 + 8 * i] : 1.0f) * W8_SCALE; *(LAS f32x4*)(scr + (r0 + 8 * i) * 32 + ((g ^ (i >> 1)) << 2)) = v[i] * gs;
              if ((i & 3) == 3) asm volatile("" ::: "memory"); } }
        LDS_WAIT(); asm volatile("" ::: "memory");
#pragma unroll
        for (int j = 0; j < 4; ++j) { const int n = (lane >> 3) + 8 * j; const LAS float* s = scr + (16 * c) * 32 + ((((n >> 2) ^ c) << 2) + (n & 3));
            v4u o; o.x = pk4_fp8(s[0 * 32], s[1 * 32], s[2 * 32], s[3 * 32]); o.y = pk4_fp8(s[4 * 32], s[5 * 32], s[6 * 32], s[7 * 32]); o.z = pk4_fp8(s[8 * 32], s[9 * 32], s[10 * 32], s[11 * 32]); o.w = pk4_fp8(s[12 * 32], s[13 * 32], s[14 * 32], s[15 * 32]);
            __builtin_nontemporal_store(o, (GAS v4u*)(d.WT + (size_t)(d.drow0 + n) * d.K + d.k0 + 16 * c)); }
    } else {
        { const int g = lane & 7, r0 = lane >> 3;
#pragma unroll
          for (int i = 0; i < 8; ++i) *(LAS f32x4*)(scr + (r0 + 8 * i) * 32 + ((g ^ i) << 2)) = v[i]; }
        LDS_WAIT(); asm volatile("" ::: "memory");
        float g[8];
#pragma unroll
        for (int j = 0; j < 8; ++j) g[j] = d.gain ? d.gain[d.k0 + 8 * c + j] : 1.0f;
#pragma unroll
        for (int j = 0; j < 4; ++j) { const int n = (lane >> 3) + 8 * j; const LAS float* s = scr + (8 * c) * 32 + ((((n >> 2) ^ c) << 2) + (n & 3));
            v4u o; o.x = pk2(s[0 * 32] * g[0], s[1 * 32] * g[1]); o.y = pk2(s[2 * 32] * g[2], s[3 * 32] * g[3]); o.z = pk2(s[4 * 32] * g[4], s[5 * 32] * g[5]); o.w = pk2(s[6 * 32] * g[6], s[7 * 32] * g[7]);
            *(GAS v4u*)(d.WT + ((size_t)(d.drow0 + n) * d.K + d.k0 + 8 * c) * 2) = o; }
    }
    LDS_WAIT(); asm volatile("" ::: "memory");
}
__device__ __forceinline__ void row_to_bf16(const float* xrow, bf16* orow, float* ss, int lane) {
    const GAS f32x4* xr = (const GAS f32x4*)xrow + lane; float s = 0.f;
    GAS v2u* o8 = (GAS v2u*)orow + lane;
#pragma unroll
    for (int j = 0; j < 8; ++j) { const f32x4 v = xr[64 * j]; s += (v.x * v.x + v.y * v.y) + (v.z * v.z + v.w * v.w); v2u w; w.x = pk2(v.x, v.y); w.y = pk2(v.z, v.w); o8[64 * j] = w; }
    s = wave_sum(s); if (lane == 0) *ss = s;
}
constexpr int P0_I_IN = 32 * 160, P0_I_OUT = 32 * 64, P0_I_CQ = 32 * 16, P0_I_CKV = 32 * 32, P0_I_CO = 8 * 64, P0_I_G = 8 * 2 * 4, P0_I_GU = 32 * 16 * 128, P0_I_DN = 32 * 16 * 64;
constexpr int P0_NONMOE = P0_I_IN + P0_I_OUT + P0_I_CQ + P0_I_CKV + P0_I_CO + 2 * P0_I_G, P0_NITEMS = P0_NONMOE + P0_I_GU + P0_I_DN;
__device__ __forceinline__ void p0_rows(const P& p, int gw, int NGW, int lane) {
    unsigned char* ws = p.ws;
    for (int m = gw; m < NTOK; m += NGW) row_to_bf16(p.x + (size_t)m * DM, (bf16*)(ws + WS_XB) + (size_t)m * DM, (float*)(ws + WS_SS0) + m, lane);
    for (int m = gw; m < NMEM; m += NGW) row_to_bf16(p.mem + (size_t)m * DM, (bf16*)(ws + WS_MEMB) + (size_t)m * DM, (float*)(ws + WS_SSM) + m, lane);
    for (int i = gw * 64 + lane; i < NE * DM; i += NGW * 64) { const int e = i >> 11, k = i & 2047; ((float*)(ws + WS_W_R))[i] = p.g_ffn[k] * p.w_r[k * NE + e]; }
}
__device__ __forceinline__ void p0_items(const P& p, LAS unsigned char* lds, int first, int last, int gw, int NGW, int wave, int lane) {
    LAS float* scr = (LAS float*)(lds + wave * 16384);
    unsigned char* ws = p.ws;
    constexpr int I_IN = P0_I_IN, I_OUT = P0_I_OUT, I_CQ = P0_I_CQ, I_CKV = P0_I_CKV, I_CO = P0_I_CO, I_G = P0_I_G, I_GU = P0_I_GU;
#define P0_DESC(d, it) do { int r = (it); \
        if (r < I_IN)  { const int kb = r / 160, nb = r % 160; d = TrItem{p.w_in, p.g_mix, ws + WS_W_IN, 5120, DM, kb * 64, nb * 32, nb * 32, 0}; break; } r -= I_IN; \
        if (r < I_OUT) { const int kb = r / 64, nb = r % 64; d = TrItem{p.w_out, kb < 16 ? p.g_att : p.g_lru - 1024, ws + WS_W_OUT, DM, DM, kb * 64, nb * 32, nb * 32, 0}; break; } r -= I_OUT; \
        if (r < I_CQ)  { const int kb = r / 16, nb = r % 16; d = TrItem{p.w_cq, p.g_cross, ws + WS_W_CQ, XW, DM, kb * 64, nb * 32, nb * 32, 0}; break; } r -= I_CQ; \
        if (r < I_CKV) { const int kb = r / 32, nb = r % 32; d = TrItem{p.w_ckv, p.g_mem, ws + WS_W_CKV, 2 * XW, DM, kb * 64, nb * 32, nb * 32, 0}; break; } r -= I_CKV; \
        if (r < I_CO)  { const int kb = r / 64, nb = r % 64; d = TrItem{p.w_co, nullptr, ws + WS_W_CO, DM, XW, kb * 64, nb * 32, nb * 32, 0}; break; } r -= I_CO; \
        if (r < I_G)   { const int n = r >> 3, kb = (r >> 2) & 1, nb = r & 3; d = TrItem{p.w_ga + n * 16384, nullptr, ws + WS_W_GA + n * 32768, LBW, LBW, kb * 64, nb * 32, nb * 32, 0}; break; } r -= I_G; \
        if (r < I_G)   { const int n = r >> 3, kb = (r >> 2) & 1, nb = r & 3; d = TrItem{p.w_gx + n * 16384, nullptr, ws + WS_W_GX + n * 32768, LBW, LBW, kb * 64, nb * 32, nb * 32, 0}; break; } r -= I_G; \
        if (r < I_GU)  { const int e = r >> 11, q = r & 2047, kb = q >> 7, nb = q & 127, n0 = nb * 32; const int c = n0 & 2047, up = n0 >> 11; \
                         d = TrItem{p.w_gu + (size_t)e * DM * 4096, p.g_ffn, ws + WS_W_GU + (size_t)e * 4096 * DM, 4096, DM, kb * 128, n0, 256 * (c >> 7) + (c & 127) + 128 * up, 1}; break; } r -= I_GU; \
        { const int e = r >> 10, q = r & 1023, kb = q >> 6, nb = q & 63; d = TrItem{p.w_dn + (size_t)e * DFF * DM, nullptr, ws + WS_W_DN + (size_t)e * DM * DFF, DM, DFF, kb * 128, nb * 32, nb * 32, 1}; } } while (0)
    const int it0 = first + gw, st = NGW;
    if (it0 < last) {
        TrItem d0, d1, d2; f32x4 v0[16], v1[16], v2[16];
        P0_DESC(d0, it0); tr_load(d0, v0, lane); d1 = d0; d2 = d0;
        if (it0 + st < last) { P0_DESC(d1, it0 + st); tr_load(d1, v1, lane); }
        for (int it = it0; it < last; it += 3 * st) {
            if (it + 2 * st < last) { P0_DESC(d2, it + 2 * st); tr_load(d2, v2, lane); }
            tr_finish(d0, v0, scr, lane);
            if (it + st >= last) break;
            if (it + 3 * st < last) { P0_DESC(d0, it + 3 * st); tr_load(d0, v0, lane); }
            tr_finish(d1, v1, scr, lane);
            if (it + 2 * st >= last) break;
            if (it + 4 * st < last) { P0_DESC(d1, it + 4 * st); tr_load(d1, v1, lane); }
            tr_finish(d2, v2, scr, lane);
        }
    }
#undef P0_DESC
}
__device__ __forceinline__ void p3_scales(const P& p, int gtid, int NT) {
    const float* ssa = (const float*)(p.ws + WS_SSA); const float* ssl = (const float*)(p.ws + WS_SSL); float* scl = (float*)(p.ws + WS_SCL);
    for (int m = gtid; m < NTOK; m += NT) { float a = 0.f, l = 0.f;
#pragma unroll
        for (int i = 0; i < 16; ++i) { a += ssa[(size_t)m * 16 + i]; l += ssl[(size_t)m * 16 + i]; }
        const float ra = rsqrtf(a * (1.0f / AW) + EPS), rl = rsqrtf(l * (1.0f / LW) + EPS);
        scl[2 * m] = ra / rl; scl[2 * m + 1] = rl; }
}
__device__ __forceinline__ void p8_router(const P& p, LAS unsigned char* lds, int bx, int G, int tid, int lane, int wave) {
    const float* wrt = (const float*)(p.ws + WS_W_R); const bf16* x2 = (const bf16*)(p.ws + WS_X2H);
    int* cnt = (int*)(p.ws + WS_CTL) + CW_CNT; int* list = (int*)(p.ws + WS_LIST);
    int* tope = (int*)(p.ws + WS_TOPE); float* topg = (float*)(p.ws + WS_TOPG); int* tpos = (int*)(p.ws + WS_TPOS); float* r2 = (float*)(p.ws + WS_R2);
    LAS int* lcnt = (LAS int*)lds; LAS int* lbase = lcnt + 32;
    const int r32 = lane & 31, hh = lane >> 5;
    for (int tb = bx; tb < NTOK / 128; tb += G) {
        if (tid < 64) lcnt[tid] = 0;
        __syncthreads();
        const int t = tb * 128 + (wave & 3) * 32 + r32;
        float tv[4]; int te[4], posl[4]; float rr = 0.f, g0 = 0.f, g1 = 0.f, g2 = 0.f, g3 = 0.f;
        f32x16 acc = {}; float ss = 0.f;
        {
            const GAS v4u* xp = (const GAS v4u*)(x2 + (size_t)t * DM + 16 * hh);
            const GAS f32x4* wp = (const GAS f32x4*)(wrt + (size_t)r32 * DM + 16 * hh);
            f32x4 xa[4], wa[4], xb[4], wb[4]; const int m0 = (wave >> 2) * 32;
#define RT_LOAD(X, W, m) do { const v4u w0_ = xp[4 * (m)], w1_ = xp[4 * (m) + 1]; \
        X[0] = (f32x4){__uint_as_float(w0_.x << 16), __uint_as_float(w0_.x & 0xffff0000u), __uint_as_float(w0_.y << 16), __uint_as_float(w0_.y & 0xffff0000u)}; \
        X[1] = (f32x4){__uint_as_float(w0_.z << 16), __uint_as_float(w0_.z & 0xffff0000u), __uint_as_float(w0_.w << 16), __uint_as_float(w0_.w & 0xffff0000u)}; \
        X[2] = (f32x4){__uint_as_float(w1_.x << 16), __uint_as_float(w1_.x & 0xffff0000u), __uint_as_float(w1_.y << 16), __uint_as_float(w1_.y & 0xffff0000u)}; \
        X[3] = (f32x4){__uint_as_float(w1_.z << 16), __uint_as_float(w1_.z & 0xffff0000u), __uint_as_float(w1_.w << 16), __uint_as_float(w1_.w & 0xffff0000u)}; \
        _Pragma("unroll") for (int q = 0; q < 4; ++q) W[q] = wp[8 * (m) + q]; } while (0)
#define RT_MMA(X, W) do { _Pragma("unroll") for (int q = 0; q < 4; ++q) _Pragma("unroll") for (int jj = 0; jj < 4; ++jj) { acc = __builtin_amdgcn_mfma_f32_32x32x2f32(W[q][jj], X[q][jj], acc, 0, 0, 0); ss += X[q][jj] * X[q][jj]; } } while (0)
            RT_LOAD(xa, wa, m0);
#pragma unroll 1
            for (int m = m0; m < m0 + 32; m += 2) {
                RT_LOAD(xb, wb, m + 1);
                RT_MMA(xa, wa);
                if (m + 2 < m0 + 32) RT_LOAD(xa, wa, m + 2);
                RT_MMA(xb, wb);
            }
#undef RT_LOAD
#undef RT_MMA
        }
        LAS float* part = (LAS float*)(lds + 1024);
        if (wave >= 4) {
#pragma unroll
            for (int r = 0; r < 16; ++r) part[((wave & 3) * 17 + r) * 64 + lane] = acc[r];
            part[((wave & 3) * 17 + 16) * 64 + lane] = ss; }
        __syncthreads();
        if (wave < 4) {
#pragma unroll
            for (int r = 0; r < 16; ++r) acc[r] += part[(wave * 17 + r) * 64 + lane];
            ss += part[(wave * 17 + 16) * 64 + lane];
            ss += __shfl_xor(ss, 32); rr = rsqrtf(ss * (1.0f / DM) + EPS);
            float l[16];
#pragma unroll
            for (int r = 0; r < 16; ++r) l[r] = acc[r] * rr + p.b_r[(r & 3) + 8 * (r >> 2) + 4 * hh];
#pragma unroll
            for (int k = 0; k < TOPK; ++k) { float bv = l[0]; int bi = 0;
#pragma unroll
                for (int r = 1; r < 16; ++r) if (l[r] > bv) { bv = l[r]; bi = r; }
                const int be = (bi & 3) + 8 * (bi >> 2) + 4 * hh; const float pv = __shfl_xor(bv, 32); const int pe = __shfl_xor(be, 32);
                const bool win = (bv > pv) || (bv == pv && be < pe);
                tv[k] = win ? bv : pv; te[k] = win ? be : pe;
#pragma unroll
                for (int r = 0; r < 16; ++r) l[r] = (win && r == bi) ? -INFINITY : l[r]; }
            const float e1 = __expf(tv[1] - tv[0]), e2 = __expf(tv[2] - tv[0]), e3 = __expf(tv[3] - tv[0]); const float inv = 1.0f / (1.0f + e1 + e2 + e3);
            g0 = inv; g1 = e1 * inv; g2 = e2 * inv; g3 = e3 * inv;
            if (hh == 0) {
#pragma unroll
                for (int k = 0; k < TOPK; ++k) posl[k] = __hip_atomic_fetch_add(&lcnt[te[k]], 1, __ATOMIC_RELAXED, __HIP_MEMORY_SCOPE_WORKGROUP); }
        }
        __syncthreads();
        if (tid < NE) lbase[tid] = atomicAdd(&cnt[tid], lcnt[tid]);
        __syncthreads();
        if (wave < 4 && hh == 0) {
#pragma unroll
            for (int k = 0; k < TOPK; ++k) { const int e = te[k], pos = lbase[e] + posl[k]; *(v2u*)(list + 2 * ((size_t)e * NTOK + pos)) = (v2u){(unsigned)t, __float_as_uint(rr)}; tope[t * 4 + k] = e; tpos[t * 4 + k] = pos; }
            *(f32x4*)(topg + (size_t)t * 4) = (f32x4){g0, g1, g2, g3}; r2[t] = rr;
        }
        __syncthreads();
    }
}
__device__ __forceinline__ void p11_combine(const P& p, int gw, int NGW, int lane, float oscale) {
    const int* cnt = (const int*)(p.ws + WS_CTL) + CW_CNT; const unsigned char* Y = (const unsigned char*)(p.ws + WS_Y);
    const int* tope = (const int*)(p.ws + WS_TOPE); const float* topg = (const float*)(p.ws + WS_TOPG); const int* tpos = (const int*)(p.ws + WS_TPOS);
    int pad = lane < NE ? ((cnt[lane & 31] + 255) >> 8) : 0; int inc = pad;
#pragma unroll
    for (int o = 1; o < 32; o <<= 1) { const int t = __shfl_up(inc, o); if ((lane & 31) >= o) inc += t; }
    const int toff_l = inc - pad;
    for (int m = gw; m < NTOK; m += NGW) {
        GAS f32x4* xr = (GAS f32x4*)(p.out + (size_t)m * DM) + lane;
        const GAS v2u* x2r = (const GAS v2u*)((const bf16*)(p.ws + WS_X2H) + (size_t)m * DM) + lane;
        f32x4 a[8];
#pragma unroll
        for (int j = 0; j < 8; ++j) { const v2u w = x2r[64 * j]; a[j] = (f32x4){__uint_as_float(w.x << 16), __uint_as_float(w.x & 0xffff0000u), __uint_as_float(w.y << 16), __uint_as_float(w.y & 0xffff0000u)}; }
#pragma unroll
        for (int k = 0; k < TOPK; ++k) { const int e = tope[m * 4 + k]; const float g = topg[m * 4 + k]; const int slot = 256 * __shfl(toff_l, e) + tpos[m * 4 + k];
            const GAS unsigned* yr = (const GAS unsigned*)(Y + (size_t)slot * DM) + lane;
#pragma unroll
            for (int j = 0; j < 8; ++j) { const int w = (int)yr[64 * j]; const f32x2 lo = __builtin_amdgcn_cvt_pk_f32_fp8(w, false), hi = __builtin_amdgcn_cvt_pk_f32_fp8(w, true);
                a[j].x += g * lo.x; a[j].y += g * lo.y; a[j].z += g * hi.x; a[j].w += g * hi.y; } }
        float ss = 0.f;
#pragma unroll
        for (int j = 0; j < 8; ++j) ss += (a[j].x * a[j].x + a[j].y * a[j].y) + (a[j].z * a[j].z + a[j].w * a[j].w);
        ss = wave_sum(ss); const float r = rsqrtf(ss * (1.0f / DM) + EPS) * oscale;
        const GAS f32x4* gf = (const GAS f32x4*)p.g_fin + lane;
#pragma unroll
        for (int j = 0; j < 8; ++j) { const f32x4 g = gf[64 * j]; xr[64 * j] = a[j] * r * g; }
    }
}

#ifndef FAST_MASK
#define FAST_MASK 0xFFFu
#endif
#ifndef STAG1
#define STAG1 0
#define STAG9 0
#define STAG10 0
#define STAG4 0
#define STAG7 0
#endif
#ifndef PROBE_PH
#define PROBE_PH (-1)
#define PROBE_US 2000.0f
#define PROBE_OFF 0.0f
#define PROBE_MB 0
#define PROBE_STEPS 4.0f
#define PROBE_CLK 0
#endif
#ifndef NHELP
#define NHELP 40
#define P0_SPLIT (P0_NONMOE + 62000)
#endif
#ifndef DUP_MASK
#define DUP_MASK 0u
#endif
#ifndef SUB2_MASK
#define SUB2_MASK 0x7u
#endif
__global__ void __launch_bounds__(NWAVES * 64, 2) fwd(P p) {
    extern __shared__ __attribute__((aligned(16))) unsigned char lds_raw[];
    LAS unsigned char* lds = (LAS unsigned char*)lds_raw;
    volatile LAS unsigned* MISC = (volatile LAS unsigned*)(lds + MISC_OFF);
    const int tid = threadIdx.x, lane = tid & 63, wave = __builtin_amdgcn_readfirstlane(tid >> 6);
    const int G = gridDim.x, bx = blockIdx.x; const int vcu = (G % 8 == 0) ? (bx % 8) * (G / 8) + bx / 8 : bx;
    const int gw = vcu * NWAVES + wave, NGW = G * NWAVES;
    for (int u = tid; u < (LDS_BYTES - LDSCTL_OFF) / 4; u += NWAVES * 64) ((LAS unsigned*)(lds + LDSCTL_OFF))[u] = 0u;
    __syncthreads();
    unsigned* ctl = (unsigned*)(p.ws + WS_CTL);
    const int lo = p.ph_lo, hi = p.ph_hi;
    XcdBarrier bar; bar.bar = ctl + CW_BAR + p.li * XCD_BAR_WORDS; bar.x = 0; bar.st = nullptr;
    if (hi - lo > 1) bar = xcd_barrier_post(ctl + CW_BAR + p.li * XCD_BAR_WORDS, MISC + 8);
#define IN(k) (lo <= (k) && (k) < hi)
#define SEAM(k) do { if (PROBE_CLK && PROBE_PH >= 0 && bx == 0 && tid == 0) { const unsigned long long c_ = __builtin_amdgcn_s_memtime(), t_ = __builtin_amdgcn_s_memrealtime();   \
            if ((k) == PROBE_PH) { const unsigned long long c0_ = ((unsigned long long)CLK[1] << 32) | CLK[0], t0_ = ((unsigned long long)MISC[17 + 2 * (k)] << 32) | MISC[16 + 2 * (k)]; \
                __hip_atomic_store(ctl + 32, (unsigned)(1000.0f * (float)(c_ - c0_) / (float)(t_ - t0_)), __ATOMIC_RELAXED, __HIP_MEMORY_SCOPE_AGENT); } } \
        if (IN(k) && IN((k) + 1)) xcd_barrier(bar); if (PROBE_PH >= 0 && bx == 0 && tid == 0) { const unsigned long long t_ = __builtin_amdgcn_s_memrealtime(), c_ = __builtin_amdgcn_s_memtime(); MISC[16 + 2 * ((k) + 1)] = (unsigned)t_; MISC[17 + 2 * ((k) + 1)] = (unsigned)(t_ >> 32); CLK[0] = (unsigned)c_; CLK[1] = (unsigned)(c_ >> 32); \
        if (!PROBE_CLK && (k) == PROBE_PH) { const unsigned long long t0_ = ((unsigned long long)MISC[17 + 2 * (k)] << 32) | MISC[16 + 2 * (k)]; __hip_atomic_store(ctl + 32, (unsigned)(t_ - t0_), __ATOMIC_RELAXED, __HIP_MEMORY_SCOPE_AGENT); } } } while (0)
    unsigned char* ws = p.ws;
    LAS int* l_toff = (LAS int*)(lds + LDSCTL_OFF + 512); LAS int* l_cnt = (LAS int*)(lds + LDSCTL_OFF + 768);
    LAS int* l_utab9 = (LAS int*)(lds + LDSCTL_OFF + 1280); LAS int* l_utab10 = (LAS int*)(lds + LDSCTL_OFF + 1536);
    LAS float* l_slots = (LAS float*)(lds + LDSCTL_OFF + 2048);
#define RUN(k, BODY) do { if (IN(k)) { BODY; if ((DUP_MASK >> (k)) & 1u) { xcd_barrier(bar); BODY; } } } while (0)
    const int GP1 = (G == 256) ? G - NHELP : G, p0_last = (G == 256) ? P0_SPLIT : P0_NITEMS;
#define PH0 do { p0_rows(p, gw, NGW, lane); p0_items(p, lds, 0, p0_last, gw, NGW, wave, lane); } while (0)
#define PH1 do {   \
        if (bx < GP1) { pg8::SchedP1 S{(const char*)(ws + WS_XB), (const char*)(ws + WS_W_IN), GP1, bx}; \
          pg8::EpiP1 E{pg8::EpiRowScale{(const float*)(ws + WS_SS0), (bf16*)(ws + WS_QKXY), 1024, 1024, (size_t)NTOK * 1024, QSCALE, l_slots}, pg8::EpiColScale{(const float*)(ws + WS_SS0), (bf16*)(ws + WS_VT), (size_t)NTOK, l_slots}}; \
          pg8::gemm_phase(lds, 2 * DM, S, E, STAG1); } \
        else p0_items(p, lds, p0_last, P0_NITEMS, (bx - GP1) * NWAVES + wave, (G - GP1) * NWAVES, wave, lane); } while (0)
#define PH2 do { \
        if (SUB2_MASK & 1u) {     \
            { pg8::SchedReg S{(const char*)(ws + WS_MEMB), (const char*)(ws + WS_W_CKV), NMEM / 256, 2, G, bx, 4096, 1 << 30, 0}; \
              pg8::EpiRowScale E{(const float*)(ws + WS_SSM), (bf16*)(ws + WS_CK), XW, 0, 0, 1.0f, l_slots}; \
              pg8::gemm_phase(lds, 2 * DM, S, E); } \
            { pg8::SchedReg S{(const char*)(ws + WS_W_CKV) + (size_t)512 * 4096, (const char*)(ws + WS_MEMB), 2, NMEM / 256, G, (bx + 32) % G, 4096, 1 << 30, 0}; \
              pg8::EpiColScale E{(const float*)(ws + WS_SSM), (bf16*)(ws + WS_CVT), (size_t)NMEM, l_slots}; \
              pg8::gemm_phase(lds, 2 * DM, S, E); } \
        } \
        const bf16* QKXY = (const bf16*)(ws + WS_QKXY); \
        if (SUB2_MASK & 4u) { \
            for (int U = vcu; U < BATCH * 16; U += G) \
                lru::unit(lds, QKXY + (size_t)2 * NTOK * 1024, QKXY + (size_t)3 * NTOK * 1024, p.conv_w, p.conv_b, (const bf16*)(ws + WS_W_GA), (const bf16*)(ws + WS_W_GX), p.b_ga, p.b_gx, p.lam, (bf16*)(ws + WS_MIX), (float*)(ws + WS_SSL), U >> 4, U & 15); \
        } \
        if (SUB2_MASK & 2u) {     \
            if (G == 256) { const bool ckvb = (bx < 32) || (bx >= 224); const int idx = ckvb ? (bx < 32 ? bx : bx - 192) : bx - 32, nu = ckvb ? 5 : 9, u0 = ckvb ? idx * 5 : 320 + idx * 9;     \
                for (int q = 0; q < nu; ++q) { const int U = u0 + q; \
                    battn::unit(lds, QKXY, QKXY + (size_t)NTOK * 1024, (const bf16*)(ws + WS_VT), p.rel, (bf16*)(ws + WS_MIX), (float*)(ws + WS_SSA), U >> 7, (U >> 3) & 15, U & 7); } } \
            else for (int U = vcu; U < BATCH * AH * 8; U += G) \
                battn::unit(lds, QKXY, QKXY + (size_t)NTOK * 1024, (const bf16*)(ws + WS_VT), p.rel, (bf16*)(ws + WS_MIX), (float*)(ws + WS_SSA), U >> 7, (U >> 3) & 15, U & 7); \
        } } while (0)
#define PH3 p3_scales(p, gw * 64 + lane, NGW * 64)
#define PH4 do { \
        pg8::SchedReg S{(const char*)(ws + WS_MIX), (const char*)(ws + WS_W_OUT), NTOK / 256, 8, G, bx, 4096, 1 << 30, 0}; \
        pg8::EpiX1 E{(const float*)(ws + WS_SCL), (const bf16*)(ws + WS_XB), p.out, (bf16*)(ws + WS_X1B), (float*)(ws + WS_SS1P), l_slots}; \
        pg8::gemm_phase(lds, 2 * DM, S, E, STAG4); } while (0)
#define PH5 do { \
        pg8::SchedReg S{(const char*)(ws + WS_X1B), (const char*)(ws + WS_W_CQ), NTOK / 256, 2, G, bx, 4096, 1 << 30, 0}; \
        pg8::EpiCQ E{(const float*)(ws + WS_SS1P), (bf16*)(ws + WS_CQ), l_slots}; \
        pg8::gemm_phase(lds, 2 * DM, S, E); } while (0)
#define PH6 do { int prev = -1;     \
        if (G == 256) { for (int i = 0; i < 2; ++i) { const int bh = vcu >> 2; \
            xattn::unit(lds, (const bf16*)(ws + WS_CQ), (const bf16*)(ws + WS_CK), (const bf16*)(ws + WS_CVT), (bf16*)(ws + WS_OX), bh >> 2, bh & 3, (vcu & 3) * 2 + i, i == 0); } } \
        else for (int U = vcu; U < BATCH * XH * 8; U += G) { const int bh = U >> 3; \
            xattn::unit(lds, (const bf16*)(ws + WS_CQ), (const bf16*)(ws + WS_CK), (const bf16*)(ws + WS_CVT), (bf16*)(ws + WS_OX), bh >> 2, bh & 3, U & 7, bh != prev); prev = bh; } } while (0)
#define PH7 do { \
        pg8::SchedReg S{(const char*)(ws + WS_OX), (const char*)(ws + WS_W_CO), NTOK / 256, 8, G, bx, 1024, 1 << 30, 0}; \
        pg8::EpiX2 E{(const bf16*)(ws + WS_X1B), (bf16*)(ws + WS_X2H), (unsigned char*)(ws + WS_X2B)}; \
        pg8::gemm_phase(lds, 2 * XW, S, E, STAG7); } while (0)
#define PH8 p8_router(p, lds, vcu, G, tid, lane, wave)
#define PH9 do { \
        pg8::SchedMoE<true> S{l_utab9, l_cnt, (const int*)(ws + WS_LIST), (const char*)(ws + WS_X2B), (const char*)(ws + WS_W_GU), 4096}; \
        pg8::EpiAct E{l_cnt, (const int*)(ws + WS_LIST), (const float*)(ws + WS_R2), p.b_gu, (unsigned char*)(ws + WS_ACT), l_slots}; \
        pg8::gemm_phase(lds, DM, S, E, STAG9); } while (0)
#define PH10 do { \
        pg8::SchedMoE<false> S{l_utab10, l_cnt, nullptr, (const char*)(ws + WS_ACT), (const char*)(ws + WS_W_DN), 2048}; \
        pg8::EpiY E{p.b_dn, (unsigned char*)(ws + WS_Y), l_slots}; \
        pg8::gemm_phase(lds, DFF, S, E, STAG10); } while (0)
#define PH11 p11_combine(p, gw, NGW, lane, PROBE_PH >= 0 ? 1.0f + sqrtf(exp2f((floorf(log2f((float)__hip_atomic_load(ctl + 32, __ATOMIC_RELAXED, __HIP_MEMORY_SCOPE_AGENT) * 0.01f) * PROBE_STEPS + PROBE_OFF) + 0.5f - PROBE_OFF) * (1.0f / PROBE_STEPS)) * (1.0f / PROBE_US)) : 1.0f)
    volatile LAS unsigned* CLK = (volatile LAS unsigned*)(lds + LDSCTL_OFF + 1024);
    if (PROBE_PH >= 0 && bx == 0 && tid == 0) { const unsigned long long t_ = __builtin_amdgcn_s_memrealtime(), c_ = __builtin_amdgcn_s_memtime(); MISC[16 + 2 * lo] = (unsigned)t_; MISC[17 + 2 * lo] = (unsigned)(t_ >> 32); CLK[0] = (unsigned)c_; CLK[1] = (unsigned)(c_ >> 32); }
    RUN(0, PH0); SEAM(0);
    RUN(1, PH1); SEAM(1);
    RUN(2, PH2); SEAM(2);
    RUN(3, PH3);
    if (PROBE_MB && IN(3)) {
        pg8::v8i a8, b8; bf16x8 a4, b4; f32x4 ac[8];
        for (int i = 0; i < 8; ++i) { a8[i] = 0x38383838 + lane; b8[i] = 0x3c3c3c3c ^ (lane << 3); }
        for (int i = 0; i < 8; ++i) { a4[i] = (short)(0x3f80 + lane); b4[i] = (short)(0x3f00 + 3 * lane); ac[i] = (f32x4){0.f, 0.f, 0.f, 0.f}; }
        asm volatile("" : "+v"(a8), "+v"(b8), "+v"(a4), "+v"(b4));
        __syncthreads();
        const unsigned long long c0 = __builtin_amdgcn_s_memtime();
#pragma unroll 1
        for (int it = 0; it < 2048; ++it) {
#pragma unroll
            for (int i = 0; i < 8; ++i) { if (PROBE_MB == 1) ac[i] = __builtin_amdgcn_mfma_f32_16x16x32_bf16(a4, b4, ac[i], 0, 0, 0);
                else ac[i] = __builtin_amdgcn_mfma_scale_f32_16x16x128_f8f6f4(a8, b8, ac[i], 0, 0, 0, 0x7C7C7C7C, 0, 0x7C7C7C7C); } }
        const unsigned long long c1 = __builtin_amdgcn_s_memtime();
#pragma unroll
        for (int i = 0; i < 8; ++i) asm volatile("" :: "v"(ac[i]));
        if (bx == 0 && tid == 0) __hip_atomic_store(ctl + 32, (unsigned)((c1 - c0) * 100ull / (2048ull * 8ull)) * 100u, __ATOMIC_RELAXED, __HIP_MEMORY_SCOPE_AGENT);
    }
    SEAM(3);
    RUN(4, PH4); SEAM(4);
    RUN(5, PH5); SEAM(5);
    RUN(6, PH6); SEAM(6);
    if (IN(7)) { PH7; } SEAM(7);
    if (IN(8)) { PH8; } SEAM(8);
    if (IN(9) || IN(10)) {
        if (tid < NE) l_cnt[tid] = ((const int*)ctl)[CW_CNT + tid];
        __syncthreads();
        if (tid == 0) { int a = 0; for (int e = 0; e < NE; ++e) { l_toff[e] = a; a += (l_cnt[e] + 255) >> 8; } l_toff[NE] = a; }
        __syncthreads();
        pg8::moe_unit_table(l_toff, l_utab9, 16, G, bx, tid); pg8::moe_unit_table(l_toff, l_utab10, 8, G, bx, tid);
        __syncthreads();
    }
    RUN(9, PH9); SEAM(9);
    RUN(10, PH10); SEAM(10);
    if (IN(11)) { PH11; }
#undef IN
#undef SEAM
}

extern "C" void kernel_launch(void* const* d_in, const int* in_sizes, int n_in, void* d_out, int out_size, void* d_ws, size_t ws_size, hipStream_t stream) {
    static int grid = 0;
    if (grid == 0) {
        if (n_in != 28 || in_sizes[0] != NTOK * DM || out_size != NTOK * DM || ws_size < WS_END) { fprintf(stderr, "kernel_launch: unexpected shapes (n_in %d, ws %zu)\n", n_in, ws_size); grid = -1; return; }
        int dev = 0, cus = 0;
        if (hipGetDevice(&dev) != hipSuccess || hipDeviceGetAttribute(&cus, hipDeviceAttributeMultiprocessorCount, dev) != hipSuccess) { grid = -1; return; }
        if (hipFuncSetAttribute((const void*)fwd, hipFuncAttributeMaxDynamicSharedMemorySize, LDS_BYTES) != hipSuccess) { fprintf(stderr, "kernel_launch: hipFuncSetAttribute failed\n"); grid = -1; return; }
        int per_cu = 0; (void)hipOccupancyMaxActiveBlocksPerMultiprocessor(&per_cu, (const void*)fwd, NWAVES * 64, LDS_BYTES); (void)hipGetLastError();
        grid = cus;
    }
    if (grid < 0) return;
    (void)hipMemsetAsync((char*)d_ws + WS_CTL, 0, (FAST_MASK == 0xFFFu) ? (size_t)32768 : CTL_ZERO_BYTES, stream);
    P p{};
    const float** pp = (const float**)&p;
    for (int i = 0; i < 28; ++i) pp[i] = (const float*)d_in[i];
    p.out = (float*)d_out; p.ws = (unsigned char*)d_ws;
    unsigned char* ws = (unsigned char*)d_ws;
    bf16* QKXY = (bf16*)(ws + WS_QKXY); int* ctl = (int*)(ws + WS_CTL);
    int li = 0;
    auto isfast = [](int ph) { return ph == 2 ? (SUB2_MASK != 0u) : (((FAST_MASK >> ph) & 1u) != 0u); };
    for (int ph = 0; ph < NPHASE;) {
        if (ph == 2) {
            if (!(SUB2_MASK & 1u)) { F1b f{}; f.A = (bf16*)(ws + WS_MEMB); f.Bt = (bf16*)(ws + WS_W_CKV); f.ssm = (float*)(ws + WS_SSM); f.ck = (bf16*)(ws + WS_CK); f.cvt = (bf16*)(ws + WS_CVT);
                  hipLaunchKernelGGL(ngemm<F1b>, dim3(1024 / 64, NMEM / 64), dim3(256), 0, stream, f); }
            if (!(SUB2_MASK & 2u)) hipLaunchKernelGGL(n_attn, dim3(BATCH * AH * 8), dim3(256), 0, stream, QKXY, (const bf16*)(ws + WS_VT), p.rel, (bf16*)(ws + WS_MIX), (float*)(ws + WS_SSA));
            if (!(SUB2_MASK & 4u)) {
                  hipLaunchKernelGGL(n_lru_a, dim3(NTOK * 4), dim3(256), 0, stream, QKXY + (size_t)2 * NTOK * 1024, p.conv_w, p.conv_b, (const bf16*)(ws + WS_W_GA), p.b_ga, (const bf16*)(ws + WS_W_GX), p.b_gx, p.lam, (float*)(ws + WS_NA), (float*)(ws + WS_NB));
                  hipLaunchKernelGGL(n_lru_b, dim3(256), dim3(64), 0, stream, (const float*)(ws + WS_NA), (const float*)(ws + WS_NB), QKXY + (size_t)3 * NTOK * 1024, (bf16*)(ws + WS_MIX), (float*)(ws + WS_SSL)); }
        }
        if (isfast(ph)) { int hi = ph + 1; while (hi < NPHASE && isfast(hi) && !(hi == 2 && SUB2_MASK != 7u)) ++hi;
            p.ph_lo = ph; p.ph_hi = hi; p.li = li++; hipLaunchKernelGGL(fwd, dim3(grid), dim3(NWAVES * 64), LDS_BYTES, stream, p); ph = hi; continue; }
        switch (ph) {
        case 1: { F1 f{}; f.A = (bf16*)(ws + WS_XB); f.Bt = (bf16*)(ws + WS_W_IN); f.ss0 = (float*)(ws + WS_SS0); f.qkxy = QKXY; f.vt = (bf16*)(ws + WS_VT);
                  hipLaunchKernelGGL(ngemm<F1>, dim3(5120 / 64, NTOK / 64), dim3(256), 0, stream, f); } break;
        case 4: { F4 f{}; f.A = (bf16*)(ws + WS_MIX); f.Bt = (bf16*)(ws + WS_W_OUT); f.scl = (float*)(ws + WS_SCL); f.x = p.x; f.x1 = p.out; f.x1b = (bf16*)(ws + WS_X1B); f.ss1p = (float*)(ws + WS_SS1P);
                  hipLaunchKernelGGL(ngemm<F4>, dim3(DM / 64, NTOK / 64), dim3(256), 0, stream, f); } break;
        case 5: { F5 f{}; f.A = (bf16*)(ws + WS_X1B); f.Bt = (bf16*)(ws + WS_W_CQ); f.ss1p = (float*)(ws + WS_SS1P); f.cq = (bf16*)(ws + WS_CQ);
                  hipLaunchKernelGGL(ngemm<F5>, dim3(XW / 64, NTOK / 64), dim3(256), 0, stream, f); } break;
        case 6: hipLaunchKernelGGL(n_xattn, dim3(BATCH * XH * 8 * 2), dim3(256), 0, stream, (const bf16*)(ws + WS_CQ), (const bf16*)(ws + WS_CK), (const bf16*)(ws + WS_CVT), (bf16*)(ws + WS_OX)); break;
        case 7: { F7 f{}; f.A = (bf16*)(ws + WS_OX); f.Bt = (bf16*)(ws + WS_W_CO); f.x12 = p.out; f.x2b = (unsigned char*)(ws + WS_X2B);
                  hipLaunchKernelGGL(ngemm<F7>, dim3(DM / 64, NTOK / 64), dim3(256), 0, stream, f); } break;
        case 9: { hipLaunchKernelGGL(n_toff, dim3(1), dim3(64), 0, stream, (const int*)(ctl + CW_CNT), ctl + CW_TOFF);
                  F9 f{}; f.x2b = (unsigned char*)(ws + WS_X2B); f.wgu = (unsigned char*)(ws + WS_W_GU); f.toff = ctl + CW_TOFF; f.cnt = ctl + CW_CNT; f.list = (int*)(ws + WS_LIST); f.r2 = (float*)(ws + WS_R2); f.b_gu = p.b_gu; f.act = (unsigned char*)(ws + WS_ACT);
                  hipLaunchKernelGGL(ngemm<F9>, dim3(DFF / 32, NSLOT / 64), dim3(256), 0, stream, f); } break;
        case 10: { hipLaunchKernelGGL(n_toff, dim3(1), dim3(64), 0, stream, (const int*)(ctl + CW_CNT), ctl + CW_TOFF);
                  F10 f{}; f.act = (unsigned char*)(ws + WS_ACT); f.wdn = (unsigned char*)(ws + WS_W_DN); f.toff = ctl + CW_TOFF; f.b_dn = p.b_dn; f.y = (unsigned char*)(ws + WS_Y);
                  hipLaunchKernelGGL(ngemm<F10>, dim3(DM / 64, NSLOT / 64), dim3(256), 0, stream, f); } break;
        default: break;
        }
        ++ph;
    }
}
```

```cpp
#include <hip/hip_runtime.h>
#include <cstdio>
#include <cstdint>
#include <cmath>

#define GAS __attribute__((address_space(1)))
#define LAS __attribute__((address_space(3)))
typedef unsigned short bf16;
typedef unsigned v4u __attribute__((ext_vector_type(4)));
typedef unsigned v2u __attribute__((ext_vector_type(2)));
typedef float f32x4 __attribute__((ext_vector_type(4)));
typedef float f32x2 __attribute__((ext_vector_type(2)));
typedef float f32x16 __attribute__((ext_vector_type(16)));
typedef short bf16x8 __attribute__((ext_vector_type(8)));

constexpr int BATCH = 16, SEQ = 2048, DM = 2048, NTOK = BATCH * SEQ;
constexpr int CHUNK = 64, LEFTC = 8, AW = 1024, AH = 16, AHD = 64, MAXREL = 128, RELW = 2 * MAXREL + 1;
constexpr int LW = 1024, LB = 8, LBW = 128;
constexpr int MEML = 256, NMEM = BATCH * MEML, XH = 4, XHD = 128, XW = 512;
constexpr int NE = 32, TOPK = 4, DFF = 2048;
constexpr int NSLOT = NTOK * TOPK + NE * 256;
constexpr float EPS = 1e-6f, LOG2E = 1.4426950408889634f;
constexpr float QSCALE = 0.125f * LOG2E;
constexpr float CQSCALE = 0.08838834764831845f * LOG2E;
constexpr float SW_ALPHA = 1.702f, SW_LIMIT = 7.0f;

constexpr size_t MiB = 1u << 20;
constexpr size_t WS_CTL = 0, CTL_ZERO_BYTES = 1 * MiB;
constexpr size_t WS_W_IN = 2 * MiB, WS_W_OUT = 22 * MiB, WS_W_CQ = 30 * MiB, WS_W_CKV = 32 * MiB, WS_W_CO = 36 * MiB;
constexpr size_t WS_W_GA = 38 * MiB, WS_W_GX = WS_W_GA + 256 * 1024, WS_W_R = WS_W_GX + 256 * 1024;
constexpr size_t WS_SS0 = 39 * MiB, WS_SSM = WS_SS0 + 128 * 1024, WS_R2 = WS_SS0 + 256 * 1024;
constexpr size_t WS_SSA = 40 * MiB, WS_SSL = 42 * MiB, WS_SCL = 44 * MiB, WS_SS1P = 45 * MiB;
constexpr size_t WS_TOPE = 49 * MiB, WS_TOPG = WS_TOPE + 512 * 1024, WS_TPOS = 50 * MiB;
constexpr size_t WS_LIST = 3008 * MiB  , WS_CK = 55 * MiB, WS_CVT = 59 * MiB, WS_MEMB = 64 * MiB;
constexpr size_t WS_W_GU = 128 * MiB, WS_W_DN = 640 * MiB;
constexpr size_t WS_XB = 896 * MiB, WS_MIX = 2496 * MiB;
constexpr size_t WS_QKXY = 1024 * MiB, WS_VT = 1280 * MiB, WS_X1B = 1344 * MiB, WS_CQ = 1472 * MiB, WS_OX = 1504 * MiB, WS_X2B = 1536 * MiB;
constexpr size_t WS_X2H = 2752 * MiB;
constexpr size_t WS_ACT = 1664 * MiB, WS_Y = 2208 * MiB, WS_NA = 2752 * MiB, WS_NB = 2880 * MiB, WS_END = 3016 * MiB;
constexpr int CW_CNT = 64;
constexpr int CW_TOFF = 128;
constexpr int CW_BAR = 4096;

struct P {
    const float *x, *mem, *g_mix, *w_in, *rel, *conv_w, *conv_b, *w_ga, *b_ga, *w_gx, *b_gx, *lam, *g_att, *g_lru, *w_out, *g_cross, *g_mem,
        *w_cq, *w_ckv, *w_co, *g_ffn, *w_r, *b_r, *w_gu, *b_gu, *w_dn, *b_dn, *g_fin;
    float* out; unsigned char* ws;
    int ph_lo, ph_hi, li, pad;
};

__device__ __forceinline__ float bf2f(bf16 b) { return __uint_as_float(((unsigned)b) << 16); }
__device__ __forceinline__ unsigned f2bf(float f) { unsigned u = __float_as_uint(f); return (u + 0x7fffu + ((u >> 16) & 1u)) >> 16; }
__device__ __forceinline__ unsigned pk2(float lo, float hi) { return f2bf(lo) | (f2bf(hi) << 16); }
constexpr float W8_SCALE = 64.0f, W8_INV = 1.0f / 64.0f;
__device__ __forceinline__ unsigned pk4_fp8(float a, float b, float c, float d) { int w = 0; w = __builtin_amdgcn_cvt_pk_fp8_f32(a, b, w, false); w = __builtin_amdgcn_cvt_pk_fp8_f32(c, d, w, true); return (unsigned)w; }
__device__ __forceinline__ float fp8_to_f(unsigned b) { const unsigned s = (b >> 7) & 1u, e = (b >> 3) & 15u, m = b & 7u; const float v = e ? ldexpf(1.0f + (float)m * 0.125f, (int)e - 7) : ldexpf((float)m * 0.125f, -6); return s ? -v : v; }
__device__ __forceinline__ float wave_sum(float v) {
#pragma unroll
    for (int o = 1; o < 64; o <<= 1) v += __shfl_xor(v, o);
    return v;
}
__device__ __forceinline__ float sigmoidf_(float x) { return 1.0f / (1.0f + __expf(-x)); }
__device__ __forceinline__ float gelu_tanh(float x) { const float u = 0.7978845608028654f * (x + 0.044715f * x * x * x); return 0.5f * x * (1.0f + tanhf(u)); }
__device__ __forceinline__ int find_expert(const int* toff, int tile) { int e = 0;
#pragma unroll 1
    for (int i = 1; i < NE; ++i) e += (tile >= toff[i]) ? 1 : 0;
    return e; }

template <class F>
__global__ void __launch_bounds__(256) ngemm(F f) {
    __shared__ float As[16][68], Bs[16][68];
    const int tx = threadIdx.x & 15, ty = threadIdx.x >> 4, bm = blockIdx.y, bn = blockIdx.x;
    if (!f.valid(bm)) return;
    const int lr = threadIdx.x >> 2, lk = (threadIdx.x & 3) * 4;
    const unsigned char* ap = (const unsigned char*)f.aptr(bm * 64 + lr);
    const unsigned char* bp = (const unsigned char*)f.bptr(bm, bn, lr);
    float acc[4][4];
#pragma unroll
    for (int i = 0; i < 4; ++i)
#pragma unroll
        for (int j = 0; j < 4; ++j) acc[i][j] = 0.f;
    for (int k0 = 0; k0 < F::K; k0 += 16) {
        f.mid(k0, bm, ty, acc);
        if constexpr (F::FP8) { const unsigned av = *(const unsigned*)(ap + k0 + lk), bv = *(const unsigned*)(bp + k0 + lk);
#pragma unroll
            for (int q = 0; q < 4; ++q) { As[lk + q][lr] = fp8_to_f((av >> (8 * q)) & 255u); Bs[lk + q][lr] = fp8_to_f((bv >> (8 * q)) & 255u) * W8_INV; } }
        else { const v2u av = *(const v2u*)(ap + 2 * (k0 + lk)), bv = *(const v2u*)(bp + 2 * (k0 + lk));
        As[lk + 0][lr] = __uint_as_float(av.x << 16); As[lk + 1][lr] = __uint_as_float(av.x & 0xffff0000u);
        As[lk + 2][lr] = __uint_as_float(av.y << 16); As[lk + 3][lr] = __uint_as_float(av.y & 0xffff0000u);
        Bs[lk + 0][lr] = __uint_as_float(bv.x << 16); Bs[lk + 1][lr] = __uint_as_float(bv.x & 0xffff0000u);
        Bs[lk + 2][lr] = __uint_as_float(bv.y << 16); Bs[lk + 3][lr] = __uint_as_float(bv.y & 0xffff0000u); }
        __syncthreads();
#pragma unroll
        for (int kk = 0; kk < 16; ++kk) {
            const f32x4 a = *(const f32x4*)&As[kk][ty * 4], b = *(const f32x4*)&Bs[kk][tx * 4];
#pragma unroll
            for (int i = 0; i < 4; ++i)
#pragma unroll
                for (int j = 0; j < 4; ++j) acc[i][j] += a[i] * b[j];
        }
        __syncthreads();
    }
    f.out(bm, bn, ty, tx, acc);
}
struct FBase { static constexpr bool FP8 = false;
    __device__ bool valid(int) const { return true; }
    __device__ void mid(int, int, int, float (&)[4][4]) const {}
};
struct F1 : FBase { static constexpr int K = 2048; const bf16* A; const bf16* Bt; const float* ss0; bf16* qkxy; bf16* vt;
    __device__ const bf16* aptr(int row) const { return A + (size_t)row * K; }
    __device__ const bf16* bptr(int, int bn, int j) const { return Bt + (size_t)(bn * 64 + j) * K; }
    __device__ void out(int bm, int bn, int ty, int tx, float (&acc)[4][4]) const {
        for (int i = 0; i < 4; ++i) { const int m = bm * 64 + ty * 4 + i; const float r0 = rsqrtf(ss0[m] * (1.0f / DM) + EPS);
            for (int j = 0; j < 4; ++j) { const int n = bn * 64 + tx * 4 + j, t = n >> 10, c = n & 1023; float v = acc[i][j] * r0;
                if (t == 2) vt[(size_t)c * NTOK + m] = (bf16)f2bf(v);
                else { const int slot = t < 2 ? t : t - 1; if (t == 0) v *= QSCALE; qkxy[(size_t)slot * NTOK * 1024 + (size_t)m * 1024 + c] = (bf16)f2bf(v); } } }
    }
};
struct F1b : FBase { static constexpr int K = 2048; const bf16* A; const bf16* Bt; const float* ssm; bf16* ck; bf16* cvt;
    __device__ const bf16* aptr(int row) const { return A + (size_t)row * K; }
    __device__ const bf16* bptr(int, int bn, int j) const { return Bt + (size_t)(bn * 64 + j) * K; }
    __device__ void out(int bm, int bn, int ty, int tx, float (&acc)[4][4]) const {
        for (int i = 0; i < 4; ++i) { const int m = bm * 64 + ty * 4 + i; const float r = rsqrtf(ssm[m] * (1.0f / DM) + EPS);
            for (int j = 0; j < 4; ++j) { const int n = bn * 64 + tx * 4 + j; const float v = acc[i][j] * r;
                if (n < XW) ck[(size_t)m * XW + n] = (bf16)f2bf(v); else cvt[(size_t)(n - XW) * NMEM + m] = (bf16)f2bf(v); } }
    }
};
struct F4 : FBase { static constexpr int K = 2048; const bf16* A; const bf16* Bt; const float* scl; const float* x; float* x1; bf16* x1b; float* ss1p;
    __device__ const bf16* aptr(int row) const { return A + (size_t)row * K; }
    __device__ const bf16* bptr(int, int bn, int j) const { return Bt + (size_t)(bn * 64 + j) * K; }
    __device__ void mid(int k0, int bm, int ty, float (&acc)[4][4]) const { if (k0 == 1024) { for (int i = 0; i < 4; ++i) { const float s = scl[2 * (bm * 64 + ty * 4 + i)]; for (int j = 0; j < 4; ++j) acc[i][j] *= s; } } }
    __device__ void out(int bm, int bn, int ty, int tx, float (&acc)[4][4]) const {
        for (int i = 0; i < 4; ++i) { const int m = bm * 64 + ty * 4 + i; const float s = scl[2 * m + 1]; float q = 0.f;
            for (int j = 0; j < 4; ++j) { const int n = bn * 64 + tx * 4 + j; const float v = x[(size_t)m * DM + n] + acc[i][j] * s; x1[(size_t)m * DM + n] = v; x1b[(size_t)m * DM + n] = (bf16)f2bf(v); q += v * v; }
            q += __shfl_xor(q, 1); q += __shfl_xor(q, 2); q += __shfl_xor(q, 4); q += __shfl_xor(q, 8);
            if (tx == 0) ss1p[(size_t)m * 32 + bn] = q; }
    }
};
struct F5 : FBase { static constexpr int K = 2048; const bf16* A; const bf16* Bt; const float* ss1p; bf16* cq;
    __device__ const bf16* aptr(int row) const { return A + (size_t)row * K; }
    __device__ const bf16* bptr(int, int bn, int j) const { return Bt + (size_t)(bn * 64 + j) * K; }
    __device__ void out(int bm, int bn, int ty, int tx, float (&acc)[4][4]) const {
        for (int i = 0; i < 4; ++i) { const int m = bm * 64 + ty * 4 + i; float q = 0.f; for (int p = 0; p < 32; ++p) q += ss1p[(size_t)m * 32 + p];
            const float r1 = rsqrtf(q * (1.0f / DM) + EPS) * CQSCALE;
            for (int j = 0; j < 4; ++j) { const int n = bn * 64 + tx * 4 + j; cq[(size_t)m * XW + n] = (bf16)f2bf(acc[i][j] * r1); } }
    }
};
struct F7 : FBase { static constexpr int K = 512; const bf16* A; const bf16* Bt; float* x12; unsigned char* x2b;
    __device__ const bf16* aptr(int row) const { return A + (size_t)row * K; }
    __device__ const bf16* bptr(int, int bn, int j) const { return Bt + (size_t)(bn * 64 + j) * K; }
    __device__ void out(int bm, int bn, int ty, int tx, float (&acc)[4][4]) const {
        for (int i = 0; i < 4; ++i) { const int m = bm * 64 + ty * 4 + i;
            for (int j = 0; j < 4; ++j) { const int n = bn * 64 + tx * 4 + j; const float v = x12[(size_t)m * DM + n] + acc[i][j]; x12[(size_t)m * DM + n] = v; x2b[(size_t)m * DM + n] = (unsigned char)(pk4_fp8(v, 0.f, 0.f, 0.f) & 255u); } }
    }
};
struct F9 { static constexpr int K = 2048; static constexpr bool FP8 = true; const unsigned char* x2b; const unsigned char* wgu; const int* toff; const int* cnt; const int* list; const float* r2; const float* b_gu; unsigned char* act;
    __device__ bool valid(int bm) const { return (bm >> 2) < toff[NE]; }
    __device__ void mid(int, int, int, float (&)[4][4]) const {}
    __device__ int tok_of(int slot, int& e) const { const int tile = slot >> 8; e = find_expert(toff, tile); const int pos = slot - 256 * toff[e]; return pos < cnt[e] ? list[2 * (e * NTOK + pos)] : 0; }
    __device__ const unsigned char* aptr(int slot) const { int e; const int tok = tok_of(slot, e); return x2b + (size_t)tok * K; }
    __device__ const unsigned char* bptr(int bm, int bn, int j) const { const int e = find_expert(toff, bm >> 2); const int a = bn * 32 + (j >> 2) * 2 + (j & 1), up = (j >> 1) & 1;
        const int row = 256 * (a >> 7) + (a & 127) + 128 * up; return wgu + ((size_t)e * 4096 + row) * K; }
    __device__ void out(int bm, int bn, int ty, int tx, float (&acc)[4][4]) const {
        for (int i = 0; i < 4; ++i) { const int slot = bm * 64 + ty * 4 + i; int e; const int tok = tok_of(slot, e); const float r = r2[tok];
            for (int j = 0; j < 2; ++j) { const int a = bn * 32 + tx * 2 + j;
                float g = acc[i][j] * r + b_gu[e * 4096 + a], u = acc[i][2 + j] * r + b_gu[e * 4096 + 2048 + a];
                g = fminf(g, SW_LIMIT); u = fminf(fmaxf(u, -SW_LIMIT), SW_LIMIT);
                act[(size_t)slot * DFF + a] = (unsigned char)(pk4_fp8((u + 1.0f) * g * sigmoidf_(SW_ALPHA * g), 0.f, 0.f, 0.f) & 255u); } }
    }
};
struct F10 { static constexpr int K = 2048; static constexpr bool FP8 = true; const unsigned char* act; const unsigned char* wdn; const int* toff; const float* b_dn; unsigned char* y;
    __device__ bool valid(int bm) const { return (bm >> 2) < toff[NE]; }
    __device__ void mid(int, int, int, float (&)[4][4]) const {}
    __device__ const unsigned char* aptr(int slot) const { return act + (size_t)slot * K; }
    __device__ const unsigned char* bptr(int bm, int bn, int j) const { const int e = find_expert(toff, bm >> 2); return wdn + ((size_t)e * DM + bn * 64 + j) * K; }
    __device__ void out(int bm, int bn, int ty, int tx, float (&acc)[4][4]) const { const int e = find_expert(toff, bm >> 2);
        for (int i = 0; i < 4; ++i) { const int slot = bm * 64 + ty * 4 + i;
            for (int j = 0; j < 4; ++j) { const int n = bn * 64 + tx * 4 + j; y[(size_t)slot * DM + n] = (unsigned char)(pk4_fp8(acc[i][j] + b_dn[e * DM + n], 0.f, 0.f, 0.f) & 255u); } }
    }
};

__global__ void __launch_bounds__(256) n_attn(const bf16* __restrict__ qkxy, const bf16* __restrict__ vt, const float* __restrict__ rel, bf16* mix, float* ssa) {
    const int blk = blockIdx.x, tq = (blk & 7) * 256 + threadIdx.x, bh = blk >> 3, h = bh & 15, b = bh >> 4;
    const size_t m = (size_t)b * SEQ + tq;
    const bf16* Q = qkxy; const bf16* Kp = qkxy + (size_t)NTOK * 1024;
    float q[64], o[64];
#pragma unroll
    for (int d = 0; d < 64; ++d) { q[d] = bf2f(Q[m * 1024 + h * 64 + d]); o[d] = 0.f; }
    float mx = -INFINITY, l = 0.f;
    const int c = tq >> 6, k0 = (c > LEFTC ? c - LEFTC : 0) * 64, k1 = (c + 1) * 64;
    const float* tab = rel + h * RELW;
    for (int key = k0; key < k1; ++key) {
        const bf16* kr = Kp + ((size_t)b * SEQ + key) * 1024 + h * 64;
        float s = 0.f;
#pragma unroll
        for (int d = 0; d < 64; ++d) s += q[d] * bf2f(kr[d]);
        int r = tq - key; r = (r < -MAXREL ? -MAXREL : (r > MAXREL ? MAXREL : r)) + MAXREL;
        s += tab[r] * LOG2E;
        const float mn = fmaxf(mx, s), corr = exp2f(mx - mn), pe = exp2f(s - mn);
        l = l * corr + pe;
        const bf16* vp = vt + (size_t)(h * 64) * NTOK + (size_t)b * SEQ + key;
#pragma unroll
        for (int d = 0; d < 64; ++d) o[d] = o[d] * corr + pe * bf2f(vp[(size_t)d * NTOK]);
        mx = mn;
    }
    const float il = 1.0f / l; float ss = 0.f;
#pragma unroll
    for (int d = 0; d < 64; ++d) { const float v = o[d] * il; ss += v * v; mix[m * DM + h * 64 + d] = (bf16)f2bf(v); }
    ssa[m * 16 + h] = ss;
}
__global__ void __launch_bounds__(256) n_xattn(const bf16* __restrict__ cq, const bf16* __restrict__ ck, const bf16* __restrict__ cvt, bf16* ox) {
    const int blk = blockIdx.x, dh = blk & 1, tq = ((blk >> 1) & 7) * 256 + threadIdx.x, bh = blk >> 4, h = bh & 3, b = bh >> 2;
    const size_t m = (size_t)b * SEQ + tq;
    float q[128], o[64];
#pragma unroll
    for (int d = 0; d < 128; ++d) q[d] = bf2f(cq[m * XW + h * XHD + d]);
#pragma unroll
    for (int d = 0; d < 64; ++d) o[d] = 0.f;
    float mx = -INFINITY, l = 0.f;
    for (int key = 0; key < MEML; ++key) {
        const bf16* kr = ck + ((size_t)b * MEML + key) * XW + h * XHD;
        float s = 0.f;
#pragma unroll
        for (int d = 0; d < 128; ++d) s += q[d] * bf2f(kr[d]);
        const float mn = fmaxf(mx, s), corr = exp2f(mx - mn), pe = exp2f(s - mn);
        l = l * corr + pe;
        const bf16* vp = cvt + (size_t)(h * XHD + dh * 64) * NMEM + (size_t)b * MEML + key;
#pragma unroll
        for (int d = 0; d < 64; ++d) o[d] = o[d] * corr + pe * bf2f(vp[(size_t)d * NMEM]);
        mx = mn;
    }
    const float il = 1.0f / l;
#pragma unroll
    for (int d = 0; d < 64; ++d) ox[m * XW + h * XHD + dh * 64 + d] = (bf16)f2bf(o[d] * il);
}
__global__ void __launch_bounds__(256) n_lru_a(const bf16* __restrict__ xr, const float* __restrict__ conv_w, const float* __restrict__ conv_b, const bf16* __restrict__ wga_t, const float* __restrict__ b_ga,
                                              const bf16* __restrict__ wgx_t, const float* __restrict__ b_gx, const float* __restrict__ lam, float* na, float* nb) {
    const size_t idx = (size_t)blockIdx.x * 256 + threadIdx.x; const int c = (int)(idx & 1023); const size_t m = idx >> 10; const int t = (int)(m & (SEQ - 1)), n = c >> 7, d = c & 127;
    float rp = b_ga[c], ip = b_gx[c], xown = 0.f;
    const bf16* wa = wga_t + (size_t)(n * 128 + d) * 128; const bf16* wx = wgx_t + (size_t)(n * 128 + d) * 128;
    for (int cp = 0; cp < 128; ++cp) { const int cc = n * 128 + cp; float xc = conv_b[cc];
#pragma unroll
        for (int j = 0; j < 4; ++j) { const int tt = t - 3 + j; if (tt >= 0) xc += conv_w[j * LW + cc] * bf2f(xr[(m - 3 + j) * 1024 + cc]); }
        rp += xc * bf2f(wa[cp]); ip += xc * bf2f(wx[cp]); if (cp == d) xown = xc; }
    const float r = sigmoidf_(rp), ig = sigmoidf_(ip);
    const float la = -8.0f * r * log1pf(__expf(-lam[c]));
    na[idx] = __expf(la); nb[idx] = sqrtf(-expm1f(2.0f * la)) * (ig * xown);
}
__global__ void __launch_bounds__(64) n_lru_b(const float* __restrict__ na, const float* __restrict__ nb, const bf16* __restrict__ yg, bf16* mix, float* ssl) {
    const int b = blockIdx.x >> 4, g = blockIdx.x & 15, c = g * 64 + threadIdx.x; float h = 0.f;
    for (int t = 0; t < SEQ; ++t) { const size_t m = (size_t)b * SEQ + t; h = na[m * 1024 + c] * h + nb[m * 1024 + c];
        const float y = h * gelu_tanh(bf2f(yg[m * 1024 + c])); mix[m * DM + 1024 + c] = (bf16)f2bf(y);
        const float s = wave_sum(y * y); if (threadIdx.x == 0) ssl[m * 16 + g] = s; }
}
__global__ void n_toff(const int* cnt, int* toff) { if (threadIdx.x == 0 && blockIdx.x == 0) { int a = 0; for (int e = 0; e < NE; ++e) { toff[e] = a; a += (cnt[e] + 255) >> 8; } toff[NE] = a; } }

#define XB_TMO      128
#define XB_XCNT(j)  (256  + 64 * (j))
#define XB_XSUB(j)  (1280 + 64 * (j))
#define XB_XGEN(j)  (2304 + 64 * (j))
#define XB_TOP      3328
#define XB_TOPGEN   3392
#define XCD_BAR_WORDS 3456
#define XB_SPIN_CAP (1u << 18)
__device__ __forceinline__ unsigned xb_ld(unsigned* p)              { return __hip_atomic_load(p, __ATOMIC_RELAXED, __HIP_MEMORY_SCOPE_AGENT); }
__device__ __forceinline__ unsigned xb_add(unsigned* p, unsigned v) { return __hip_atomic_fetch_add(p, v, __ATOMIC_RELAXED, __HIP_MEMORY_SCOPE_AGENT); }
__device__ __forceinline__ unsigned xb_xcc_id() { return (unsigned)__builtin_amdgcn_s_getreg((3 << 11) | 20) & 0xFu; }
#define XB_SPIN(cond, bar) do { unsigned _sp = 0; while (cond) { __builtin_amdgcn_s_sleep(1); \
    if ((++_sp & 255u) == 0u) { if (xb_ld(&(bar)[XB_TMO])) break; if (_sp > XB_SPIN_CAP) { atomicAdd(&(bar)[XB_TMO], 1u); break; } } } } while (0)
struct XcdBarrier { unsigned* bar; unsigned x; volatile LAS unsigned* st; };
__device__ __forceinline__ XcdBarrier xcd_barrier_post(unsigned* bar, volatile LAS unsigned* st) {
    XcdBarrier b; b.bar = bar; b.x = xb_xcc_id(); b.st = st;
    if (threadIdx.x == 0) (void)xb_add(&bar[XB_XCNT(b.x)], 1u);
    return b;
}
__device__ __forceinline__ void xcd_barrier_complete(unsigned* bar, unsigned x, unsigned& nloc, unsigned& nx) {
    const unsigned G = gridDim.x * gridDim.y * gridDim.z;
    unsigned sum, cnt, mine, sp = 0u;
    for (;;) {
        sum = 0u; cnt = 0u; mine = 0u;
#pragma unroll
        for (unsigned j = 0; j < 16; ++j) { const unsigned c = xb_ld(&bar[XB_XCNT(j)]); sum += c; cnt += (c > 0u) ? 1u : 0u; mine = (j == x) ? c : mine; }
        if (sum == G) break;
        __builtin_amdgcn_s_sleep(1);
        if ((++sp & 255u) == 0u) { if (xb_ld(&bar[XB_TMO])) break; if (sp > XB_SPIN_CAP) { atomicAdd(&bar[XB_TMO], 1u); break; } }
    }
    nloc = mine > 0u ? mine : 1u; nx = cnt > 0u ? cnt : 1u;
}
__device__ __forceinline__ void xcd_barrier(const XcdBarrier& b) {
    asm volatile("s_waitcnt vmcnt(0)" ::: "memory");
    __syncthreads();
    if (threadIdx.x == 0) {
        unsigned* bar = b.bar;
        __builtin_amdgcn_s_waitcnt(0);
        unsigned nloc = b.st[0], nx = b.st[1];
        if (nloc == 0u) { xcd_barrier_complete(bar, b.x, nloc, nx); b.st[0] = nloc; b.st[1] = nx; }
        const unsigned old = xb_add(&bar[XB_XSUB(b.x)], 1u);
        const unsigned gen = old / nloc;
        if (old + 1u == (gen + 1u) * nloc) {
            __builtin_amdgcn_fence(__ATOMIC_RELEASE, "agent");
            asm volatile("s_waitcnt vmcnt(0)" ::: "memory");
            const unsigned og = xb_add(&bar[XB_TOP], 1u);
            const unsigned tg = og / nx;
            if (og + 1u == (tg + 1u) * nx) xb_add(&bar[XB_TOPGEN], 1u);
            else XB_SPIN(xb_ld(&bar[XB_TOPGEN]) == tg, bar);
            __builtin_amdgcn_fence(__ATOMIC_ACQUIRE, "agent");
            xb_add(&bar[XB_XGEN(b.x)], 1u);
            asm volatile("s_waitcnt vmcnt(0)" ::: "memory");
        } else {
            XB_SPIN(xb_ld(&bar[XB_XGEN(b.x)]) == gen, bar);
            __builtin_amdgcn_fence(__ATOMIC_ACQUIRE, "agent");
            asm volatile("s_waitcnt vmcnt(0)" ::: "memory");
        }
    }
    __syncthreads();
}

#ifndef EPI_TWICE
#define EPI_TWICE 0
#endif
namespace pg8 {
constexpr int BM = 256, BK = 64, HALF = 128, HTB = HALF * BK * 2, STAGE_BYTES = 8 * HTB;
__host__ __device__ __forceinline__ int lds_byte(int r, int c) { const int st = (r >> 4) * 2 + (c >> 5), rr = r & 15, cc = c & 31, ob = rr * 64 + cc * 2; return st * 1024 + (ob ^ (((ob >> 9) & 1) << 5)); }
__host__ __device__ __forceinline__ void stage_rc(int b, int& R, int& C) { const int st = b / 1024, sb = b % 1024, swz = sb ^ (((sb >> 9) & 1) << 5); R = (st >> 1) * 16 + swz / 64; C = (st & 1) * 32 + (swz % 64) / 2; }
__host__ __device__ __forceinline__ int perm32(int rho) { const int n = rho >> 4, i = rho & 15; return 8 * (i >> 2) + 4 * n + (i & 3); }
__device__ __forceinline__ unsigned cvt_pk_bf16(float lo, float hi) { unsigned r; asm volatile("v_cvt_pk_bf16_f32 %0, %1, %2" : "=v"(r) : "v"(lo), "v"(hi)); return r; }
struct Unit { const char* a; const char* b; int pm, pn, e, tl, idx; };
typedef f32x4 Acc[2][2][4][2];
typedef int v8i __attribute__((ext_vector_type(8)));
__device__ __forceinline__ v8i cat8(const bf16x8 lo, const bf16x8 hi) { const v4u a = __builtin_bit_cast(v4u, lo), b = __builtin_bit_cast(v4u, hi); return (v8i){(int)a.x, (int)a.y, (int)a.z, (int)a.w, (int)b.x, (int)b.y, (int)b.z, (int)b.w}; }
template <class Epi, class Sched>
__device__ __forceinline__ void gemm_phase(LAS unsigned char* lds, const int KB  , const Sched& S, const Epi& E, const int stagger = 0) {
    if (stagger) { const unsigned long long t0 = __builtin_amdgcn_s_memrealtime(), d = (unsigned long long)(((blockIdx.x >> 3) & 3u) * (unsigned)stagger);
        while (__builtin_amdgcn_s_memrealtime() - t0 < d) __builtin_amdgcn_s_sleep(8); }
    const int tid = threadIdx.x, wid = __builtin_amdgcn_readfirstlane(tid >> 6), lane = tid & 63, wr = wid >> 2, wc = wid & 3, fr = lane & 15, fq = lane >> 4;
    const int nt = KB / 128;
    unsigned voffA[2], voffB[2];
#pragma unroll
    for (int i = 0; i < 2; ++i) { int R, C; stage_rc(tid * 16 + i * 8192, R, C); const int Rb = Epi::PERM ? ((R & ~31) + perm32(R & 31)) : R;
        voffA[i] = Sched::GATHER ? (unsigned)(C * 2) : (unsigned)(R * KB + C * 2); voffB[i] = (unsigned)(Rb * KB + C * 2); }
    const size_t kstep = (size_t)(BK * 2);
    const size_t hstep = (size_t)HALF * KB;
    const unsigned ldsw = (unsigned)wid * 1024u;
    const int aoff = lds_byte(wr * 64 + fr, fq * 8), boff = lds_byte(wc * 32 + fr, fq * 8);
#define PG8_SA(b, h) (((b) * 2 + (h)) * HTB)
#define PG8_SB(b, h) ((4 + (b) * 2 + (h)) * HTB)
#define PG8_STAGE(bufoff, gbase, voff) do { _Pragma("unroll") for (int _i = 0; _i < 2; ++_i) { unsigned _vo = (voff)[_i]; asm volatile("" : "+v"(_vo)); \
        __builtin_amdgcn_global_load_lds((const unsigned*)((const char*)(gbase) + _vo), (LAS unsigned*)(lds + (bufoff) + ldsw + _i * 8192), 16, 0, 0); } } while (0)
#define PG8_STAGE_A(bufoff, gbase, h, go) do { if constexpr (Sched::GATHER) { PG8_STAGE(bufoff, gbase, go[h]); } else { PG8_STAGE(bufoff, (gbase) + (h) * hstep, voffA); } } while (0)
#define PG8_LDA(dst, b, h) do { _Pragma("unroll") for (int m = 0; m < 4; ++m) _Pragma("unroll") for (int k = 0; k < 2; ++k) dst[m][k] = *(const LAS bf16x8*)(lds + PG8_SA(b, h) + aoff + m * 2048 + k * 1024); } while (0)
#define PG8_LDB(dst, b, h) do { _Pragma("unroll") for (int n = 0; n < 2; ++n) _Pragma("unroll") for (int k = 0; k < 2; ++k) dst[n][k] = *(const LAS bf16x8*)(lds + PG8_SB(b, h) + boff + n * 2048 + k * 1024); } while (0)
#define PG8_MMA(ai, bj, At, Bt) do { __builtin_amdgcn_s_setprio(1); _Pragma("unroll") for (int m = 0; m < 4; ++m) _Pragma("unroll") for (int n = 0; n < 2; ++n) { \
        if constexpr (Sched::FP8) acc[ai][bj][m][n] = __builtin_amdgcn_mfma_scale_f32_16x16x128_f8f6f4(cat8(Bt[n][0], Bt[n][1]), cat8(At[m][0], At[m][1]), acc[ai][bj][m][n], 0, 0, 0, 0x7C7C7C7C, 0, 0x7C7C7C7C);     \
        else { _Pragma("unroll") for (int k = 0; k < 2; ++k) acc[ai][bj][m][n] = __builtin_amdgcn_mfma_f32_16x16x32_bf16(Bt[n][k], At[m][k], acc[ai][bj][m][n], 0, 0, 0); } } __builtin_amdgcn_s_setprio(0); } while (0)
#define PG8_WAIT_V(n) asm volatile("s_waitcnt vmcnt(" #n ")" ::: "memory")
#define PG8_WAIT_L(n) asm volatile("s_waitcnt lgkmcnt(" #n ")" ::: "memory")
#define PG8_BAR __builtin_amdgcn_s_barrier()
#define PG8_SCHED __builtin_amdgcn_sched_barrier(0)
    Unit cur, nxt; int ui = 0;
    if (!S.next(0, cur)) return;
    Acc acc;
#pragma unroll
    for (int a = 0; a < 2; ++a)
#pragma unroll
        for (int b = 0; b < 2; ++b)
#pragma unroll
            for (int m = 0; m < 4; ++m)
#pragma unroll
                for (int n = 0; n < 2; ++n) acc[a][b][m][n] = (f32x4){0.f, 0.f, 0.f, 0.f};
    bf16x8 At[4][2], B0[2][2], B1[2][2];
    const char* cA = cur.a; const char* cB = cur.b;
    unsigned gc[2][2], gn[2][2];
    if constexpr (Sched::GATHER) { S.gather(cur, voffA, gc); }
    if constexpr (Epi::PREF) E.prefetch(cur);
    PG8_STAGE(PG8_SB(0, 0), cB, voffB); PG8_STAGE(PG8_SB(0, 1), cB + hstep, voffB); PG8_STAGE_A(PG8_SA(0, 0), cA, 0, gc); PG8_STAGE_A(PG8_SA(0, 1), cA, 1, gc);
    if (wr == 1) PG8_BAR;
    PG8_WAIT_V(2); PG8_BAR;
    PG8_STAGE(PG8_SB(1, 0), cB + kstep, voffB); PG8_STAGE_A(PG8_SA(1, 0), cA + kstep, 0, gc); PG8_STAGE(PG8_SB(1, 1), cB + hstep + kstep, voffB);
    PG8_WAIT_V(6); PG8_BAR;
    for (;;) {
        const bool has_next = S.next(ui + 1, nxt);
        const char* nA = has_next ? nxt.a : cA; const char* nB = has_next ? nxt.b : cB;
        if constexpr (Sched::GATHER) { if (has_next) S.gather(nxt, voffA, gn); else {
#pragma unroll
            for (int h = 0; h < 2; ++h)
#pragma unroll
                for (int i = 0; i < 2; ++i) gn[h][i] = gc[h][i]; } }
        for (int t = 0; t < nt; t += 2) {
            const bool last = (t == nt - 2);
            if constexpr (Epi::MIDK) { if (t == nt / 2) { int fr_e = fr; asm volatile("" : "+v"(fr_e)); E.midk(acc, cur, wr, fr_e); } }
            const char* a1 = cA + (size_t)(t + 1) * kstep;
            const char* a2 = last ? nA : cA + (size_t)(t + 2) * kstep; const char* b2 = last ? nB : cB + (size_t)(t + 2) * kstep;
            const char* a3 = a2 + kstep; const char* b3 = b2 + kstep;
            PG8_LDB(B0, 0, 0); PG8_LDB(B1, 0, 1); PG8_SCHED; PG8_LDA(At, 0, 0); PG8_STAGE_A(PG8_SA(1, 1), a1, 1, gc);
            if constexpr (Sched::GATHER) { if (last) {
#pragma unroll
                for (int h = 0; h < 2; ++h)
#pragma unroll
                    for (int i = 0; i < 2; ++i) gc[h][i] = gn[h][i]; } }
            PG8_WAIT_V(8); PG8_WAIT_L(0); PG8_BAR; PG8_MMA(0, 0, At, B0); PG8_MMA(0, 1, At, B1); PG8_BAR; PG8_SCHED;
            PG8_LDA(At, 0, 1); PG8_STAGE(PG8_SB(0, 0), b2, voffB); PG8_STAGE(PG8_SB(0, 1), b2 + hstep, voffB); PG8_STAGE_A(PG8_SA(0, 0), a2, 0, gc);
            PG8_WAIT_V(8); PG8_WAIT_L(0); PG8_BAR; PG8_MMA(1, 0, At, B0); PG8_MMA(1, 1, At, B1); PG8_BAR; PG8_SCHED;
            PG8_LDB(B0, 1, 0); PG8_LDB(B1, 1, 1); PG8_SCHED; PG8_LDA(At, 1, 0); PG8_STAGE_A(PG8_SA(0, 1), a2, 1, gc);
            PG8_WAIT_V(8); PG8_WAIT_L(0); PG8_BAR; PG8_MMA(0, 0, At, B0); PG8_MMA(0, 1, At, B1); PG8_BAR; PG8_SCHED;
            PG8_LDA(At, 1, 1); PG8_STAGE(PG8_SB(1, 0), b3, voffB); PG8_STAGE(PG8_SB(1, 1), b3 + hstep, voffB); PG8_STAGE_A(PG8_SA(1, 0), a3, 0, gc);
            PG8_WAIT_V(8); PG8_WAIT_L(0); PG8_BAR; PG8_MMA(1, 0, At, B0); PG8_MMA(1, 1, At, B1); PG8_BAR; PG8_SCHED;
        }
        if (wr == 0) PG8_BAR;
        { int fr_e = fr, fq_e = fq; asm volatile("" : "+v"(fr_e), "+v"(fq_e));
          E(acc, cur, wr, wc, fr_e, fq_e);
          if constexpr (EPI_TWICE != 0 && !Epi::INPLACE) { asm volatile("" : "+v"(fr_e), "+v"(fq_e)); E(acc, cur, wr, wc, fr_e, fq_e); } }
        if (!has_next) break;
#pragma unroll
        for (int a = 0; a < 2; ++a)
#pragma unroll
            for (int b = 0; b < 2; ++b)
#pragma unroll
                for (int m = 0; m < 4; ++m)
#pragma unroll
                    for (int n = 0; n < 2; ++n) acc[a][b][m][n] = (f32x4){0.f, 0.f, 0.f, 0.f};
        cur = nxt; cA = nA; cB = nB; ++ui;
        if constexpr (Epi::PREF) E.prefetch(cur);
        if (wr == 1) PG8_BAR;
    }
    PG8_WAIT_V(0);
    PG8_BAR;
#undef PG8_SA
#undef PG8_SB
#undef PG8_STAGE
#undef PG8_STAGE_A
#undef PG8_LDA
#undef PG8_LDB
#undef PG8_MMA
#undef PG8_WAIT_V
#undef PG8_WAIT_L
#undef PG8_BAR
#undef PG8_SCHED
}
}

namespace pg8 {
__device__ __forceinline__ void tile_of(int L, int nM, int nN, int& pm, int& pn) {
    const int nwg = nM * nN; int wgid = L; { const int q = nwg / 8, r = nwg % 8, xcd = wgid % 8, off = wgid / 8; wgid = (xcd < r ? xcd * (q + 1) : r * (q + 1) + (xcd - r) * q) + off; }
    const int nig = 8 * nN, gid = wgid / nig, fm = gid * 8, gsz = (nM - fm) < 8 ? (nM - fm) : 8;
    pm = fm + ((wgid % nig) % gsz); pn = (wgid % nig) / gsz;
}
struct SchedReg { static constexpr bool GATHER = false, FP8 = false;
    const char* A; const char* Bt; int nM, nN, G, c, rowbytes, bskip_from, bskip_rows;
    __device__ __forceinline__ bool next(int i, Unit& u) const { const int L = i * G + c; if (L >= nM * nN) return false; tile_of(L, nM, nN, u.pm, u.pn); u.e = 0; u.tl = 0; u.idx = i;
        u.a = A + (size_t)u.pm * 256 * rowbytes; const int brow = u.pn * 256 + (u.pn >= bskip_from ? bskip_rows : 0); u.b = Bt + (size_t)brow * rowbytes; return true; }
    __device__ __forceinline__ void gather(const Unit&, const unsigned (&)[2], unsigned (&)[2][2]) const {}
};
__device__ __forceinline__ void moe_unit_table(const LAS int* toff, LAS int* utab, int npn, int G, int c, int tid) {
    if (tid < 64) { int v = -1; const int ttot = toff[NE];
        int tile = -1, pn = 0;
        if (G == 256) { const int x = c & 7, j = c >> 3;
            if (npn == 16) { tile = 16 * tid + (j & 15); pn = 2 * x + (j >> 4); } else { tile = 32 * tid + x + 8 * (j >> 3); pn = j & 7; }
            if (tile >= ttot) tile = -1; }
        else { const int L = tid * G + c; if (L < ttot * npn) { int e = 0;
#pragma unroll 1
                for (int jj = 1; jj < NE; ++jj) e += (L >= toff[jj] * npn) ? 1 : 0;
                const int t0 = toff[e], ne = toff[e + 1] - t0, Ll = L - t0 * npn; pn = Ll / ne; tile = t0 + (Ll - pn * ne); } }
        if (tile >= 0) { int e = 0;
#pragma unroll 1
            for (int jj = 1; jj < NE; ++jj) e += (tile >= toff[jj]) ? 1 : 0;
            v = e | ((tile - toff[e]) << 8) | (pn << 16) | (tile << 21); }
        utab[tid] = v; }
}
template <bool G_> struct SchedMoE { static constexpr bool GATHER = G_, FP8 = true;
    const LAS int* utab; const LAS int* cnt; const int* list; const char* A; const char* Bt; int brows;
    __device__ __forceinline__ bool next(int i, Unit& u) const { if (i >= 64) return false; const int v = utab[i]; if (v < 0) return false; u.idx = i;
        u.e = v & 255; u.tl = (v >> 8) & 255; u.pn = (v >> 16) & 31; u.pm = (int)((unsigned)v >> 21);
        u.a = GATHER ? A : A + (size_t)u.pm * 256 * 2048; u.b = Bt + ((size_t)u.e * brows + u.pn * 256) * 2048; return true; }
    __device__ __forceinline__ void gather(const Unit& u, const unsigned (&voffA)[2], unsigned (&g)[2][2]) const {
        const int ce = cnt[u.e];
#pragma unroll
        for (int i = 0; i < 2; ++i) { int R, C; stage_rc((int)threadIdx.x * 16 + i * 8192, R, C);
#pragma unroll
            for (int h = 0; h < 2; ++h) { const int pos = u.tl * 256 + h * 128 + R; const int pc = pos < ce ? pos : ce - 1; const int tok = list[2 * ((size_t)u.e * NTOK + pc)]; g[h][i] = (unsigned)tok * 2048u + voffA[i]; } }
    }
};
struct SchedP1 { static constexpr bool GATHER = false, FP8 = false;
    const char* XB; const char* WIN; int G, c;
    __device__ __forceinline__ bool next(int i, Unit& u) const { const int L = i * G + c; if (L >= 2560) return false; u.tl = 0; u.idx = i;
        if (L < 2048) { tile_of(L, NTOK / 256, 16, u.pm, u.pn); u.e = 0; u.a = XB + (size_t)u.pm * 256 * 4096; u.b = WIN + (size_t)(u.pn * 256 + (u.pn >= 8 ? 1024 : 0)) * 4096; }
        else { tile_of(L - 2048, 4, NTOK / 256, u.pm, u.pn); u.e = 1; u.a = WIN + (size_t)(2048 + u.pm * 256) * 4096; u.b = XB + (size_t)u.pn * 256 * 4096; }
        return true; }
    __device__ __forceinline__ void gather(const Unit&, const unsigned (&)[2], unsigned (&)[2][2]) const {}
};
#define EPI_ROWS(ai, m) (u.pm * 256 + (ai) * 128 + wr * 64 + (m) * 16 + fr)
__device__ __forceinline__ v4u pack8(const f32x4 a, const f32x4 b) { v4u w; w.x = cvt_pk_bf16(a[0], a[1]); w.y = cvt_pk_bf16(a[2], a[3]); w.z = cvt_pk_bf16(b[0], b[1]); w.w = cvt_pk_bf16(b[2], b[3]); return w; }
struct EpiRowScale { static constexpr bool PERM = true, MIDK = false, INPLACE = false, PREF = true; const float* ss; bf16* out; int ld, split_cols; size_t split_stride; float mul0; LAS float* slots;
    __device__ __forceinline__ void prefetch(const Unit& u) const { const int tid = threadIdx.x, w = __builtin_amdgcn_readfirstlane(tid >> 6);
        if (w < 4) __builtin_amdgcn_global_load_lds((const unsigned*)(ss + u.pm * 256 + tid), (LAS unsigned*)(slots + (u.idx & 1) * 512 + w * 64), 4, 0, 0); }
    __device__ __forceinline__ void operator()(const Acc& acc, const Unit& u, int wr, int wc, int fr, int fq) const {
        int colt = u.pn * 256; bf16* base = out; float mul = mul0;
        if (split_cols) { const int t = colt / split_cols; base += (size_t)t * split_stride; colt -= t * split_cols; mul = t == 0 ? mul0 : 1.0f; }
        const int col0 = colt + wc * 32 + 8 * fq;
        float rs[2][4]; const LAS float* sl = slots + (u.idx & 1) * 512 + wr * 64 + fr;
#pragma unroll
        for (int ai = 0; ai < 2; ++ai)
#pragma unroll
            for (int m = 0; m < 4; ++m) rs[ai][m] = sl[ai * 128 + m * 16];
#pragma unroll
        for (int ai = 0; ai < 2; ++ai)
#pragma unroll
            for (int m = 0; m < 4; ++m) { const int row = EPI_ROWS(ai, m); const float r = rsqrtf(rs[ai][m] * (1.0f / DM) + EPS) * mul; bf16* rowp = base + (size_t)row * ld + col0;
#pragma unroll
                for (int bj = 0; bj < 2; ++bj) *(v4u*)(rowp + bj * 128) = pack8(acc[ai][bj][m][0] * r, acc[ai][bj][m][1] * r); }
    }
};
struct EpiColScale { static constexpr bool PERM = true, MIDK = false, INPLACE = false, PREF = true; const float* ss; bf16* out; size_t ld; LAS float* slots;
    __device__ __forceinline__ void prefetch(const Unit& u) const { const int tid = threadIdx.x, w = __builtin_amdgcn_readfirstlane(tid >> 6);
        if (w < 4) __builtin_amdgcn_global_load_lds((const unsigned*)(ss + u.pn * 256 + tid), (LAS unsigned*)(slots + (u.idx & 1) * 512 + w * 64), 4, 0, 0); }
    __device__ __forceinline__ void operator()(const Acc& acc, const Unit& u, int wr, int wc, int fr, int fq) const {
        f32x4 sc[2][2];
#pragma unroll
        for (int bj = 0; bj < 2; ++bj) { const LAS float* sl = slots + (u.idx & 1) * 512 + bj * 128 + wc * 32 + 8 * fq; sc[bj][0] = *(const LAS f32x4*)sl; sc[bj][1] = *(const LAS f32x4*)(sl + 4); }
#pragma unroll
        for (int bj = 0; bj < 2; ++bj) { const int c0 = u.pn * 256 + bj * 128 + wc * 32 + 8 * fq; f32x4 s0 = sc[bj][0], s1 = sc[bj][1];
#pragma unroll
            for (int j = 0; j < 4; ++j) { s0[j] = rsqrtf(s0[j] * (1.0f / DM) + EPS); s1[j] = rsqrtf(s1[j] * (1.0f / DM) + EPS); }
#pragma unroll
            for (int ai = 0; ai < 2; ++ai)
#pragma unroll
                for (int m = 0; m < 4; ++m) { const int row = EPI_ROWS(ai, m); *(v4u*)(out + (size_t)row * ld + c0) = pack8(acc[ai][bj][m][0] * s0, acc[ai][bj][m][1] * s1); } }
    }
};
struct EpiP1 { static constexpr bool PERM = true, MIDK = false, INPLACE = false, PREF = true; EpiRowScale rs; EpiColScale cs;
    __device__ __forceinline__ void prefetch(const Unit& u) const { if (u.e == 0) rs.prefetch(u); else cs.prefetch(u); }
    __device__ __forceinline__ void operator()(const Acc& acc, const Unit& u, int wr, int wc, int fr, int fq) const { if (u.e == 0) rs(acc, u, wr, wc, fr, fq); else cs(acc, u, wr, wc, fr, fq); }
};
struct EpiX1 { static constexpr bool PERM = true, MIDK = true, INPLACE = false, PREF = true; const float* scl; const bf16* x; float* x1; bf16* x1b; float* ss1p; LAS float* slots;
    __device__ __forceinline__ void prefetch(const Unit& u) const { const int tid = threadIdx.x, w = __builtin_amdgcn_readfirstlane(tid >> 6);
        __builtin_amdgcn_global_load_lds((const unsigned*)(scl + 2 * (size_t)(u.pm * 256 + (tid & 255)) + (tid >> 8)), (LAS unsigned*)(slots + (u.idx & 1) * 512 + w * 64), 4, 0, 0); }
    __device__ __forceinline__ void midk(Acc& acc, const Unit& u, int wr, int fr) const { const LAS float* sl = slots + (u.idx & 1) * 512 + wr * 64 + fr;
#pragma unroll
        for (int ai = 0; ai < 2; ++ai)
#pragma unroll
            for (int m = 0; m < 4; ++m) { const float s = sl[ai * 128 + m * 16];
#pragma unroll
                for (int bj = 0; bj < 2; ++bj) { acc[ai][bj][m][0] *= s; acc[ai][bj][m][1] *= s; } }
    }
    __device__ __forceinline__ void operator()(const Acc& acc, const Unit& u, int wr, int wc, int fr, int fq) const {
        const int col0 = u.pn * 256 + wc * 32 + 8 * fq; const LAS float* sl = slots + (u.idx & 1) * 512 + 256 + wr * 64 + fr;
#pragma unroll
        for (int ai = 0; ai < 2; ++ai) {
            v4u xw[4][2]; float sv[4];
#pragma unroll
            for (int m = 0; m < 4; ++m) { const int row = EPI_ROWS(ai, m); const size_t off = (size_t)row * DM + col0; sv[m] = sl[ai * 128 + m * 16];
#pragma unroll
                for (int bj = 0; bj < 2; ++bj) xw[m][bj] = *(const v4u*)(x + off + bj * 128); }
#pragma unroll
            for (int m = 0; m < 4; ++m) { const int row = EPI_ROWS(ai, m); const float s = sv[m]; const size_t off = (size_t)row * DM + col0; float q = 0.f;
#pragma unroll
                for (int bj = 0; bj < 2; ++bj) { const v4u w = xw[m][bj];
                    const f32x4 v0 = (f32x4){__uint_as_float(w.x << 16), __uint_as_float(w.x & 0xffff0000u), __uint_as_float(w.y << 16), __uint_as_float(w.y & 0xffff0000u)} + acc[ai][bj][m][0] * s,
                                v1 = (f32x4){__uint_as_float(w.z << 16), __uint_as_float(w.z & 0xffff0000u), __uint_as_float(w.w << 16), __uint_as_float(w.w & 0xffff0000u)} + acc[ai][bj][m][1] * s;
                    *(v4u*)(x1b + off + bj * 128) = pack8(v0, v1);
                    q += (v0[0] * v0[0] + v0[1] * v0[1]) + (v0[2] * v0[2] + v0[3] * v0[3]) + (v1[0] * v1[0] + v1[1] * v1[1]) + (v1[2] * v1[2] + v1[3] * v1[3]); }
                q += __shfl_xor(q, 16); q += __shfl_xor(q, 32);
                if (fq == 0) ss1p[(size_t)row * 32 + u.pn * 4 + wc] = q; } }
    }
};
struct EpiCQ { static constexpr bool PERM = true, MIDK = false, INPLACE = false, PREF = true; const float* ss1p; bf16* cq; LAS float* slots;
    __device__ __forceinline__ void prefetch(const Unit& u) const { const int tid = threadIdx.x;
        if (tid < 256) { const f32x4* sp = (const f32x4*)(ss1p + (size_t)(u.pm * 256 + tid) * 32); f32x4 t = sp[0];
#pragma unroll
            for (int j = 1; j < 8; ++j) t += sp[j];
            slots[(u.idx & 1) * 512 + tid] = rsqrtf(((t[0] + t[1]) + (t[2] + t[3])) * (1.0f / DM) + EPS) * CQSCALE; } }
    __device__ __forceinline__ void operator()(const Acc& acc, const Unit& u, int wr, int wc, int fr, int fq) const {
        const int col0 = u.pn * 256 + wc * 32 + 8 * fq; const LAS float* sl = slots + (u.idx & 1) * 512 + wr * 64 + fr;
        float rr[2][4];
#pragma unroll
        for (int ai = 0; ai < 2; ++ai)
#pragma unroll
            for (int m = 0; m < 4; ++m) rr[ai][m] = sl[ai * 128 + m * 16];
#pragma unroll
        for (int ai = 0; ai < 2; ++ai)
#pragma unroll
            for (int m = 0; m < 4; ++m) { const int row = EPI_ROWS(ai, m); const float r = rr[ai][m];
#pragma unroll
                for (int bj = 0; bj < 2; ++bj) *(v4u*)(cq + (size_t)row * XW + col0 + bj * 128) = pack8(acc[ai][bj][m][0] * r, acc[ai][bj][m][1] * r); }
    }
};
struct EpiX2 { static constexpr bool PERM = true, MIDK = false, INPLACE = false, PREF = false; const bf16* x1b; bf16* x2; unsigned char* x2b;
    __device__ __forceinline__ void operator()(const Acc& acc, const Unit& u, int wr, int wc, int fr, int fq) const {
        const int col0 = u.pn * 256 + wc * 32 + 8 * fq;
#pragma unroll
        for (int ai = 0; ai < 2; ++ai) { v4u xv[4][2];
#pragma unroll
            for (int m = 0; m < 4; ++m) { const size_t off = (size_t)EPI_ROWS(ai, m) * DM + col0;
#pragma unroll
                for (int bj = 0; bj < 2; ++bj) xv[m][bj] = *(const v4u*)(x1b + off + bj * 128); }
#pragma unroll
            for (int m = 0; m < 4; ++m) { const size_t off = (size_t)EPI_ROWS(ai, m) * DM + col0;
#pragma unroll
                for (int bj = 0; bj < 2; ++bj) { const v4u w = xv[m][bj];
                    const f32x4 v0 = (f32x4){__uint_as_float(w.x << 16), __uint_as_float(w.x & 0xffff0000u), __uint_as_float(w.y << 16), __uint_as_float(w.y & 0xffff0000u)} + acc[ai][bj][m][0],
                                v1 = (f32x4){__uint_as_float(w.z << 16), __uint_as_float(w.z & 0xffff0000u), __uint_as_float(w.w << 16), __uint_as_float(w.w & 0xffff0000u)} + acc[ai][bj][m][1];
                    *(v4u*)(x2 + off + bj * 128) = pack8(v0, v1); v2u o; o.x = pk4_fp8(v0[0], v0[1], v0[2], v0[3]); o.y = pk4_fp8(v1[0], v1[1], v1[2], v1[3]); *(v2u*)(x2b + off + bj * 128) = o; } } }
    }
};
struct EpiAct { static constexpr bool PERM = true, MIDK = false, INPLACE = false, PREF = true; const LAS int* cnt; const int* list; const float* r2; const float* b_gu; unsigned char* act; LAS float* slots;
    __device__ __forceinline__ void prefetch(const Unit& u) const { const int tid = threadIdx.x, w = __builtin_amdgcn_readfirstlane(tid >> 6); LAS float* s = slots + (u.idx & 1) * 512 + w * 64; const float* g;
        if (w < 4) { const int ce = cnt[u.e], pos = u.tl * 256 + tid, pc = pos < ce ? pos : ce - 1; g = (const float*)(list + 2 * ((size_t)u.e * NTOK + pc) + 1); }
        else { const int c = tid - 256; g = b_gu + (size_t)u.e * 4096 + (c >> 7) * 2048 + u.pn * 128 + (c & 127); }
        __builtin_amdgcn_global_load_lds((const unsigned*)g, (LAS unsigned*)s, 4, 0, 0); }
    __device__ __forceinline__ void operator()(const Acc& acc, const Unit& u, int wr, int wc, int fr, int fq) const {
        const int cb = u.pn * 128 + wc * 32 + 8 * fq; const LAS float* sl = slots + (u.idx & 1) * 512; const LAS float* bl = sl + 256 + wc * 32 + 8 * fq;
        const f32x4 bg0 = *(const LAS f32x4*)bl, bg1 = *(const LAS f32x4*)(bl + 4), bu0 = *(const LAS f32x4*)(bl + 128) + 1.0f, bu1 = *(const LAS f32x4*)(bl + 132) + 1.0f;
        float sv[2][4];
#pragma unroll
        for (int ai = 0; ai < 2; ++ai)
#pragma unroll
            for (int m = 0; m < 4; ++m) sv[ai][m] = sl[ai * 128 + wr * 64 + m * 16 + fr];
#pragma unroll
        for (int ai = 0; ai < 2; ++ai)
#pragma unroll
            for (int m = 0; m < 4; ++m) { const int r = ai * 128 + wr * 64 + m * 16 + fr; const float s = sv[ai][m];
                f32x4 g0 = acc[ai][0][m][0] * s + bg0, g1 = acc[ai][0][m][1] * s + bg1, u0 = acc[ai][1][m][0] * s + bu0, u1 = acc[ai][1][m][1] * s + bu1;
#pragma unroll
                for (int j = 0; j < 4; ++j) { g0[j] = fminf(g0[j], SW_LIMIT); g1[j] = fminf(g1[j], SW_LIMIT); u0[j] = __builtin_amdgcn_fmed3f(u0[j], 1.0f - SW_LIMIT, 1.0f + SW_LIMIT); u1[j] = __builtin_amdgcn_fmed3f(u1[j], 1.0f - SW_LIMIT, 1.0f + SW_LIMIT); }
                f32x4 z0 = g0 * (-SW_ALPHA * LOG2E), z1 = g1 * (-SW_ALPHA * LOG2E);
#pragma unroll
                for (int j = 0; j < 4; ++j) { z0[j] = __builtin_amdgcn_exp2f(z0[j]); z1[j] = __builtin_amdgcn_exp2f(z1[j]); }
                z0 = z0 + 1.0f; z1 = z1 + 1.0f;
#pragma unroll
                for (int j = 0; j < 4; ++j) { z0[j] = __builtin_amdgcn_rcpf(z0[j]); z1[j] = __builtin_amdgcn_rcpf(z1[j]); }
                g0 = u0 * (g0 * z0); g1 = u1 * (g1 * z1);
                v2u w; w.x = pk4_fp8(g0[0], g0[1], g0[2], g0[3]); w.y = pk4_fp8(g1[0], g1[1], g1[2], g1[3]); *(v2u*)(act + (size_t)(u.pm * 256 + r) * DFF + cb) = w; }
    }
};
struct EpiY { static constexpr bool PERM = true, MIDK = false, INPLACE = false, PREF = true; const float* b_dn; unsigned char* y; LAS float* slots;
    __device__ __forceinline__ void prefetch(const Unit& u) const { const int tid = threadIdx.x, w = __builtin_amdgcn_readfirstlane(tid >> 6);
        if (w < 4) __builtin_amdgcn_global_load_lds((const unsigned*)(b_dn + (size_t)u.e * DM + u.pn * 256 + tid), (LAS unsigned*)(slots + (u.idx & 1) * 512 + 256 + w * 64), 4, 0, 0); }
    __device__ __forceinline__ void operator()(const Acc& acc, const Unit& u, int wr, int wc, int fr, int fq) const {
        const int col0 = u.pn * 256 + wc * 32 + 8 * fq; const LAS float* bl = slots + (u.idx & 1) * 512 + 256 + wc * 32 + 8 * fq;
        f32x4 bb[2][2];
#pragma unroll
        for (int bj = 0; bj < 2; ++bj) { bb[bj][0] = *(const LAS f32x4*)(bl + bj * 128); bb[bj][1] = *(const LAS f32x4*)(bl + bj * 128 + 4); }
#pragma unroll
        for (int bj = 0; bj < 2; ++bj) { const f32x4 b0 = bb[bj][0], b1 = bb[bj][1];
#pragma unroll
            for (int ai = 0; ai < 2; ++ai)
#pragma unroll
                for (int m = 0; m < 4; ++m) { const f32x4 v0 = acc[ai][bj][m][0] + b0, v1 = acc[ai][bj][m][1] + b1; v2u w; w.x = pk4_fp8(v0[0], v0[1], v0[2], v0[3]); w.y = pk4_fp8(v1[0], v1[1], v1[2], v1[3]);
                    *(v2u*)(y + (size_t)EPI_ROWS(ai, m) * DM + col0 + bj * 128) = w; } }
    }
};
#undef EPI_ROWS
}

#define GLDS16(gp, lp) __builtin_amdgcn_global_load_lds((const unsigned*)(gp), (LAS unsigned*)(lp), 16, 0, 0)
#define MFMA32(a, b, c) __builtin_amdgcn_mfma_f32_32x32x16_bf16((a), (b), (c), 0, 0, 0)
#define MFMA16(a, b, c) __builtin_amdgcn_mfma_f32_16x16x32_bf16((a), (b), (c), 0, 0, 0)
typedef __bf16 bf16x2_t __attribute__((ext_vector_type(2)));
__device__ __forceinline__ unsigned cvtpk(float lo, float hi) { const f32x2 v = {lo, hi}; return __builtin_bit_cast(unsigned, __builtin_convertvector(v, bf16x2_t)); }
__device__ __forceinline__ bf16x8 pack_p(const f32x16& p, int s) {
    v4u w; w.x = cvtpk(p[8 * s + 0], p[8 * s + 1]); w.y = cvtpk(p[8 * s + 2], p[8 * s + 3]); w.z = cvtpk(p[8 * s + 4], p[8 * s + 5]); w.w = cvtpk(p[8 * s + 6], p[8 * s + 7]);
    return __builtin_bit_cast(bf16x8, w);
}
__device__ __forceinline__ int pi32(int r) { return (r & 0x13) | ((r & 4) << 1) | ((r & 8) >> 1); }
__device__ __forceinline__ float max3f(float a, float b, float c) { float r; asm("v_max3_f32 %0, %1, %2, %3" : "=v"(r) : "v"(a), "v"(b), "v"(c)); return r; }
__device__ __forceinline__ float max32(const f32x16& p, const f32x16& q) {
    float a = max3f(p[0], p[1], p[2]), b = max3f(p[3], p[4], p[5]), c = max3f(p[6], p[7], p[8]), d = max3f(p[9], p[10], p[11]);
    a = max3f(a, p[12], p[13]); b = max3f(b, p[14], p[15]); c = max3f(c, q[0], q[1]); d = max3f(d, q[2], q[3]);
    a = max3f(a, q[4], q[5]); b = max3f(b, q[6], q[7]); c = max3f(c, q[8], q[9]); d = max3f(d, q[10], q[11]);
    a = max3f(a, q[12], q[13]); b = max3f(b, q[14], q[15]); return max3f(max3f(a, b, c), d, d); }
__device__ __forceinline__ float max16(const f32x16& p) { float a = fmaxf(fmaxf(p[0], p[1]), fmaxf(p[2], p[3])), b = fmaxf(fmaxf(p[4], p[5]), fmaxf(p[6], p[7])), c = fmaxf(fmaxf(p[8], p[9]), fmaxf(p[10], p[11])), d = fmaxf(fmaxf(p[12], p[13]), fmaxf(p[14], p[15])); return fmaxf(fmaxf(a, b), fmaxf(c, d)); }
__device__ __forceinline__ float sum16(const f32x16& p) { return ((p[0] + p[1]) + (p[2] + p[3])) + ((p[4] + p[5]) + (p[6] + p[7])) + ((p[8] + p[9]) + (p[10] + p[11])) + ((p[12] + p[13]) + (p[14] + p[15])); }

namespace battn {
constexpr int NS = 6, SLOT = 16384, TAB_OFF = NS * SLOT;
__device__ __forceinline__ void unit(LAS unsigned char* lds, const bf16* __restrict__ Q, const bf16* __restrict__ Kp, const bf16* __restrict__ VT, const float* __restrict__ rel, bf16* mix, float* ssa, int b, int h, int u) {
    const int tid = threadIdx.x, lane = tid & 63, wave = __builtin_amdgcn_readfirstlane(tid >> 6), r32 = lane & 31, hh = lane >> 5, j = wave >> 1, qh = wave & 1, c0 = 4 * u;
    LAS float* tab = (LAS float*)(lds + TAB_OFF);
    const int tix = tid < RELW ? tid : RELW - 1; const float trel = rel[h * RELW + tix], tfar = rel[h * RELW + RELW - 1];
    const int lrow = tid >> 3, lchunk = (tid & 7) ^ ((lrow >> 1) & 7);
    const bf16* ksrc = Kp + ((size_t)b * SEQ + lrow) * 1024 + h * 64 + lchunk * 8;
    const bf16* vsrc = VT + (size_t)(h * 64 + lrow) * NTOK + (size_t)b * SEQ + lchunk * 8;
#define BA_LOAD(T) do { const int _sl = (((T) + 12) % NS) * SLOT + wave * 1024; const int _t = (T) < 0 ? 0 : (T); GLDS16(ksrc + (size_t)_t * 64 * 1024, lds + _sl); GLDS16(vsrc + (size_t)_t * 64, lds + _sl + 8192); } while (0)
    const size_t tok = (size_t)b * SEQ + (c0 + j) * 64 + 32 * qh + r32;
    bf16x8 qf[4];
#pragma unroll
    for (int d0 = 0; d0 < 4; ++d0) qf[d0] = *(const bf16x8*)(Q + tok * 1024 + h * 64 + 16 * d0 + 8 * hh);
#pragma unroll
    for (int T = c0 - 8; T < c0 - 3; ++T) BA_LOAD(T);
    if (tid < 320) tab[tid] = (trel - tfar) * LOG2E;
    asm volatile("s_waitcnt vmcnt(2) lgkmcnt(0)" ::: "memory"); __builtin_amdgcn_s_barrier(); asm volatile("" ::: "memory");
    float mrun = 0.f; f32x16 o0 = {}, o1 = {}, o2 = {}; bool first = true;
    f32x16 cfarv;
    const bf16x8 onesf = (r32 == 0) ? (bf16x8){0x3f80, 0x3f80, 0x3f80, 0x3f80, 0x3f80, 0x3f80, 0x3f80, 0x3f80} : (bf16x8){0, 0, 0, 0, 0, 0, 0, 0};
    constexpr float THR = 8.0f;
    const float cfar = rel[h * RELW + RELW - 1] * LOG2E;
#pragma unroll
    for (int r = 0; r < 16; ++r) cfarv[r] = cfar;
    const int k0r = pi32(r32), ks0 = (k0r >> 1) & 7, vs0 = (r32 >> 1) & 7;
    unsigned kof[4], vof[4];
#pragma unroll
    for (int d0 = 0; d0 < 4; ++d0) { kof[d0] = (unsigned)(k0r * 128 + (((2 * d0 + hh) ^ ks0) << 4)); vof[d0] = (unsigned)(8192 + r32 * 128 + (((2 * d0 + hh) ^ vs0) << 4)); asm volatile("" : "+v"(kof[d0]), "+v"(vof[d0])); }
#pragma unroll 1
    for (int s = 0; s < 9; ++s) {
        if (s < 7) BA_LOAD(c0 - 3 + s);
        const int T = c0 + j - 8 + s;
        if (T >= 0) {
            unsigned sbo = (unsigned)(((T + 12) % NS) * SLOT); asm volatile("" : "+s"(sbo));
            const int dj = 8 - s;
            bf16x8 kf0[4], kf1[4], vf0[4], vf1[4];
#pragma unroll
            for (int d0 = 0; d0 < 4; ++d0) { const LAS unsigned char* kp_ = lds + (kof[d0] + sbo); kf0[d0] = *(const LAS bf16x8*)kp_; kf1[d0] = *(const LAS bf16x8*)(kp_ + 4096); }
#pragma unroll
            for (int d0 = 0; d0 < 4; ++d0) { const LAS unsigned char* vp_ = lds + (vof[d0] + sbo); vf0[d0] = *(const LAS bf16x8*)vp_; vf1[d0] = *(const LAS bf16x8*)(vp_ + 4096); }
            f32x16 p0 = MFMA32(kf0[0], qf[0], cfarv), p1 = MFMA32(kf1[0], qf[0], cfarv);
#pragma unroll
            for (int d0 = 1; d0 < 4; ++d0) { p0 = MFMA32(kf0[d0], qf[d0], p0); p1 = MFMA32(kf1[d0], qf[d0], p1); }
            if (dj < 3) { const LAS float* tb = tab + (64 * dj + 32 * qh + r32 + 128 - 8 * hh - 55); asm volatile("" : "+v"(tb));
#pragma unroll
                for (int r = 0; r < 16; ++r) { p0[r] += tb[55 - (16 * (r >> 3) + (r & 7))]; p1[r] += tb[23 - (16 * (r >> 3) + (r & 7))]; } }
            asm volatile("s_nop 15\n\ts_nop 7" : "+v"(p0), "+v"(p1));
            float mx = max32(p0, p1); { auto t_ = __builtin_amdgcn_permlane32_swap(__float_as_uint(mx), __float_as_uint(mx), false, false); mx = fmaxf(__uint_as_float(t_[0]), __uint_as_float(t_[1])); }
            if (first || __any(mx > THR)) {
                const float dl = first ? mx : fmaxf(mx, 0.f); mrun += dl;
                const float corr = first ? 1.0f : __builtin_amdgcn_exp2f(-dl); first = false;
#pragma unroll
                for (int r = 0; r < 16; ++r) { p0[r] -= dl; p1[r] -= dl; o0[r] *= corr; o1[r] *= corr; cfarv[r] = cfar - mrun; }
                o2[0] *= corr; }
#pragma unroll
            for (int r = 0; r < 16; ++r) { p0[r] = __builtin_amdgcn_exp2f(p0[r]); p1[r] = __builtin_amdgcn_exp2f(p1[r]); }
            const bf16x8 pf00 = pack_p(p0, 0), pf01 = pack_p(p0, 1), pf10 = pack_p(p1, 0), pf11 = pack_p(p1, 1);
#define BA_V(c, hi) ((hi) ? vf1[c] : vf0[c])
            o0 = MFMA32(BA_V(0, 0), pf00, o0); o0 = MFMA32(BA_V(1, 0), pf01, o0); o0 = MFMA32(BA_V(2, 0), pf10, o0); o0 = MFMA32(BA_V(3, 0), pf11, o0);
            o1 = MFMA32(BA_V(0, 1), pf00, o1); o1 = MFMA32(BA_V(1, 1), pf01, o1); o1 = MFMA32(BA_V(2, 1), pf10, o1); o1 = MFMA32(BA_V(3, 1), pf11, o1);
            o2 = MFMA32(onesf, pf00, o2); o2 = MFMA32(onesf, pf01, o2); o2 = MFMA32(onesf, pf10, o2); o2 = MFMA32(onesf, pf11, o2);
#undef BA_V
        }
        if (s < 7) asm volatile("s_waitcnt vmcnt(2) lgkmcnt(0)" ::: "memory"); else asm volatile("s_waitcnt vmcnt(0) lgkmcnt(0)" ::: "memory");
        __builtin_amdgcn_s_barrier(); asm volatile("" ::: "memory");
    }
#undef BA_LOAD
    const float lden = hh == 0 ? o2[0] : 0.f;
    const float inv = 1.0f / (lden + __shfl_xor(lden, 32)); float ss = 0.f;
#pragma unroll
    for (int r = 0; r < 16; ++r) { o0[r] *= inv; o1[r] *= inv; ss += o0[r] * o0[r] + o1[r] * o1[r]; }
    ss += __shfl_xor(ss, 32); if (hh == 0) ssa[tok * 16 + h] = ss;
    bf16* op = mix + tok * DM + h * 64 + 4 * hh;
#pragma unroll
    for (int g = 0; g < 4; ++g) { v2u w; w.x = pg8::cvt_pk_bf16(o0[4 * g], o0[4 * g + 1]); w.y = pg8::cvt_pk_bf16(o0[4 * g + 2], o0[4 * g + 3]); *(v2u*)(op + 8 * g) = w;
        w.x = pg8::cvt_pk_bf16(o1[4 * g], o1[4 * g + 1]); w.y = pg8::cvt_pk_bf16(o1[4 * g + 2], o1[4 * g + 3]); *(v2u*)(op + 32 + 8 * g) = w; }
}
}

namespace xattn {
__device__ __forceinline__ void unit(LAS unsigned char* lds, const bf16* __restrict__ CQ, const bf16* __restrict__ CK, const bf16* __restrict__ CVT, bf16* ox, int b, int h, int qb, bool reload) {
    const int tid = threadIdx.x, lane = tid & 63, wave = __builtin_amdgcn_readfirstlane(tid >> 6), r32 = lane & 31, hh = lane >> 5;
    if (reload) {
#pragma unroll
        for (int i = 0; i < 8; ++i) { const int idx = i * 512 + tid;
            const int kr = idx >> 4, kc = (idx & 15) ^ (kr & 15); GLDS16(CK + ((size_t)b * MEML + kr) * XW + h * XHD + kc * 8, lds + i * 8192 + wave * 1024);
            const int vr = idx >> 5, vc = (idx & 31) ^ (vr & 15); GLDS16(CVT + (size_t)(h * XHD + vr) * NMEM + (size_t)b * MEML + vc * 8, lds + 65536 + i * 8192 + wave * 1024); }
    }
    const size_t tok = (size_t)b * SEQ + qb * 256 + wave * 32 + r32;
    bf16x8 qf[8];
#pragma unroll
    for (int d0 = 0; d0 < 8; ++d0) qf[d0] = *(const bf16x8*)(CQ + tok * XW + h * XHD + 16 * d0 + 8 * hh);
    asm volatile("s_waitcnt vmcnt(0)" ::: "memory"); __builtin_amdgcn_s_barrier(); asm volatile("" ::: "memory");
    float mrun = -1e30f, lsum = 0.f; f32x16 o[4] = {};
    const int kp = pi32(r32);
    unsigned xkof[8];
#pragma unroll
    for (int d0 = 0; d0 < 8; ++d0) { xkof[d0] = (unsigned)(kp * 256 + (((2 * d0 + hh) ^ (kp & 15)) << 4)); asm volatile("" : "+v"(xkof[d0])); }
#pragma unroll 1
    for (int s = 0; s < 4; ++s) {
        f32x16 p0 = {}, p1 = {};
        unsigned so = (unsigned)(s * 16384); asm volatile("" : "+s"(so));
        bf16x8 kf0[8], kf1[8];
#pragma unroll
        for (int d0 = 0; d0 < 8; ++d0) { const LAS unsigned char* kp_ = lds + (xkof[d0] + so); kf0[d0] = *(const LAS bf16x8*)kp_; kf1[d0] = *(const LAS bf16x8*)(kp_ + 8192); }
#pragma unroll
        for (int d0 = 0; d0 < 8; ++d0) { p0 = MFMA32(kf0[d0], qf[d0], p0); p1 = MFMA32(kf1[d0], qf[d0], p1); }
        asm volatile("s_nop 15\n\ts_nop 7" : "+v"(p0), "+v"(p1));
        float mx = max32(p0, p1); { auto t_ = __builtin_amdgcn_permlane32_swap(__float_as_uint(mx), __float_as_uint(mx), false, false); mx = fmaxf(__uint_as_float(t_[0]), __uint_as_float(t_[1])); }
        const float mnew = fmaxf(mrun, mx), corr = __builtin_amdgcn_exp2f(mrun - mnew); mrun = mnew;
#pragma unroll
        for (int r = 0; r < 16; ++r) { p0[r] = __builtin_amdgcn_exp2f(p0[r] - mnew); p1[r] = __builtin_amdgcn_exp2f(p1[r] - mnew); }
        lsum = lsum * corr + (sum16(p0) + sum16(p1));
        const bf16x8 pf00 = pack_p(p0, 0), pf01 = pack_p(p0, 1), pf10 = pack_p(p1, 0), pf11 = pack_p(p1, 1);
#pragma unroll
        for (int dh = 0; dh < 4; ++dh) { const int vr = 32 * dh + r32; const LAS unsigned char* vb = lds + 65536 + vr * 512;
#pragma unroll
            for (int r = 0; r < 16; ++r) o[dh][r] *= corr;
#define XA_V(c) (*(const LAS bf16x8*)(vb + ((((8 * s + (c) + hh)) ^ (vr & 15)) << 4)))
            o[dh] = MFMA32(XA_V(0), pf00, o[dh]); o[dh] = MFMA32(XA_V(2), pf01, o[dh]); o[dh] = MFMA32(XA_V(4), pf10, o[dh]); o[dh] = MFMA32(XA_V(6), pf11, o[dh]);
#undef XA_V
        }
    }
    const float inv = 1.0f / (lsum + __shfl_xor(lsum, 32));
    bf16* op = ox + tok * XW + h * XHD + 4 * hh;
#pragma unroll
    for (int dh = 0; dh < 4; ++dh)
#pragma unroll
        for (int g = 0; g < 4; ++g) { v2u w; w.x = pg8::cvt_pk_bf16(o[dh][4 * g] * inv, o[dh][4 * g + 1] * inv); w.y = pg8::cvt_pk_bf16(o[dh][4 * g + 2] * inv, o[dh][4 * g + 3] * inv); *(v2u*)(op + 32 * dh + 8 * g) = w; }
    asm volatile("s_waitcnt lgkmcnt(0)" ::: "memory"); __builtin_amdgcn_s_barrier(); asm volatile("" ::: "memory");
}
}

namespace lru {
constexpr int XA_P = 272, XA_OFF = 0, XF_OFF = 64 * XA_P, SA_OFF = XF_OFF + 64 * 64 * 4, SB_OFF = SA_OFF + 64 * 68 * 4, SC_OFF = SB_OFF + 64 * 68 * 4, HS_OFF = SC_OFF + 8 * 64 * 8, END_OFF = HS_OFF + 256;
__device__ __forceinline__ float fsig(float x) { return __builtin_amdgcn_rcpf(1.0f + __builtin_amdgcn_exp2f(-LOG2E * x)); }
__device__ __forceinline__ void unit(LAS unsigned char* lds, const bf16* __restrict__ xr, const bf16* __restrict__ yg, const float* __restrict__ conv_w, const float* __restrict__ conv_b, const bf16* __restrict__ wga_t, const bf16* __restrict__ wgx_t,
                                     const float* __restrict__ b_ga, const float* __restrict__ b_gx, const float* __restrict__ lam, bf16* mix, float* ssl, int b, int g) {
    const int tid = threadIdx.x, lane = tid & 63, wave = __builtin_amdgcn_readfirstlane(tid >> 6), n = g >> 1, hf = g & 1;
    LAS float* XF = (LAS float*)(lds + XF_OFF); LAS float* SA = (LAS float*)(lds + SA_OFF); LAS float* SB = (LAS float*)(lds + SB_OFF); LAS f32x2* SC = (LAS f32x2*)(lds + SC_OFF); LAS float* HS = (LAS float*)(lds + HS_OFF);
    if (tid < 64) HS[tid] = 0.f;
    const int tb = wave & 3, dq = wave >> 2, l15 = lane & 15, l4 = lane >> 4;
    bf16x8 wf[2][2][4];
#pragma unroll
    for (int dt = 0; dt < 2; ++dt)
#pragma unroll
        for (int ks = 0; ks < 4; ++ks) { const size_t off = (size_t)(n * 128 + hf * 64 + dq * 32 + 16 * dt + l15) * 128 + 32 * ks + 8 * l4;
            wf[0][dt][ks] = *(const bf16x8*)(wga_t + off); wf[1][dt][ks] = *(const bf16x8*)(wgx_t + off); }
    float cba[2][4], cbx[2][4], csp[2][4];
#pragma unroll
    for (int dt = 0; dt < 2; ++dt)
#pragma unroll
        for (int r = 0; r < 4; ++r) { const int c = n * 128 + hf * 64 + dq * 32 + 16 * dt + 4 * l4 + r; cba[dt][r] = -LOG2E * b_ga[c]; cbx[dt][r] = -LOG2E * b_gx[c]; csp[dt][r] = LOG2E * (-8.0f * log1pf(__expf(-lam[c]))); }
    float cw0[4], cw1[4];
#pragma unroll
    for (int jj = 0; jj < 4; ++jj) { cw0[jj] = conv_w[jj * LW + n * 128 + 2 * lane]; cw1[jj] = conv_w[jj * LW + n * 128 + 2 * lane + 1]; }
    const float cb0 = conv_b[n * 128 + 2 * lane], cb1 = conv_b[n * 128 + 2 * lane + 1];
#define LRU_UNI(p) ({ const unsigned long long _p = (unsigned long long)(p); (GAS char*)(((unsigned long long)(unsigned)__builtin_amdgcn_readfirstlane((int)(_p >> 32)) << 32) | (unsigned)__builtin_amdgcn_readfirstlane((int)_p)); })
#define LRU_VO(v) ({ unsigned _v = (v); asm volatile("" : "+v"(_v)); _v; })
#define LRU_SP(p) ({ GAS char* _q = (GAS char*)(p); asm volatile("" : "+s"(_q)); _q; })
    const GAS char* xru = LRU_UNI(xr + ((size_t)b * SEQ + 8 * wave) * 1024 + n * 128);
    const unsigned lo4 = 4u * (unsigned)lane, lo2 = 2u * (unsigned)lane;
    const int cc = lane, sg = wave;
    const GAS char* ygu = LRU_UNI(yg + ((size_t)b * SEQ + 8 * sg) * 1024 + n * 128 + hf * 64);
    GAS char* outu = LRU_UNI(mix + ((size_t)b * SEQ + 8 * sg) * DM + 1024 + n * 128 + hf * 64);
    unsigned xq[11]; bf16 yv[8];
#define LRU_LOADX(t0) do { _Pragma("unroll") for (int k = 0; k < 11; ++k) { const int trow = (t0) + 8 * wave - 3 + k; xq[k] = trow >= 0 ? *(const GAS unsigned*)(LRU_SP(xru + ((ptrdiff_t)((t0) - 3 + k)) * 2048) + LRU_VO(lo4)) : 0u; } \
        _Pragma("unroll") for (int i = 0; i < 8; ++i) yv[i] = *(const GAS bf16*)(LRU_SP(ygu + ((size_t)(t0) + i) * 2048) + LRU_VO(lo2)); } while (0)
    LRU_LOADX(0);
    asm volatile("s_waitcnt lgkmcnt(0)" ::: "memory"); __builtin_amdgcn_s_barrier(); asm volatile("" ::: "memory");
#pragma unroll 1
    for (int t0 = 0; t0 < SEQ; t0 += 64) {
        { f32x2 xe[11];
#pragma unroll
          for (int k = 0; k < 11; ++k) xe[k] = (f32x2){__uint_as_float(xq[k] << 16), __uint_as_float(xq[k] & 0xffff0000u)};
#pragma unroll
          for (int i = 0; i < 8; ++i) { f32x2 xc2 = (f32x2){cb0, cb1};
#pragma unroll
            for (int jj = 0; jj < 4; ++jj) xc2 += (f32x2){cw0[jj], cw1[jj]} * xe[i + jj];
            *(LAS unsigned*)(lds + XA_OFF + (8 * wave + i) * XA_P + 4 * lane) = cvtpk(xc2.x, xc2.y);
            if ((lane >> 5) == hf) *(LAS f32x2*)(XF + (8 * wave + i) * 64 + 2 * (lane & 31)) = xc2; } }
        bf16 ycur[8];
#pragma unroll
        for (int i = 0; i < 8; ++i) ycur[i] = yv[i];
        if (t0 + 64 < SEQ) LRU_LOADX(t0 + 64);
        asm volatile("s_waitcnt lgkmcnt(0)" ::: "memory"); __builtin_amdgcn_s_barrier(); asm volatile("" ::: "memory");
        {
            f32x4 ar[2] = {}, ai[2] = {};
#pragma unroll
            for (int ks = 0; ks < 4; ++ks) { const bf16x8 xfr = *(const LAS bf16x8*)(lds + XA_OFF + (16 * tb + l15) * XA_P + 64 * ks + 16 * l4);
#pragma unroll
                for (int dt = 0; dt < 2; ++dt) { ar[dt] = MFMA16(wf[0][dt][ks], xfr, ar[dt]); ai[dt] = MFMA16(wf[1][dt][ks], xfr, ai[dt]); } }
            const int tk = 16 * tb + l15;
#pragma unroll
            for (int dt = 0; dt < 2; ++dt) { const int dl = dq * 32 + 16 * dt + 4 * l4; const f32x4 xo = *(const LAS f32x4*)(XF + tk * 64 + dl); f32x4 av, bv;
#pragma unroll
                for (int r = 0; r < 4; ++r) { const float rg = __builtin_amdgcn_rcpf(1.0f + __builtin_amdgcn_exp2f(fmaf(ar[dt][r], -LOG2E, cba[dt][r]))), ig = __builtin_amdgcn_rcpf(1.0f + __builtin_amdgcn_exp2f(fmaf(ai[dt][r], -LOG2E, cbx[dt][r])));
                    const float a_ = __builtin_amdgcn_exp2f(rg * csp[dt][r]); av[r] = a_;
                    bv[r] = __builtin_amdgcn_sqrtf(fmaxf(1.0f - a_ * a_, 0.f)) * (ig * xo[r]); }
                *(LAS f32x4*)(SA + tk * 68 + dl) = av; *(LAS f32x4*)(SB + tk * 68 + dl) = bv; }
        }
        asm volatile("s_waitcnt lgkmcnt(0)" ::: "memory"); __builtin_amdgcn_s_barrier(); asm volatile("" ::: "memory");
        float a8[8], b8[8];
        { float A = 1.f, B = 0.f;
#pragma unroll
            for (int i = 0; i < 8; ++i) { a8[i] = SA[(8 * sg + i) * 68 + cc]; b8[i] = SB[(8 * sg + i) * 68 + cc]; B = a8[i] * B + b8[i]; A *= a8[i]; }
            SC[sg * 64 + cc] = (f32x2){A, B}; }
        asm volatile("s_waitcnt lgkmcnt(0)" ::: "memory"); __builtin_amdgcn_s_barrier(); asm volatile("" ::: "memory");
        {
            float hcur = HS[cc];
#pragma unroll
            for (int s2 = 0; s2 < 7; ++s2) { const f32x2 ab = SC[s2 * 64 + cc]; if (s2 < sg) hcur = ab.x * hcur + ab.y; }
            float ysq[8];
#pragma unroll
            for (int i = 0; i < 8; ++i) { hcur = a8[i] * hcur + b8[i]; const float x = bf2f(ycur[i]);
                const float zg = x * fmaf(x * x, -LOG2E * 1.5957691216f * 0.044715f, -LOG2E * 1.5957691216f);
                const float y = hcur * (x * __builtin_amdgcn_rcpf(1.0f + __builtin_amdgcn_exp2f(zg))); *(GAS bf16*)(LRU_SP(outu + ((size_t)t0 + i) * (DM * 2)) + LRU_VO(lo2)) = (bf16)(cvtpk(y, 0.f) & 0xffffu); ysq[i] = y * y; }
            float rs2[2];
            { float a4[4];
#pragma unroll
              for (int p2 = 0; p2 < 4; ++p2) { auto s_ = __builtin_amdgcn_permlane32_swap(__float_as_uint(ysq[2 * p2]), __float_as_uint(ysq[2 * p2 + 1]), false, false); a4[p2] = __uint_as_float(s_[0]) + __uint_as_float(s_[1]); }
#pragma unroll
              for (int q2 = 0; q2 < 2; ++q2) { auto s_ = __builtin_amdgcn_permlane16_swap(__float_as_uint(a4[2 * q2]), __float_as_uint(a4[2 * q2 + 1]), false, false); float v = __uint_as_float(s_[0]) + __uint_as_float(s_[1]);
                v += __builtin_bit_cast(float, __builtin_amdgcn_mov_dpp(__builtin_bit_cast(int, v), 0xB1, 0xf, 0xf, true));
                v += __builtin_bit_cast(float, __builtin_amdgcn_mov_dpp(__builtin_bit_cast(int, v), 0x4E, 0xf, 0xf, true));
                v += __builtin_bit_cast(float, __builtin_amdgcn_mov_dpp(__builtin_bit_cast(int, v), 0x141, 0xf, 0xf, true));
                v += __builtin_bit_cast(float, __builtin_amdgcn_mov_dpp(__builtin_bit_cast(int, v), 0x140, 0xf, 0xf, true));
                rs2[q2] = v; } }
            if ((lane & 15) == 15) { const int rho = lane >> 4, pv = ((rho & 1) << 1) | (rho >> 1); float* sp = ssl + ((size_t)b * SEQ + t0 + 8 * sg + pv) * 16 + g; sp[0] = rs2[0]; sp[64] = rs2[1]; }
            asm volatile("s_waitcnt lgkmcnt(0)" ::: "memory"); __builtin_amdgcn_s_barrier(); asm volatile("" ::: "memory");
            if (sg == 7) HS[cc] = hcur;
        }
    }
#undef LRU_LOADX
#undef LRU_VO
#undef LRU_SP
#undef LRU_UNI
    asm volatile("s_waitcnt vmcnt(0) lgkmcnt(0)" ::: "memory"); __builtin_amdgcn_s_barrier(); asm volatile("" ::: "memory");
}
}

constexpr int NWAVES = 8, NPHASE = 12;
constexpr int RING_BYTES = 131072, LDSCTL_OFF = RING_BYTES, MISC_OFF = LDSCTL_OFF + 320, LDS_BYTES = 147456;
#define LDS_WAIT() asm volatile("s_waitcnt lgkmcnt(0)" ::: "memory")
#define VM_WAIT() asm volatile("s_waitcnt vmcnt(0)" ::: "memory")

struct TrItem { const float* W; const float* gain; unsigned char* WT; int N, K, k0, n0, drow0, is8; };
__device__ __forceinline__ void tr_load(const TrItem& d, f32x4 (&v)[16], int lane) {
    const int g = lane & 7, r0 = lane >> 3;
#pragma unroll
    for (int i = 0; i < 8; ++i) v[i] = __builtin_nontemporal_load((const GAS f32x4*)(d.W + (size_t)(d.k0 + r0 + 8 * i) * d.N + d.n0 + 4 * g));
    if (d.is8) {
#pragma unroll
        for (int i = 8; i < 16; ++i) v[i] = __builtin_nontemporal_load((const GAS f32x4*)(d.W + (size_t)(d.k0 + r0 + 8 * i) * d.N + d.n0 + 4 * g)); }
}
__device__ __forceinline__ void tr_finish(const TrItem& d, const f32x4 (&v)[16], LAS float* scr, int lane_) {
    int lane = lane_; asm volatile("" : "+v"(lane));
    const int c = lane & 7;
    if (d.is8) {
        { const int g = lane & 7, r0 = lane >> 3;
#pragma unroll
          for (int i = 0; i < 16; ++i) { const float gs = (d.gain ? d.gain[d.k0 + r0 + 8 * i] : 1.0f) * W8_SCALE; *(LAS f32x4*)(scr + (r0 + 8 * i) * 32 + ((g ^ (i >> 1)) << 2)) = v[i] * gs;
              if ((i & 3) == 3) asm volatile("" ::: "memory"); } }
        LDS_WAIT(); asm volatile("" ::: "memory");
#pragma unroll
        for (int j = 0; j < 4; ++j) { const int n = (lane >> 3) + 8 * j; const LAS float* s = scr + (16 * c) * 32 + ((((n >> 2) ^ c) << 2) + (n & 3));
            v4u o; o.x = pk4_fp8(s[0 * 32], s[1 * 32], s[2 * 32], s[3 * 32]); o.y = pk4_fp8(s[4 * 32], s[5 * 32], s[6 * 32], s[7 * 32]); o.z = pk4_fp8(s[8 * 32], s[9 * 32], s[10 * 32], s[11 * 32]); o.w = pk4_fp8(s[12 * 32], s[13 * 32], s[14 * 32], s[15 * 32]);
            __builtin_nontemporal_store(o, (GAS v4u*)(d.WT + (size_t)(d.drow0 + n) * d.K + d.k0 + 16 * c)); }
    } else {
        { const int g = lane & 7, r0 = lane >> 3;
#pragma unroll
          for (int i = 0; i < 8; ++i) *(LAS f32x4*)(scr + (r0 + 8 * i) * 32 + ((g ^ i) << 2)) = v[i]; }
        LDS_WAIT(); asm volatile("" ::: "memory");
        float g[8];
#pragma unroll
        for (int j = 0; j < 8; ++j) g[j] = d.gain ? d.gain[d.k0 + 8 * c + j] : 1.0f;
#pragma unroll
        for (int j = 0; j < 4; ++j) { const int n = (lane >> 3) + 8 * j; const LAS float* s = scr + (8 * c) * 32 + ((((n >> 2) ^ c) << 2) + (n & 3));
            v4u o; o.x = pk2(s[0 * 32] * g[0], s[1 * 32] * g[1]); o.y = pk2(s[2 * 32] * g[2], s[3 * 32] * g[3]); o.z = pk2(s[4 * 32] * g[4], s[5 * 32] * g[5]); o.w = pk2(s[6 * 32] * g[6], s[7 * 32] * g[7]);
            *(GAS v4u*)(d.WT + ((size_t)(d.drow0 + n) * d.K + d.k0 + 8 * c) * 2) = o; }
    }
    LDS_WAIT(); asm volatile("" ::: "memory");
}
__device__ __forceinline__ void row_to_bf16(const float* xrow, bf16* orow, float* ss, int lane) {
    const GAS f32x4* xr = (const GAS f32x4*)xrow + lane; float s = 0.f;
    GAS v2u* o8 = (GAS v2u*)orow + lane;
#pragma unroll
    for (int j = 0; j < 8; ++j) { const f32x4 v = xr[64 * j]; s += (v.x * v.x + v.y * v.y) + (v.z * v.z + v.w * v.w); v2u w; w.x = pk2(v.x, v.y); w.y = pk2(v.z, v.w); o8[64 * j] = w; }
    s = wave_sum(s); if (lane == 0) *ss = s;
}
constexpr int P0_I_IN = 32 * 160, P0_I_OUT = 32 * 64, P0_I_CQ = 32 * 16, P0_I_CKV = 32 * 32, P0_I_CO = 8 * 64, P0_I_G = 8 * 2 * 4, P0_I_GU = 32 * 16 * 128, P0_I_DN = 32 * 16 * 64;
constexpr int P0_NONMOE = P0_I_IN + P0_I_OUT + P0_I_CQ + P0_I_CKV + P0_I_CO + 2 * P0_I_G, P0_NITEMS = P0_NONMOE + P0_I_GU + P0_I_DN;
__device__ __forceinline__ void p0_rows(const P& p, int gw, int NGW, int lane) {
    unsigned char* ws = p.ws;
    for (int m = gw; m < NTOK; m += NGW) row_to_bf16(p.x + (size_t)m * DM, (bf16*)(ws + WS_XB) + (size_t)m * DM, (float*)(ws + WS_SS0) + m, lane);
    for (int m = gw; m < NMEM; m += NGW) row_to_bf16(p.mem + (size_t)m * DM, (bf16*)(ws + WS_MEMB) + (size_t)m * DM, (float*)(ws + WS_SSM) + m, lane);
    for (int i = gw * 64 + lane; i < NE * DM; i += NGW * 64) { const int e = i >> 11, k = i & 2047; ((float*)(ws + WS_W_R))[i] = p.g_ffn[k] * p.w_r[k * NE + e]; }
}
__device__ __forceinline__ void p0_items(const P& p, LAS unsigned char* lds, int first, int last, int gw, int NGW, int wave, int lane) {
    LAS float* scr = (LAS float*)(lds + wave * 16384);
    unsigned char* ws = p.ws;
    constexpr int I_IN = P0_I_IN, I_OUT = P0_I_OUT, I_CQ = P0_I_CQ, I_CKV = P0_I_CKV, I_CO = P0_I_CO, I_G = P0_I_G, I_GU = P0_I_GU;
#define P0_DESC(d, it) do { int r = (it); \
        if (r < I_IN)  { const int kb = r / 160, nb = r % 160; d = TrItem{p.w_in, p.g_mix, ws + WS_W_IN, 5120, DM, kb * 64, nb * 32, nb * 32, 0}; break; } r -= I_IN; \
        if (r < I_OUT) { const int kb = r / 64, nb = r % 64; d = TrItem{p.w_out, kb < 16 ? p.g_att : p.g_lru - 1024, ws + WS_W_OUT, DM, DM, kb * 64, nb * 32, nb * 32, 0}; break; } r -= I_OUT; \
        if (r < I_CQ)  { const int kb = r / 16, nb = r % 16; d = TrItem{p.w_cq, p.g_cross, ws + WS_W_CQ, XW, DM, kb * 64, nb * 32, nb * 32, 0}; break; } r -= I_CQ; \
        if (r < I_CKV) { const int kb = r / 32, nb = r % 32; d = TrItem{p.w_ckv, p.g_mem, ws + WS_W_CKV, 2 * XW, DM, kb * 64, nb * 32, nb * 32, 0}; break; } r -= I_CKV; \
        if (r < I_CO)  { const int kb = r / 64, nb = r % 64; d = TrItem{p.w_co, nullptr, ws + WS_W_CO, DM, XW, kb * 64, nb * 32, nb * 32, 0}; break; } r -= I_CO; \
        if (r < I_G)   { const int n = r >> 3, kb = (r >> 2) & 1, nb = r & 3; d = TrItem{p.w_ga + n * 16384, nullptr, ws + WS_W_GA + n * 32768, LBW, LBW, kb * 64, nb * 32, nb * 32, 0}; break; } r -= I_G; \
        if (r < I_G)   { const int n = r >> 3, kb = (r >> 2) & 1, nb = r & 3; d = TrItem{p.w_gx + n * 16384, nullptr, ws + WS_W_GX + n * 32768, LBW, LBW, kb * 64, nb * 32, nb * 32, 0}; break; } r -= I_G; \
        if (r < I_GU)  { const int e = r >> 11, q = r & 2047, kb = q >> 7, nb = q & 127, n0 = nb * 32; const int c = n0 & 2047, up = n0 >> 11; \
                         d = TrItem{p.w_gu + (size_t)e * DM * 4096, p.g_ffn, ws + WS_W_GU + (size_t)e * 4096 * DM, 4096, DM, kb * 128, n0, 256 * (c >> 7) + (c & 127) + 128 * up, 1}; break; } r -= I_GU; \
        { const int e = r >> 10, q = r & 1023, kb = q >> 6, nb = q & 63; d = TrItem{p.w_dn + (size_t)e * DFF * DM, nullptr, ws + WS_W_DN + (size_t)e * DM * DFF, DM, DFF, kb * 128, nb * 32, nb * 32, 1}; } } while (0)
    const int it0 = first + gw, st = NGW;
    if (it0 < last) {
        TrItem d0, d1, d2; f32x4 v0[16], v1[16], v2[16];
        P0_DESC(d0, it0); tr_load(d0, v0, lane); d1 = d0; d2 = d0;
        if (it0 + st < last) { P0_DESC(d1, it0 + st); tr_load(d1, v1, lane); }
        for (int it = it0; it < last; it += 3 * st) {
            if (it + 2 * st < last) { P0_DESC(d2, it + 2 * st); tr_load(d2, v2, lane); }
            tr_finish(d0, v0, scr, lane);
            if (it + st >= last) break;
            if (it + 3 * st < last) { P0_DESC(d0, it + 3 * st); tr_load(d0, v0, lane); }
            tr_finish(d1, v1, scr, lane);
            if (it + 2 * st >= last) break;
            if (it + 4 * st < last) { P0_DESC(d1, it + 4 * st); tr_load(d1, v1, lane); }
            tr_finish(d2, v2, scr, lane);
        }
    }
#undef P0_DESC
}
__device__ __forceinline__ void p3_scales(const P& p, int gtid, int NT) {
    const float* ssa = (const float*)(p.ws + WS_SSA); const float* ssl = (const float*)(p.ws + WS_SSL); float* scl = (float*)(p.ws + WS_SCL);
    for (int m = gtid; m < NTOK; m += NT) { float a = 0.f, l = 0.f;
#pragma unroll
        for (int i = 0; i < 16; ++i) { a += ssa[(size_t)m * 16 + i]; l += ssl[(size_t)m * 16 + i]; }
        const float ra = rsqrtf(a * (1.0f / AW) + EPS), rl = rsqrtf(l * (1.0f / LW) + EPS);
        scl[2 * m] = ra / rl; scl[2 * m + 1] = rl; }
}
__device__ __forceinline__ void p8_router(const P& p, LAS unsigned char* lds, int bx, int G, int tid, int lane, int wave) {
    const float* wrt = (const float*)(p.ws + WS_W_R); const bf16* x2 = (const bf16*)(p.ws + WS_X2H);
    int* cnt = (int*)(p.ws + WS_CTL) + CW_CNT; int* list = (int*)(p.ws + WS_LIST);
    int* tope = (int*)(p.ws + WS_TOPE); float* topg = (float*)(p.ws + WS_TOPG); int* tpos = (int*)(p.ws + WS_TPOS); float* r2 = (float*)(p.ws + WS_R2);
    LAS int* lcnt = (LAS int*)lds; LAS int* lbase = lcnt + 32;
    const int r32 = lane & 31, hh = lane >> 5;
    for (int tb = bx; tb < NTOK / 128; tb += G) {
        if (tid < 64) lcnt[tid] = 0;
        __syncthreads();
        const int t = tb * 128 + (wave & 3) * 32 + r32;
        float tv[4]; int te[4], posl[4]; float rr = 0.f, g0 = 0.f, g1 = 0.f, g2 = 0.f, g3 = 0.f;
        f32x16 acc = {}; float ss = 0.f;
        {
            const GAS v4u* xp = (const GAS v4u*)(x2 + (size_t)t * DM + 16 * hh);
            const GAS f32x4* wp = (const GAS f32x4*)(wrt + (size_t)r32 * DM + 16 * hh);
            f32x4 xa[4], wa[4], xb[4], wb[4]; const int m0 = (wave >> 2) * 32;
#define RT_LOAD(X, W, m) do { const v4u w0_ = xp[4 * (m)], w1_ = xp[4 * (m) + 1]; \
        X[0] = (f32x4){__uint_as_float(w0_.x << 16), __uint_as_float(w0_.x & 0xffff0000u), __uint_as_float(w0_.y << 16), __uint_as_float(w0_.y & 0xffff0000u)}; \
        X[1] = (f32x4){__uint_as_float(w0_.z << 16), __uint_as_float(w0_.z & 0xffff0000u), __uint_as_float(w0_.w << 16), __uint_as_float(w0_.w & 0xffff0000u)}; \
        X[2] = (f32x4){__uint_as_float(w1_.x << 16), __uint_as_float(w1_.x & 0xffff0000u), __uint_as_float(w1_.y << 16), __uint_as_float(w1_.y & 0xffff0000u)}; \
        X[3] = (f32x4){__uint_as_float(w1_.z << 16), __uint_as_float(w1_.z & 0xffff0000u), __uint_as_float(w1_.w << 16), __uint_as_float(w1_.w & 0xffff0000u)}; \
        _Pragma("unroll") for (int q = 0; q < 4; ++q) W[q] = wp[8 * (m) + q]; } while (0)
#define RT_MMA(X, W) do { _Pragma("unroll") for (int q = 0; q < 4; ++q) _Pragma("unroll") for (int jj = 0; jj < 4; ++jj) { acc = __builtin_amdgcn_mfma_f32_32x32x2f32(W[q][jj], X[q][jj], acc, 0, 0, 0); ss += X[q][jj] * X[q][jj]; } } while (0)
            RT_LOAD(xa, wa, m0);
#pragma unroll 1
            for (int m = m0; m < m0 + 32; m += 2) {
                RT_LOAD(xb, wb, m + 1);
                RT_MMA(xa, wa);
                if (m + 2 < m0 + 32) RT_LOAD(xa, wa, m + 2);
                RT_MMA(xb, wb);
            }
#undef RT_LOAD
#undef RT_MMA
        }
        LAS float* part = (LAS float*)(lds + 1024);
        if (wave >= 4) {
#pragma unroll
            for (int r = 0; r < 16; ++r) part[((wave & 3) * 17 + r) * 64 + lane] = acc[r];
            part[((wave & 3) * 17 + 16) * 64 + lane] = ss; }
        __syncthreads();
        if (wave < 4) {
#pragma unroll
            for (int r = 0; r < 16; ++r) acc[r] += part[(wave * 17 + r) * 64 + lane];
            ss += part[(wave * 17 + 16) * 64 + lane];
            ss += __shfl_xor(ss, 32); rr = rsqrtf(ss * (1.0f / DM) + EPS);
            float l[16];
#pragma unroll
            for (int r = 0; r < 16; ++r) l[r] = acc[r] * rr + p.b_r[(r & 3) + 8 * (r >> 2) + 4 * hh];
#pragma unroll
            for (int k = 0; k < TOPK; ++k) { float bv = l[0]; int bi = 0;
#pragma unroll
                for (int r = 1; r < 16; ++r) if (l[r] > bv) { bv = l[r]; bi = r; }
                const int be = (bi & 3) + 8 * (bi >> 2) + 4 * hh; const float pv = __shfl_xor(bv, 32); const int pe = __shfl_xor(be, 32);
                const bool win = (bv > pv) || (bv == pv && be < pe);
                tv[k] = win ? bv : pv; te[k] = win ? be : pe;
#pragma unroll
                for (int r = 0; r < 16; ++r) l[r] = (win && r == bi) ? -INFINITY : l[r]; }
            const float e1 = __expf(tv[1] - tv[0]), e2 = __expf(tv[2] - tv[0]), e3 = __expf(tv[3] - tv[0]); const float inv = 1.0f / (1.0f + e1 + e2 + e3);
            g0 = inv; g1 = e1 * inv; g2 = e2 * inv; g3 = e3 * inv;
            if (hh == 0) {
#pragma unroll
                for (int k = 0; k < TOPK; ++k) posl[k] = __hip_atomic_fetch_add(&lcnt[te[k]], 1, __ATOMIC_RELAXED, __HIP_MEMORY_SCOPE_WORKGROUP); }
        }
        __syncthreads();
        if (tid < NE) lbase[tid] = atomicAdd(&cnt[tid], lcnt[tid]);
        __syncthreads();
        if (wave < 4 && hh == 0) {
#pragma unroll
            for (int k = 0; k < TOPK; ++k) { const int e = te[k], pos = lbase[e] + posl[k]; *(v2u*)(list + 2 * ((size_t)e * NTOK + pos)) = (v2u){(unsigned)t, __float_as_uint(rr)}; tope[t * 4 + k] = e; tpos[t * 4 + k] = pos; }
            *(f32x4*)(topg + (size_t)t * 4) = (f32x4){g0, g1, g2, g3}; r2[t] = rr;
        }
        __syncthreads();
    }
}
__device__ __forceinline__ void p11_combine(const P& p, int gw, int NGW, int lane, float oscale) {
    const int* cnt = (const int*)(p.ws + WS_CTL) + CW_CNT; const unsigned char* Y = (const unsigned char*)(p.ws + WS_Y);
    const int* tope = (const int*)(p.ws + WS_TOPE); const float* topg = (const float*)(p.ws + WS_TOPG); const int* tpos = (const int*)(p.ws + WS_TPOS);
    int pad = lane < NE ? ((cnt[lane & 31] + 255) >> 8) : 0; int inc = pad;
#pragma unroll
    for (int o = 1; o < 32; o <<= 1) { const int t = __shfl_up(inc, o); if ((lane & 31) >= o) inc += t; }
    const int toff_l = inc - pad;
    for (int m = gw; m < NTOK; m += NGW) {
        GAS f32x4* xr = (GAS f32x4*)(p.out + (size_t)m * DM) + lane;
        const GAS v2u* x2r = (const GAS v2u*)((const bf16*)(p.ws + WS_X2H) + (size_t)m * DM) + lane;
        f32x4 a[8];
#pragma unroll
        for (int j = 0; j < 8; ++j) { const v2u w = x2r[64 * j]; a[j] = (f32x4){__uint_as_float(w.x << 16), __uint_as_float(w.x & 0xffff0000u), __uint_as_float(w.y << 16), __uint_as_float(w.y & 0xffff0000u)}; }
#pragma unroll
        for (int k = 0; k < TOPK; ++k) { const int e = tope[m * 4 + k]; const float g = topg[m * 4 + k]; const int slot = 256 * __shfl(toff_l, e) + tpos[m * 4 + k];
            const GAS unsigned* yr = (const GAS unsigned*)(Y + (size_t)slot * DM) + lane;
#pragma unroll
            for (int j = 0; j < 8; ++j) { const int w = (int)yr[64 * j]; const f32x2 lo = __builtin_amdgcn_cvt_pk_f32_fp8(w, false), hi = __builtin_amdgcn_cvt_pk_f32_fp8(w, true);
                a[j].x += g * lo.x; a[j].y += g * lo.y; a[j].z += g * hi.x; a[j].w += g * hi.y; } }
        float ss = 0.f;
#pragma unroll
        for (int j = 0; j < 8; ++j) ss += (a[j].x * a[j].x + a[j].y * a[j].y) + (a[j].z * a[j].z + a[j].w * a[j].w);
        ss = wave_sum(ss); const float r = rsqrtf(ss * (1.0f / DM) + EPS) * oscale;
        const GAS f32x4* gf = (const GAS f32x4*)p.g_fin + lane;
#pragma unroll
        for (int j = 0; j < 8; ++j) { const f32x4 g = gf[64 * j]; xr[64 * j] = a[j] * r * g; }
    }
}

#ifndef FAST_MASK
#define FAST_MASK 0xFFFu
#endif
#ifndef STAG1
#define STAG1 0
#define STAG9 0
#define STAG10 0
#define STAG4 0
#define STAG7 0
#endif
#ifndef PROBE_PH
#define PROBE_PH (-1)
#define PROBE_US 2000.0f
#define PROBE_OFF 0.0f
#define PROBE_MB 0
#define PROBE_STEPS 4.0f
#define PROBE_CLK 0
#endif
#ifndef NHELP
#define NHELP 40
#define P0_SPLIT (P0_NONMOE + 62000)
#endif
#ifndef DUP_MASK
#define DUP_MASK 0u
#endif
#ifndef SUB2_MASK
#define SUB2_MASK 0x7u
#endif
__global__ void __launch_bounds__(NWAVES * 64, 2) fwd(P p) {
    extern __shared__ __attribute__((aligned(16))) unsigned char lds_raw[];
    LAS unsigned char* lds = (LAS unsigned char*)lds_raw;
    volatile LAS unsigned* MISC = (volatile LAS unsigned*)(lds + MISC_OFF);
    const int tid = threadIdx.x, lane = tid & 63, wave = __builtin_amdgcn_readfirstlane(tid >> 6);
    const int G = gridDim.x, bx = blockIdx.x; const int vcu = (G % 8 == 0) ? (bx % 8) * (G / 8) + bx / 8 : bx;
    const int gw = vcu * NWAVES + wave, NGW = G * NWAVES;
    for (int u = tid; u < (LDS_BYTES - LDSCTL_OFF) / 4; u += NWAVES * 64) ((LAS unsigned*)(lds + LDSCTL_OFF))[u] = 0u;
    __syncthreads();
    unsigned* ctl = (unsigned*)(p.ws + WS_CTL);
    const int lo = p.ph_lo, hi = p.ph_hi;
    XcdBarrier bar; bar.bar = ctl + CW_BAR + p.li * XCD_BAR_WORDS; bar.x = 0; bar.st = nullptr;
    if (hi - lo > 1) bar = xcd_barrier_post(ctl + CW_BAR + p.li * XCD_BAR_WORDS, MISC + 8);
#define IN(k) (lo <= (k) && (k) < hi)
#define SEAM(k) do { if (PROBE_CLK && PROBE_PH >= 0 && bx == 0 && tid == 0) { const unsigned long long c_ = __builtin_amdgcn_s_memtime(), t_ = __builtin_amdgcn_s_memrealtime();   \
            if ((k) == PROBE_PH) { const unsigned long long c0_ = ((unsigned long long)CLK[1] << 32) | CLK[0], t0_ = ((unsigned long long)MISC[17 + 2 * (k)] << 32) | MISC[16 + 2 * (k)]; \
                __hip_atomic_store(ctl + 32, (unsigned)(1000.0f * (float)(c_ - c0_) / (float)(t_ - t0_)), __ATOMIC_RELAXED, __HIP_MEMORY_SCOPE_AGENT); } } \
        if (IN(k) && IN((k) + 1)) xcd_barrier(bar); if (PROBE_PH >= 0 && bx == 0 && tid == 0) { const unsigned long long t_ = __builtin_amdgcn_s_memrealtime(), c_ = __builtin_amdgcn_s_memtime(); MISC[16 + 2 * ((k) + 1)] = (unsigned)t_; MISC[17 + 2 * ((k) + 1)] = (unsigned)(t_ >> 32); CLK[0] = (unsigned)c_; CLK[1] = (unsigned)(c_ >> 32); \
        if (!PROBE_CLK && (k) == PROBE_PH) { const unsigned long long t0_ = ((unsigned long long)MISC[17 + 2 * (k)] << 32) | MISC[16 + 2 * (k)]; __hip_atomic_store(ctl + 32, (unsigned)(t_ - t0_), __ATOMIC_RELAXED, __HIP_MEMORY_SCOPE_AGENT); } } } while (0)
    unsigned char* ws = p.ws;
    LAS int* l_toff = (LAS int*)(lds + LDSCTL_OFF + 512); LAS int* l_cnt = (LAS int*)(lds + LDSCTL_OFF + 768);
    LAS int* l_utab9 = (LAS int*)(lds + LDSCTL_OFF + 1280); LAS int* l_utab10 = (LAS int*)(lds + LDSCTL_OFF + 1536);
    LAS float* l_slots = (LAS float*)(lds + LDSCTL_OFF + 2048);
#define RUN(k, BODY) do { if (IN(k)) { BODY; if ((DUP_MASK >> (k)) & 1u) { xcd_barrier(bar); BODY; } } } while (0)
    const int GP1 = (G == 256) ? G - NHELP : G, p0_last = (G == 256) ? P0_SPLIT : P0_NITEMS;
#define PH0 do { p0_rows(p, gw, NGW, lane); p0_items(p, lds, 0, p0_last, gw, NGW, wave, lane); } while (0)
#define PH1 do {   \
        if (bx < GP1) { pg8::SchedP1 S{(const char*)(ws + WS_XB), (const char*)(ws + WS_W_IN), GP1, bx}; \
          pg8::EpiP1 E{pg8::EpiRowScale{(const float*)(ws + WS_SS0), (bf16*)(ws + WS_QKXY), 1024, 1024, (size_t)NTOK * 1024, QSCALE, l_slots}, pg8::EpiColScale{(const float*)(ws + WS_SS0), (bf16*)(ws + WS_VT), (size_t)NTOK, l_slots}}; \
          pg8::gemm_phase(lds, 2 * DM, S, E, STAG1); } \
        else p0_items(p, lds, p0_last, P0_NITEMS, (bx - GP1) * NWAVES + wave, (G - GP1) * NWAVES, wave, lane); } while (0)
#define PH2 do { \
        if (SUB2_MASK & 1u) {     \
            { pg8::SchedReg S{(const char*)(ws + WS_MEMB), (const char*)(ws + WS_W_CKV), NMEM / 256, 2, G, bx, 4096, 1 << 30, 0}; \
              pg8::EpiRowScale E{(const float*)(ws + WS_SSM), (bf16*)(ws + WS_CK), XW, 0, 0, 1.0f, l_slots}; \
              pg8::gemm_phase(lds, 2 * DM, S, E); } \
            { pg8::SchedReg S{(const char*)(ws + WS_W_CKV) + (size_t)512 * 4096, (const char*)(ws + WS_MEMB), 2, NMEM / 256, G, (bx + 32) % G, 4096, 1 << 30, 0}; \
              pg8::EpiColScale E{(const float*)(ws + WS_SSM), (bf16*)(ws + WS_CVT), (size_t)NMEM, l_slots}; \
              pg8::gemm_phase(lds, 2 * DM, S, E); } \
        } \
        const bf16* QKXY = (const bf16*)(ws + WS_QKXY); \
        if (SUB2_MASK & 4u) { \
            for (int U = vcu; U < BATCH * 16; U += G) \
                lru::unit(lds, QKXY + (size_t)2 * NTOK * 1024, QKXY + (size_t)3 * NTOK * 1024, p.conv_w, p.conv_b, (const bf16*)(ws + WS_W_GA), (const bf16*)(ws + WS_W_GX), p.b_ga, p.b_gx, p.lam, (bf16*)(ws + WS_MIX), (float*)(ws + WS_SSL), U >> 4, U & 15); \
        } \
        if (SUB2_MASK & 2u) {     \
            if (G == 256) { const bool ckvb = (bx < 32) || (bx >= 224); const int idx = ckvb ? (bx < 32 ? bx : bx - 192) : bx - 32, nu = ckvb ? 5 : 9, u0 = ckvb ? idx * 5 : 320 + idx * 9;     \
                for (int q = 0; q < nu; ++q) { const int U = u0 + q; \
                    battn::unit(lds, QKXY, QKXY + (size_t)NTOK * 1024, (const bf16*)(ws + WS_VT), p.rel, (bf16*)(ws + WS_MIX), (float*)(ws + WS_SSA), U >> 7, (U >> 3) & 15, U & 7); } } \
            else for (int U = vcu; U < BATCH * AH * 8; U += G) \
                battn::unit(lds, QKXY, QKXY + (size_t)NTOK * 1024, (const bf16*)(ws + WS_VT), p.rel, (bf16*)(ws + WS_MIX), (float*)(ws + WS_SSA), U >> 7, (U >> 3) & 15, U & 7); \
        } } while (0)
#define PH3 p3_scales(p, gw * 64 + lane, NGW * 64)
#define PH4 do { \
        pg8::SchedReg S{(const char*)(ws + WS_MIX), (const char*)(ws + WS_W_OUT), NTOK / 256, 8, G, bx, 4096, 1 << 30, 0}; \
        pg8::EpiX1 E{(const float*)(ws + WS_SCL), (const bf16*)(ws + WS_XB), p.out, (bf16*)(ws + WS_X1B), (float*)(ws + WS_SS1P), l_slots}; \
        pg8::gemm_phase(lds, 2 * DM, S, E, STAG4); } while (0)
#define PH5 do { \
        pg8::SchedReg S{(const char*)(ws + WS_X1B), (const char*)(ws + WS_W_CQ), NTOK / 256, 2, G, bx, 4096, 1 << 30, 0}; \
        pg8::EpiCQ E{(const float*)(ws + WS_SS1P), (bf16*)(ws + WS_CQ), l_slots}; \
        pg8::gemm_phase(lds, 2 * DM, S, E); } while (0)
#define PH6 do { int prev = -1;     \
        if (G == 256) { for (int i = 0; i < 2; ++i) { const int bh = vcu >> 2; \
            xattn::unit(lds, (const bf16*)(ws + WS_CQ), (const bf16*)(ws + WS_CK), (const bf16*)(ws + WS_CVT), (bf16*)(ws + WS_OX), bh >> 2, bh & 3, (vcu & 3) * 2 + i, i == 0); } } \
        else for (int U = vcu; U < BATCH * XH * 8; U += G) { const int bh = U >> 3; \
            xattn::unit(lds, (const bf16*)(ws + WS_CQ), (const bf16*)(ws + WS_CK), (const bf16*)(ws + WS_CVT), (bf16*)(ws + WS_OX), bh >> 2, bh & 3, U & 7, bh != prev); prev = bh; } } while (0)
#define PH7 do { \
        pg8::SchedReg S{(const char*)(ws + WS_OX), (const char*)(ws + WS_W_CO), NTOK / 256, 8, G, bx, 1024, 1 << 30, 0}; \
        pg8::EpiX2 E{(const bf16*)(ws + WS_X1B), (bf16*)(ws + WS_X2H), (unsigned char*)(ws + WS_X2B)}; \
        pg8::gemm_phase(lds, 2 * XW, S, E, STAG7); } while (0)
#define PH8 p8_router(p, lds, vcu, G, tid, lane, wave)
#define PH9 do { \
        pg8::SchedMoE<true> S{l_utab9, l_cnt, (const int*)(ws + WS_LIST), (const char*)(ws + WS_X2B), (const char*)(ws + WS_W_GU), 4096}; \
        pg8::EpiAct E{l_cnt, (const int*)(ws + WS_LIST), (const float*)(ws + WS_R2), p.b_gu, (unsigned char*)(ws + WS_ACT), l_slots}; \
        pg8::gemm_phase(lds, DM, S, E, STAG9); } while (0)
#define PH10 do { \
        pg8::SchedMoE<false> S{l_utab10, l_cnt, nullptr, (const char*)(ws + WS_ACT), (const char*)(ws + WS_W_DN), 2048}; \
        pg8::EpiY E{p.b_dn, (unsigned char*)(ws + WS_Y), l_slots}; \
        pg8::gemm_phase(lds, DFF, S, E, STAG10); } while (0)
#define PH11 p11_combine(p, gw, NGW, lane, PROBE_PH >= 0 ? 1.0f + sqrtf(exp2f((floorf(log2f((float)__hip_atomic_load(ctl + 32, __ATOMIC_RELAXED, __HIP_MEMORY_SCOPE_AGENT) * 0.01f) * PROBE_STEPS + PROBE_OFF) + 0.5f - PROBE_OFF) * (1.0f / PROBE_STEPS)) * (1.0f / PROBE_US)) : 1.0f)
    volatile LAS unsigned* CLK = (volatile LAS unsigned*)(lds + LDSCTL_OFF + 1024);
    if (PROBE_PH >= 0 && bx == 0 && tid == 0) { const unsigned long long t_ = __builtin_amdgcn_s_memrealtime(), c_ = __builtin_amdgcn_s_memtime(); MISC[16 + 2 * lo] = (unsigned)t_; MISC[17 + 2 * lo] = (unsigned)(t_ >> 32); CLK[0] = (unsigned)c_; CLK[1] = (unsigned)(c_ >> 32); }
    RUN(0, PH0); SEAM(0);
    RUN(1, PH1); SEAM(1);
    RUN(2, PH2); SEAM(2);
    RUN(3, PH3);
    if (PROBE_MB && IN(3)) {
        pg8::v8i a8, b8; bf16x8 a4, b4; f32x4 ac[8];
        for (int i = 0; i < 8; ++i) { a8[i] = 0x38383838 + lane; b8[i] = 0x3c3c3c3c ^ (lane << 3); }
        for (int i = 0; i < 8; ++i) { a4[i] = (short)(0x3f80 + lane); b4[i] = (short)(0x3f00 + 3 * lane); ac[i] = (f32x4){0.f, 0.f, 0.f, 0.f}; }
        asm volatile("" : "+v"(a8), "+v"(b8), "+v"(a4), "+v"(b4));
        __syncthreads();
        const unsigned long long c0 = __builtin_amdgcn_s_memtime();
#pragma unroll 1
        for (int it = 0; it < 2048; ++it) {
#pragma unroll
            for (int i = 0; i < 8; ++i) { if (PROBE_MB == 1) ac[i] = __builtin_amdgcn_mfma_f32_16x16x32_bf16(a4, b4, ac[i], 0, 0, 0);
                else ac[i] = __builtin_amdgcn_mfma_scale_f32_16x16x128_f8f6f4(a8, b8, ac[i], 0, 0, 0, 0x7C7C7C7C, 0, 0x7C7C7C7C); } }
        const unsigned long long c1 = __builtin_amdgcn_s_memtime();
#pragma unroll
        for (int i = 0; i < 8; ++i) asm volatile("" :: "v"(ac[i]));
        if (bx == 0 && tid == 0) __hip_atomic_store(ctl + 32, (unsigned)((c1 - c0) * 100ull / (2048ull * 8ull)) * 100u, __ATOMIC_RELAXED, __HIP_MEMORY_SCOPE_AGENT);
    }
    SEAM(3);
    RUN(4, PH4); SEAM(4);
    RUN(5, PH5); SEAM(5);
    RUN(6, PH6); SEAM(6);
    if (IN(7)) { PH7; } SEAM(7);
    if (IN(8)) { PH8; } SEAM(8);
    if (IN(9) || IN(10)) {
        if (tid < NE) l_cnt[tid] = ((const int*)ctl)[CW_CNT + tid];
        __syncthreads();
        if (tid == 0) { int a = 0; for (int e = 0; e < NE; ++e) { l_toff[e] = a; a += (l_cnt[e] + 255) >> 8; } l_toff[NE] = a; }
        __syncthreads();
        pg8::moe_unit_table(l_toff, l_utab9, 16, G, bx, tid); pg8::moe_unit_table(l_toff, l_utab10, 8, G, bx, tid);
        __syncthreads();
    }
    RUN(9, PH9); SEAM(9);
    RUN(10, PH10); SEAM(10);
    if (IN(11)) { PH11; }
#undef IN
#undef SEAM
}

extern "C" void kernel_launch(void* const* d_in, const int* in_sizes, int n_in, void* d_out, int out_size, void* d_ws, size_t ws_size, hipStream_t stream) {
    static int grid = 0;
    if (grid == 0) {
        if (n_in != 28 || in_sizes[0] != NTOK * DM || out_size != NTOK * DM || ws_size < WS_END) { fprintf(stderr, "kernel_launch: unexpected shapes (n_in %d, ws %zu)\n", n_in, ws_size); grid = -1; return; }
        int dev = 0, cus = 0;
        if (hipGetDevice(&dev) != hipSuccess || hipDeviceGetAttribute(&cus, hipDeviceAttributeMultiprocessorCount, dev) != hipSuccess) { grid = -1; return; }
        if (hipFuncSetAttribute((const void*)fwd, hipFuncAttributeMaxDynamicSharedMemorySize, LDS_BYTES) != hipSuccess) { fprintf(stderr, "kernel_launch: hipFuncSetAttribute failed\n"); grid = -1; return; }
        int per_cu = 0; (void)hipOccupancyMaxActiveBlocksPerMultiprocessor(&per_cu, (const void*)fwd, NWAVES * 64, LDS_BYTES); (void)hipGetLastError();
        grid = cus;
    }
    if (grid < 0) return;
    (void)hipMemsetAsync((char*)d_ws + WS_CTL, 0, (FAST_MASK == 0xFFFu) ? (size_t)32768 : CTL_ZERO_BYTES, stream);
    P p{};
    const float** pp = (const float**)&p;
    for (int i = 0; i < 28; ++i) pp[i] = (const float*)d_in[i];
    p.out = (float*)d_out; p.ws = (unsigned char*)d_ws;
    unsigned char* ws = (unsigned char*)d_ws;
    bf16* QKXY = (bf16*)(ws + WS_QKXY); int* ctl = (int*)(ws + WS_CTL);
    int li = 0;
    auto isfast = [](int ph) { return ph == 2 ? (SUB2_MASK != 0u) : (((FAST_MASK >> ph) & 1u) != 0u); };
    for (int ph = 0; ph < NPHASE;) {
        if (ph == 2) {
            if (!(SUB2_MASK & 1u)) { F1b f{}; f.A = (bf16*)(ws + WS_MEMB); f.Bt = (bf16*)(ws + WS_W_CKV); f.ssm = (float*)(ws + WS_SSM); f.ck = (bf16*)(ws + WS_CK); f.cvt = (bf16*)(ws + WS_CVT);
                  hipLaunchKernelGGL(ngemm<F1b>, dim3(1024 / 64, NMEM / 64), dim3(256), 0, stream, f); }
            if (!(SUB2_MASK & 2u)) hipLaunchKernelGGL(n_attn, dim3(BATCH * AH * 8), dim3(256), 0, stream, QKXY, (const bf16*)(ws + WS_VT), p.rel, (bf16*)(ws + WS_MIX), (float*)(ws + WS_SSA));
            if (!(SUB2_MASK & 4u)) {
                  hipLaunchKernelGGL(n_lru_a, dim3(NTOK * 4), dim3(256), 0, stream, QKXY + (size_t)2 * NTOK * 1024, p.conv_w, p.conv_b, (const bf16*)(ws + WS_W_GA), p.b_ga, (const bf16*)(ws + WS_W_GX), p.b_gx, p.lam, (float*)(ws + WS_NA), (float*)(ws + WS_NB));
                  hipLaunchKernelGGL(n_lru_b, dim3(256), dim3(64), 0, stream, (const float*)(ws + WS_NA), (const float*)(ws + WS_NB), QKXY + (size_t)3 * NTOK * 1024, (bf16*)(ws + WS_MIX), (float*)(ws + WS_SSL)); }
        }
        if (isfast(ph)) { int hi = ph + 1; while (hi < NPHASE && isfast(hi) && !(hi == 2 && SUB2_MASK != 7u)) ++hi;
            p.ph_lo = ph; p.ph_hi = hi; p.li = li++; hipLaunchKernelGGL(fwd, dim3(grid), dim3(NWAVES * 64), LDS_BYTES, stream, p); ph = hi; continue; }
        switch (ph) {
        case 1: { F1 f{}; f.A = (bf16*)(ws + WS_XB); f.Bt = (bf16*)(ws + WS_W_IN); f.ss0 = (float*)(ws + WS_SS0); f.qkxy = QKXY; f.vt = (bf16*)(ws + WS_VT);
                  hipLaunchKernelGGL(ngemm<F1>, dim3(5120 / 64, NTOK / 64), dim3(256), 0, stream, f); } break;
        case 4: { F4 f{}; f.A = (bf16*)(ws + WS_MIX); f.Bt = (bf16*)(ws + WS_W_OUT); f.scl = (float*)(ws + WS_SCL); f.x = p.x; f.x1 = p.out; f.x1b = (bf16*)(ws + WS_X1B); f.ss1p = (float*)(ws + WS_SS1P);
                  hipLaunchKernelGGL(ngemm<F4>, dim3(DM / 64, NTOK / 64), dim3(256), 0, stream, f); } break;
        case 5: { F5 f{}; f.A = (bf16*)(ws + WS_X1B); f.Bt = (bf16*)(ws + WS_W_CQ); f.ss1p = (float*)(ws + WS_SS1P); f.cq = (bf16*)(ws + WS_CQ);
                  hipLaunchKernelGGL(ngemm<F5>, dim3(XW / 64, NTOK / 64), dim3(256), 0, stream, f); } break;
        case 6: hipLaunchKernelGGL(n_xattn, dim3(BATCH * XH * 8 * 2), dim3(256), 0, stream, (const bf16*)(ws + WS_CQ), (const bf16*)(ws + WS_CK), (const bf16*)(ws + WS_CVT), (bf16*)(ws + WS_OX)); break;
        case 7: { F7 f{}; f.A = (bf16*)(ws + WS_OX); f.Bt = (bf16*)(ws + WS_W_CO); f.x12 = p.out; f.x2b = (unsigned char*)(ws + WS_X2B);
                  hipLaunchKernelGGL(ngemm<F7>, dim3(DM / 64, NTOK / 64), dim3(256), 0, stream, f); } break;
        case 9: { hipLaunchKernelGGL(n_toff, dim3(1), dim3(64), 0, stream, (const int*)(ctl + CW_CNT), ctl + CW_TOFF);
                  F9 f{}; f.x2b = (unsigned char*)(ws + WS_X2B); f.wgu = (unsigned char*)(ws + WS_W_GU); f.toff = ctl + CW_TOFF; f.cnt = ctl + CW_CNT; f.list = (int*)(ws + WS_LIST); f.r2 = (float*)(ws + WS_R2); f.b_gu = p.b_gu; f.act = (unsigned char*)(ws + WS_ACT);
                  hipLaunchKernelGGL(ngemm<F9>, dim3(DFF / 32, NSLOT / 64), dim3(256), 0, stream, f); } break;
        case 10: { hipLaunchKernelGGL(n_toff, dim3(1), dim3(64), 0, stream, (const int*)(ctl + CW_CNT), ctl + CW_TOFF);
                  F10 f{}; f.act = (unsigned char*)(ws + WS_ACT); f.wdn = (unsigned char*)(ws + WS_W_DN); f.toff = ctl + CW_TOFF; f.b_dn = p.b_dn; f.y = (unsigned char*)(ws + WS_Y);
                  hipLaunchKernelGGL(ngemm<F10>, dim3(DM / 64, NSLOT / 64), dim3(256), 0, stream, f); } break;
        default: break;
        }
        ++ph;
    }
}
```
